# Optimizing an MI355X kernel written in HIP

```python
import math
import numpy as np
import jax
import jax.numpy as jnp
from jax import lax

D_MODEL = 2048
BATCH = 4
SEQ = 4096
DEPTH = 2

GRID_W = 64
NA_HEADS = 8
NA_HEAD_DIM = 128
NA_WIN_H = 8
NA_WIN_W = 16
MLA_HEADS = 8
MLA_Q_RANK = 512
MLA_KV_RANK = 256
MLA_NOPE_DIM = 128
MLA_ROPE_DIM = 64
MLA_V_DIM = 128
MLA_BLOCK = 128
RET_HEADS = 8
RET_QK_DIM = 256
RET_V_DIM = 512
RET_CHUNK = 128
N_GROUPS = 4
EXPERTS_PER_GROUP = 8
N_EXPERTS = N_GROUPS * EXPERTS_PER_GROUP
TOP_K = 2
D_EXPERT = 512
MOE_BLOCK = 128
PLE_DIM = 256
ROPE_BASE = 10000.0
LN_EPS = 1e-5
RMS_EPS = 1e-6
DN_ALPHA = (2 * DEPTH) ** 0.25
DN_BETA = (8 * DEPTH) ** -0.25
NA_WIDTH = NA_HEADS * NA_HEAD_DIM
AB_IN = 3 * NA_WIDTH + MLA_Q_RANK + MLA_KV_RANK + MLA_ROPE_DIM
AB_OUT = NA_WIDTH + MLA_HEADS * MLA_V_DIM
RET_QK = RET_HEADS * RET_QK_DIM
RET_V = RET_HEADS * RET_V_DIM
C_IN = 2 * RET_QK + 2 * RET_V
C_OUT = RET_V
N_EVEN = (DEPTH + 1) // 2
N_ODD = DEPTH // 2

kernel_name = 'hybrid_natten_mla_retention_hmoe_encoder'


def layer_norm(x, g, b):
    xf = x.astype(jnp.float32)
    xc = xf - jnp.mean(xf, -1, keepdims=True)
    var = jnp.mean(xc * xc, -1, keepdims=True)
    y = xc * lax.rsqrt(var + LN_EPS) * g.astype(jnp.float32) + b.astype(jnp.float32)
    return y.astype(x.dtype)


def rms_norm(x, g):
    xf = x.astype(jnp.float32)
    y = xf * lax.rsqrt(jnp.mean(xf * xf, -1, keepdims=True) + RMS_EPS) * g.astype(jnp.float32)
    return y.astype(x.dtype)


def rope_tables(seq, dim):
    pos = jnp.arange(seq, dtype=jnp.float32)
    inv = jnp.exp(jnp.arange(0, dim, 2, dtype=jnp.float32) * (-math.log(ROPE_BASE) / dim))
    ang = pos[:, None] * inv[None, :]
    return jnp.cos(ang), jnp.sin(ang)


def apply_rope(x, cos, sin):
    xf = x.astype(jnp.float32)
    half = xf.shape[-1] // 2
    x1, x2 = xf[..., :half], xf[..., half:]
    return jnp.concatenate([x1 * cos - x2 * sin, x2 * cos + x1 * sin], -1).astype(x.dtype)


def neighbourhood_indices(rows):
    wr = min(NA_WIN_H, rows)
    ww = NA_WIN_W
    r = np.arange(rows)
    c = np.arange(GRID_W)
    rs = np.clip(r - wr // 2, 0, rows - wr)
    cs = np.clip(c - ww // 2, 0, GRID_W - ww)
    kr = rs[:, None] + np.arange(wr)[None, :]
    kc = cs[:, None] + np.arange(ww)[None, :]
    key = kr[:, None, :, None] * GRID_W + kc[None, :, None, :]
    dr = kr - r[:, None] + (NA_WIN_H - 1)
    dc = kc - c[:, None] + (NA_WIN_W - 1)
    bias = dr[:, None, :, None] * (2 * NA_WIN_W - 1) + dc[None, :, None, :]
    n_keys = wr * ww
    return (key.reshape(rows, GRID_W, n_keys).astype(np.int32),
            bias.reshape(rows, GRID_W, n_keys).astype(np.int32))


def neighbourhood_attention(q, k, v, rpb):
    b, s, h, dh = q.shape
    rows = s // GRID_W
    key_idx, bias_idx = neighbourhood_indices(rows)
    rpb_flat = rpb.reshape(h, -1)
    q_rows = q.reshape(b, rows, GRID_W, h, dh).transpose(1, 0, 2, 3, 4)
    scale = dh ** -0.5

    def row_block(args):
        qr, kidx, bidx = args
        kg = jnp.take(k, kidx, axis=1)
        vg = jnp.take(v, kidx, axis=1)
        sc = jnp.einsum('bqhd,bqkhd->bhqk', qr, kg, preferred_element_type=jnp.float32) * scale
        sc = sc + rpb_flat[:, bidx][None].astype(jnp.float32)
        att = jax.nn.softmax(sc, axis=-1).astype(v.dtype)
        return jnp.einsum('bhqk,bqkhd->bqhd', att, vg)

    out = lax.map(row_block, (q_rows, jnp.asarray(key_idx), jnp.asarray(bias_idx)))
    return out.transpose(1, 0, 2, 3, 4).reshape(b, s, h * dh)


def latent_attention(c_q, c_kv, k_rope, q_norm_g, w_uq, kv_norm_g, w_ukv, cos, sin):
    b, s, _ = c_q.shape
    dq = MLA_NOPE_DIM + MLA_ROPE_DIM
    q = (rms_norm(c_q, q_norm_g) @ w_uq).reshape(b, s, MLA_HEADS, dq)
    q_pe = apply_rope(q[..., MLA_NOPE_DIM:], cos[:, None], sin[:, None])
    q = jnp.concatenate([q[..., :MLA_NOPE_DIM], q_pe], -1)
    kv = (rms_norm(c_kv, kv_norm_g) @ w_ukv).reshape(b, s, MLA_HEADS, MLA_NOPE_DIM + MLA_V_DIM)
    v = kv[..., MLA_NOPE_DIM:]
    k_pe = apply_rope(k_rope, cos, sin)
    k = jnp.concatenate([kv[..., :MLA_NOPE_DIM],
                         jnp.broadcast_to(k_pe[:, :, None, :], (b, s, MLA_HEADS, MLA_ROPE_DIM))], -1)
    scale = dq ** -0.5
    nb = s // MLA_BLOCK
    q_blocks = q.reshape(b, nb, MLA_BLOCK, MLA_HEADS, dq).transpose(1, 0, 2, 3, 4)

    def block(qb):
        sc = jnp.einsum('bqhd,bkhd->bhqk', qb, k, preferred_element_type=jnp.float32) * scale
        att = jax.nn.softmax(sc, axis=-1).astype(v.dtype)
        return jnp.einsum('bhqk,bkhd->bqhd', att, v)

    out = lax.map(block, q_blocks)
    return out.transpose(1, 0, 2, 3, 4).reshape(b, s, MLA_HEADS * MLA_V_DIM)


def retention_scan(q, k, v, log_gamma, include_diag):
    b, h, s, dk = q.shape
    dv = v.shape[-1]
    n = s // RET_CHUNK

    def chunks(t):
        return t.reshape(b, h, n, RET_CHUNK, t.shape[-1]).transpose(2, 0, 1, 3, 4)

    idx = jnp.arange(RET_CHUNK, dtype=jnp.float32)
    rel = idx[:, None] - idx[None, :]
    keep = (rel >= 0) if include_diag else (rel > 0)
    d_intra = jnp.where(keep[None], jnp.exp(log_gamma[:, None, None] * jnp.maximum(rel, 0.0)[None]), 0.0)
    q_dec = jnp.exp(log_gamma[:, None] * (idx + 1.0))[None, :, :, None]
    k_dec = jnp.exp(log_gamma[:, None] * (RET_CHUNK - 1.0 - idx))[None, :, :, None]
    c_dec = jnp.exp(log_gamma * RET_CHUNK)[None, :, None, None]

    def step(state, inp):
        qi, ki, vi = inp
        sc = jnp.einsum('bhqd,bhkd->bhqk', qi, ki) * d_intra
        out = jnp.einsum('bhqk,bhkv->bhqv', sc, vi) + jnp.einsum('bhqd,bhdv->bhqv', qi, state) * q_dec
        state = state * c_dec + jnp.einsum('bhkd,bhkv->bhdv', ki * k_dec, vi)
        return state, out

    state0 = jnp.zeros((b, h, dk, dv), jnp.float32)
    _, out = lax.scan(step, state0, (chunks(q), chunks(k), chunks(v)))
    return out.transpose(1, 2, 0, 3, 4).reshape(b, h, s, dv)


def retention_mixer(hc, log_rate_f, log_rate_b, cos, sin):
    b, s, _ = hc.shape
    q = hc[..., :RET_QK].reshape(b, s, RET_HEADS, RET_QK_DIM)
    k = hc[..., RET_QK:2 * RET_QK].reshape(b, s, RET_HEADS, RET_QK_DIM)
    v = hc[..., 2 * RET_QK:2 * RET_QK + RET_V].reshape(b, s, RET_HEADS, RET_V_DIM)
    g = hc[..., 2 * RET_QK + RET_V:]
    q = apply_rope(q, cos[:, None], sin[:, None]).astype(jnp.float32).transpose(0, 2, 1, 3)
    k = (apply_rope(k, cos[:, None], sin[:, None]).astype(jnp.float32) * RET_QK_DIM ** -0.5).transpose(0, 2, 1, 3)
    v = v.astype(jnp.float32).transpose(0, 2, 1, 3)
    lg_f = jnp.log1p(-jnp.exp(log_rate_f.astype(jnp.float32)))
    lg_b = jnp.log1p(-jnp.exp(log_rate_b.astype(jnp.float32)))
    fwd = retention_scan(q, k, v, lg_f, True)
    bwd = jnp.flip(retention_scan(jnp.flip(q, 2), jnp.flip(k, 2), jnp.flip(v, 2), lg_b, False), 2)
    r = fwd + bwd
    r = r - jnp.mean(r, -1, keepdims=True)
    r = r * lax.rsqrt(jnp.mean(r * r, -1, keepdims=True) + LN_EPS)
    r = r.transpose(0, 2, 1, 3).reshape(b, s, RET_V)
    return (jax.nn.silu(g.astype(jnp.float32)) * r).astype(hc.dtype)


def hier_moe(x, w_group, b_group, w_router, b_router, w_gate, w_up, w_down):
    b, s, d = x.shape
    f32 = jnp.float32
    xt = x.reshape(b * s, d)
    n = xt.shape[0]
    group_prob = jax.nn.softmax(jnp.dot(xt, w_group, preferred_element_type=f32) + b_group.astype(f32), -1)
    g_idx = jnp.argmax(group_prob, -1).astype(jnp.int32)
    p_group = jnp.max(group_prob, -1, keepdims=True)
    logits = jnp.einsum('nd,gde->nge', xt, w_router, preferred_element_type=f32) + b_router.astype(f32)
    sel = jnp.einsum('nge,ng->ne', logits, jax.nn.one_hot(g_idx, N_GROUPS, dtype=f32))
    top_p, top_i = lax.top_k(jax.nn.softmax(sel, -1), TOP_K)
    w_tok = p_group * top_p / jnp.sum(top_p, -1, keepdims=True)
    e_tok = g_idx[:, None] * EXPERTS_PER_GROUP + top_i.astype(jnp.int32)
    n_assign = n * TOP_K
    a_e = e_tok.reshape(-1)
    a_t = jnp.repeat(jnp.arange(n, dtype=jnp.int32), TOP_K)
    a_w = w_tok.reshape(-1)
    order = jnp.argsort(a_e)
    se, st, sw = a_e[order], a_t[order], a_w[order]
    counts = jnp.bincount(a_e, length=N_EXPERTS).astype(jnp.int32)
    padded = (counts + MOE_BLOCK - 1) // MOE_BLOCK * MOE_BLOCK
    start = jnp.cumsum(counts) - counts
    p_end = jnp.cumsum(padded)
    p_start = p_end - padded
    dest = p_start[se] + jnp.arange(n_assign, dtype=jnp.int32) - start[se]
    n_blocks = -(-n_assign // MOE_BLOCK) + N_EXPERTS
    cap = n_blocks * MOE_BLOCK
    slot_t = jnp.zeros((cap,), jnp.int32).at[dest].set(st)
    slot_w = jnp.zeros((cap,), f32).at[dest].set(sw)
    blk_start = jnp.arange(n_blocks, dtype=jnp.int32) * MOE_BLOCK
    blk_e = jnp.clip(jnp.searchsorted(p_end, blk_start, side='right'), 0, N_EXPERTS - 1).astype(jnp.int32)

    def expert_block(args):
        tok, e = args
        xb = xt[tok]
        hb = jax.nn.silu(xb @ w_gate[e]) * (xb @ w_up[e])
        return hb @ w_down[e]

    yb = lax.map(expert_block, (slot_t.reshape(n_blocks, MOE_BLOCK), blk_e))
    y = jnp.zeros((n, d), f32).at[slot_t].add(yb.reshape(cap, d).astype(f32) * slot_w[:, None])
    return y.reshape(b, s, d).astype(x.dtype)


def _normal(key, shape, scale):
    return jax.random.normal(key, shape, jnp.float32) * scale


def setup_inputs(seed: int = 0) -> dict:
    key = jax.random.key(seed)
    ks = jax.random.split(key, 32)
    rpb_shape = (N_EVEN, NA_HEADS, 2 * NA_WIN_H - 1, 2 * NA_WIN_W - 1)
    base_rate = -(5.0 + jnp.arange(RET_HEADS, dtype=jnp.float32)) * math.log(2.0)
    return {
        'x': _normal(ks[0], (BATCH, SEQ, D_MODEL), 1.0),
        'p': _normal(ks[1], (DEPTH, BATCH, SEQ, PLE_DIM), 1.0),
        'ab_w_in': _normal(ks[2], (N_EVEN, D_MODEL, AB_IN), D_MODEL ** -0.5),
        'ab_rpb': _normal(ks[3], rpb_shape, 0.1),
        'ab_q_norm': 1.0 + _normal(ks[4], (N_EVEN, MLA_Q_RANK), 0.02),
        'ab_w_uq': _normal(ks[5], (N_EVEN, MLA_Q_RANK, MLA_HEADS * (MLA_NOPE_DIM + MLA_ROPE_DIM)), MLA_Q_RANK ** -0.5),
        'ab_kv_norm': 1.0 + _normal(ks[6], (N_EVEN, MLA_KV_RANK), 0.02),
        'ab_w_ukv': _normal(ks[7], (N_EVEN, MLA_KV_RANK, MLA_HEADS * (MLA_NOPE_DIM + MLA_V_DIM)), MLA_KV_RANK ** -0.5),
        'ab_w_out': _normal(ks[8], (N_EVEN, AB_OUT, D_MODEL), AB_OUT ** -0.5 * DN_BETA),
        'c_w_in': _normal(ks[9], (N_ODD, D_MODEL, C_IN), D_MODEL ** -0.5),
        'c_log_rate_f': base_rate[None, :] + _normal(ks[10], (N_ODD, RET_HEADS), 0.05),
        'c_log_rate_b': base_rate[None, :] + _normal(ks[11], (N_ODD, RET_HEADS), 0.05),
        'c_w_out': _normal(ks[12], (N_ODD, C_OUT, D_MODEL), C_OUT ** -0.5 * DN_BETA),
        'ln1_g': 1.0 + _normal(ks[13], (DEPTH, D_MODEL), 0.02),
        'ln1_b': _normal(ks[14], (DEPTH, D_MODEL), 0.02),
        'moe_w_group': _normal(ks[15], (DEPTH, D_MODEL, N_GROUPS), D_MODEL ** -0.5),
        'moe_b_group': _normal(ks[16], (DEPTH, N_GROUPS), 0.01),
        'moe_w_router': _normal(ks[17], (DEPTH, N_GROUPS, D_MODEL, EXPERTS_PER_GROUP), D_MODEL ** -0.5),
        'moe_b_router': _normal(ks[18], (DEPTH, N_GROUPS, EXPERTS_PER_GROUP), 0.01),
        'moe_w_gate': _normal(ks[19], (DEPTH, N_EXPERTS, D_MODEL, D_EXPERT), D_MODEL ** -0.5),
        'moe_w_up': _normal(ks[20], (DEPTH, N_EXPERTS, D_MODEL, D_EXPERT), D_MODEL ** -0.5),
        'moe_w_down': _normal(ks[21], (DEPTH, N_EXPERTS, D_EXPERT, D_MODEL), D_EXPERT ** -0.5 * DN_BETA),
        'ple_w_proj': _normal(ks[22], (DEPTH, PLE_DIM, D_MODEL), PLE_DIM ** -0.5),
        'ple_w_gate': _normal(ks[23], (DEPTH, D_MODEL, D_MODEL), D_MODEL ** -0.5),
        'ple_b_gate': _normal(ks[24], (DEPTH, D_MODEL), 0.02),
        'ln2_g': 1.0 + _normal(ks[25], (DEPTH, D_MODEL), 0.02),
        'ln2_b': _normal(ks[26], (DEPTH, D_MODEL), 0.02),
    }


def reference(x, p, ab_w_in, ab_rpb, ab_q_norm, ab_w_uq, ab_kv_norm, ab_w_ukv, ab_w_out,
              c_w_in, c_log_rate_f, c_log_rate_b, c_w_out, ln1_g, ln1_b,
              moe_w_group, moe_b_group, moe_w_router, moe_b_router, moe_w_gate, moe_w_up, moe_w_down,
              ple_w_proj, ple_w_gate, ple_b_gate, ln2_g, ln2_b):
    b, s, _ = x.shape
    cos_mla, sin_mla = rope_tables(s, MLA_ROPE_DIM)
    cos_ret, sin_ret = rope_tables(s, RET_QK_DIM)
    o1 = 3 * NA_WIDTH
    o2 = o1 + MLA_Q_RANK
    o3 = o2 + MLA_KV_RANK
    for i in range(DEPTH):
        j = i // 2
        if i % 2 == 0:
            h = x @ ab_w_in[j]
            qa = h[..., :NA_WIDTH].reshape(b, s, NA_HEADS, NA_HEAD_DIM)
            ka = h[..., NA_WIDTH:2 * NA_WIDTH].reshape(b, s, NA_HEADS, NA_HEAD_DIM)
            va = h[..., 2 * NA_WIDTH:o1].reshape(b, s, NA_HEADS, NA_HEAD_DIM)
            a_out = neighbourhood_attention(qa, ka, va, ab_rpb[j])
            b_out = latent_attention(h[..., o1:o2], h[..., o2:o3], h[..., o3:], ab_q_norm[j], ab_w_uq[j],
                                     ab_kv_norm[j], ab_w_ukv[j], cos_mla, sin_mla)
            mix = jnp.concatenate([a_out, b_out], -1) @ ab_w_out[j]
        else:
            mix = retention_mixer(x @ c_w_in[j], c_log_rate_f[j], c_log_rate_b[j], cos_ret, sin_ret) @ c_w_out[j]
        x = layer_norm(DN_ALPHA * x + mix, ln1_g[i], ln1_b[i])
        ffn = hier_moe(x, moe_w_group[i], moe_b_group[i], moe_w_router[i], moe_b_router[i],
                       moe_w_gate[i], moe_w_up[i], moe_w_down[i])
        ple = jax.nn.sigmoid(x @ ple_w_gate[i] + ple_b_gate[i]) * (p[i] @ ple_w_proj[i])
        x = layer_norm(DN_ALPHA * x + ffn + ple, ln2_g[i], ln2_b[i])
    return x
```

```cpp
#include <hip/hip_runtime.h>
#include <cstdio>
#include <cstdint>

#define GAS __attribute__((address_space(1)))
#define LAS __attribute__((address_space(3)))
typedef unsigned short bf16;
typedef unsigned short bf16_t;
typedef short bf16x8 __attribute__((ext_vector_type(8)));
typedef short s16x4 __attribute__((ext_vector_type(4)));
typedef float f32x4 __attribute__((ext_vector_type(4)));
typedef float f32x2 __attribute__((ext_vector_type(2)));
typedef float f32x8 __attribute__((ext_vector_type(8)));
typedef float f32x16 __attribute__((ext_vector_type(16)));
typedef unsigned u32x4 __attribute__((ext_vector_type(4)));
typedef unsigned u32x2 __attribute__((ext_vector_type(2)));
typedef unsigned v4u __attribute__((ext_vector_type(4)));

#define LDS_WAIT() asm volatile("s_waitcnt lgkmcnt(0)" ::: "memory")
#define VM_WAIT() asm volatile("s_waitcnt vmcnt(0)" ::: "memory")
#define SBAR() __builtin_amdgcn_sched_barrier(0)

__device__ __forceinline__ unsigned cvt_pk_bf16(float lo, float hi) { unsigned r; asm volatile("v_cvt_pk_bf16_f32 %0, %1, %2" : "=v"(r) : "v"(lo), "v"(hi)); return r; }
__device__ __forceinline__ float bf_lo(unsigned w) { return __uint_as_float(w << 16); }
__device__ __forceinline__ float bf_hi(unsigned w) { return __uint_as_float(w & 0xffff0000u); }
__device__ __forceinline__ float bf2f(bf16 h) { return __uint_as_float(((unsigned)h) << 16); }
__device__ __forceinline__ bf16 f2bf(float f) { return (bf16)(cvt_pk_bf16(f, 0.f) & 0xffffu); }
__device__ __forceinline__ float wave_sum(float v, int lane) {
#pragma unroll
    for (int o = 1; o < 64; o <<= 1) v += __int_as_float(__builtin_amdgcn_ds_bpermute((lane ^ o) << 2, __float_as_int(v)));
    return v;
}
__device__ __forceinline__ float fast_exp(float x) { return __builtin_amdgcn_exp2f(x * 1.4426950408889634f); }
__device__ __forceinline__ float sigmoidf_(float x) { return __builtin_amdgcn_rcpf(1.0f + fast_exp(-x)); }

#define XB_TMO      128
#define XB_XCNT(j)  (256  + 64 * (j))
#define XB_XSUB(j)  (1280 + 64 * (j))
#define XB_XGEN(j)  (2304 + 64 * (j))
#define XB_TOP      3328
#define XB_TOPGEN   3392
#define XCD_BAR_WORDS 3456
#define XB_SPIN_CAP (1u << 18)

__device__ __forceinline__ unsigned xb_ld(unsigned* p)              { return __hip_atomic_load(p, __ATOMIC_RELAXED, __HIP_MEMORY_SCOPE_AGENT); }
__device__ __forceinline__ unsigned xb_add(unsigned* p, unsigned v) { return __hip_atomic_fetch_add(p, v, __ATOMIC_RELAXED, __HIP_MEMORY_SCOPE_AGENT); }
__device__ __forceinline__ unsigned xb_xcc_id() { return (unsigned)__builtin_amdgcn_s_getreg((3 << 11) | 20) & 0xFu; }
#define XB_SPIN(cond, bar) do { unsigned _sp = 0; while (cond) { __builtin_amdgcn_s_sleep(1); \
    if ((++_sp & 255u) == 0u) { if (xb_ld(&(bar)[XB_TMO])) break; if (_sp > XB_SPIN_CAP) { atomicAdd(&(bar)[XB_TMO], 1u); break; } } } } while (0)

struct XcdBarrier { unsigned* bar; unsigned x; volatile LAS unsigned* st; };

__device__ __forceinline__ XcdBarrier xcd_barrier_post(unsigned* bar, volatile LAS unsigned* st) {
    XcdBarrier b; b.bar = bar; b.x = xb_xcc_id(); b.st = st;
    if (threadIdx.x == 0) (void)xb_add(&bar[XB_XCNT(b.x)], 1u);
    return b;
}
__device__ __forceinline__ void xcd_barrier_complete(unsigned* bar, unsigned x, unsigned& nloc, unsigned& nx) {
    const unsigned G = gridDim.x * gridDim.y * gridDim.z;
    unsigned sum, cnt, mine, sp = 0u;
    for (;;) {
        sum = 0u; cnt = 0u; mine = 0u;
#pragma unroll
        for (unsigned j = 0; j < 16; ++j) { const unsigned c = xb_ld(&bar[XB_XCNT(j)]); sum += c; cnt += (c > 0u) ? 1u : 0u; mine = (j == x) ? c : mine; }
        if (sum == G) break;
        __builtin_amdgcn_s_sleep(1);
        if ((++sp & 255u) == 0u) { if (xb_ld(&bar[XB_TMO])) break; if (sp > XB_SPIN_CAP) { atomicAdd(&bar[XB_TMO], 1u); break; } }
    }
    nloc = mine > 0u ? mine : 1u; nx = cnt > 0u ? cnt : 1u;
}
__device__ __forceinline__ void xcd_barrier(const XcdBarrier& b) {
    asm volatile("s_waitcnt vmcnt(0)" ::: "memory");
    __syncthreads();
    if (threadIdx.x == 0) {
        unsigned* bar = b.bar; asm volatile("" : "+s"(bar));
        __builtin_amdgcn_s_waitcnt(0);
        unsigned nloc = b.st[0], nx = b.st[1]; unsigned bx = b.x; asm volatile("" : "+s"(bx));
        if (nloc == 0u) { xcd_barrier_complete(bar, bx, nloc, nx); b.st[0] = nloc; b.st[1] = nx; }
        const unsigned old = xb_add(&bar[XB_XSUB(bx)], 1u);
        const unsigned gen = old / nloc;
        if (old + 1u == (gen + 1u) * nloc) {
            __builtin_amdgcn_fence(__ATOMIC_RELEASE, "agent");
            asm volatile("s_waitcnt vmcnt(0)" ::: "memory");
            const unsigned og = xb_add(&bar[XB_TOP], 1u);
            const unsigned tg = og / nx;
            if (og + 1u == (tg + 1u) * nx) xb_add(&bar[XB_TOPGEN], 1u);
            else XB_SPIN(xb_ld(&bar[XB_TOPGEN]) == tg, bar);
            __builtin_amdgcn_fence(__ATOMIC_ACQUIRE, "agent");
            xb_add(&bar[XB_XGEN(bx)], 1u);
            asm volatile("s_waitcnt vmcnt(0)" ::: "memory");
        } else {
            XB_SPIN(xb_ld(&bar[XB_XGEN(bx)]) == gen, bar);
            __builtin_amdgcn_fence(__ATOMIC_ACQUIRE, "agent");
            asm volatile("s_waitcnt vmcnt(0)" ::: "memory");
        }
    }
    __syncthreads();
}

namespace pg8 {
constexpr int BM = 256, BK = 64, HALF = 128, HTB = HALF * BK * 2, STAGE_BYTES = 8 * HTB, NXCD = 8, WGM = 8;
__host__ __device__ __forceinline__ int lds_byte(int r, int c) { const int st = (r >> 4) * 2 + (c >> 5), rr = r & 15, cc = c & 31, ob = rr * 64 + cc * 2; return st * 1024 + (ob ^ (((ob >> 9) & 1) << 5)); }
__host__ __device__ __forceinline__ void stage_rc(int b, int& R, int& C) { const int st = b / 1024, sb = b % 1024, swz = sb ^ (((sb >> 9) & 1) << 5); R = (st >> 1) * 16 + swz / 64; C = (st & 1) * 32 + (swz % 64) / 2; }
__host__ __device__ __forceinline__ int perm32(int rho) { const int n = rho >> 4, i = rho & 15; return 8 * (i >> 2) + 4 * n + (i & 3); }

struct Unit { const char* a; const char* b; int pm, pn; };

__device__ __forceinline__ bool static_tile(int i, int G, int c, int nM, int nN, int& pm, int& pn) {
    const int nwg = nM * nN; const long L = (long)i * G + c; if (L >= nwg) return false;
    int wgid = (int)L; { const int q = nwg / NXCD, r = nwg % NXCD, xcd = wgid % NXCD, off = wgid / NXCD; wgid = (xcd < r ? xcd * (q + 1) : r * (q + 1) + (xcd - r) * q) + off; }
    const int nig = WGM * nN, gid = wgid / nig, fm = gid * WGM, gsz = (nM - fm) < WGM ? (nM - fm) : WGM;
    pm = fm + ((wgid % nig) % gsz); pn = (wgid % nig) / gsz; return true;
}
struct DenseOrder {
    const char* A; const char* Bt; int K, nM, nN, G, c, split, skip;
    __device__ __forceinline__ bool next(int i, Unit& u) const {
        int pm, pn; if (!static_tile(i, G, c, nM, nN, pm, pn)) return false;
        const int pp = pn < split ? pn : pn + skip;
        u.pm = pm; u.pn = pn; u.a = A + (size_t)pm * 256 * K * 2; u.b = Bt + (size_t)pp * 256 * K * 2; return true;
    }
    __device__ __forceinline__ void rows(const Unit&, int, int, unsigned (&)[2], unsigned (&)[2]) const {}
};

template <class Epi, class Sched, bool ALIGN_EPI, bool GATHER>
__device__ __forceinline__ void gemm_phase(LAS unsigned char* lds, const int K, const Sched& S, const Epi& E) {
    int tid_ = threadIdx.x; asm volatile("" : "+v"(tid_));
    const int tid = tid_, wid = __builtin_amdgcn_readfirstlane(tid >> 6), lane = tid & 63, wr = wid >> 2, wc = wid & 3, fr = lane & 15, fq = lane >> 4;
    const int nt = K / BK;
    unsigned voffA[2], voffB[2]; int stR = 0, stC = 0;
#pragma unroll
    for (int i = 0; i < 2; ++i) { int R, C; stage_rc(tid * 16 + i * 8192, R, C); const int Rb = Epi::PERM ? ((R & ~31) + perm32(R & 31)) : R;
        voffA[i] = (unsigned)(R * K + C) * 2u; voffB[i] = (unsigned)(Rb * K + C) * 2u; if (i == 0) { stR = R; stC = C; } }
    const size_t kstep = (size_t)(BK * 2);
    const size_t hstep = (size_t)HALF * K * 2;
    const unsigned ldsw = (unsigned)wid * 1024u;
    const int aoff = lds_byte(wr * 64 + fr, fq * 8), boff = lds_byte(wc * 32 + fr, fq * 8);
    unsigned ga0[2] = {0u, 0u}, ga1[2] = {0u, 0u}, gn0[2] = {0u, 0u}, gn1[2] = {0u, 0u};
#define PG8_SA(b, h) (((b) * 2 + (h)) * HTB)
#define PG8_SB(b, h) ((4 + (b) * 2 + (h)) * HTB)
#define PG8_STAGE(bufoff, gbase, voff) do { _Pragma("unroll") for (int _i = 0; _i < 2; ++_i) \
        __builtin_amdgcn_global_load_lds((const unsigned*)((const char*)(gbase) + (voff)[_i]), (LAS unsigned*)(lds + (bufoff) + ldsw + _i * 8192), 16, 0, 0); } while (0)
#define PG8_STAGE_A(bufoff, gbase, h, nx) do { if constexpr (GATHER) { if (nx) { if (h) PG8_STAGE(bufoff, gbase, gn1); else PG8_STAGE(bufoff, gbase, gn0); } else { if (h) PG8_STAGE(bufoff, gbase, ga1); else PG8_STAGE(bufoff, gbase, ga0); } } \
        else { PG8_STAGE(bufoff, (gbase) + (h) * hstep, voffA); } } while (0)
#define PG8_LDA(dst, b, h) do { _Pragma("unroll") for (int m = 0; m < 4; ++m) _Pragma("unroll") for (int k = 0; k < 2; ++k) dst[m][k] = *(const LAS bf16x8*)(lds + PG8_SA(b, h) + aoff + m * 2048 + k * 1024); } while (0)
#define PG8_LDB(dst, b, h) do { _Pragma("unroll") for (int n = 0; n < 2; ++n) _Pragma("unroll") for (int k = 0; k < 2; ++k) dst[n][k] = *(const LAS bf16x8*)(lds + PG8_SB(b, h) + boff + n * 2048 + k * 1024); } while (0)
#define PG8_MMA(ai, bj, At, Bt) do { __builtin_amdgcn_s_setprio(1); _Pragma("unroll") for (int m = 0; m < 4; ++m) _Pragma("unroll") for (int n = 0; n < 2; ++n) _Pragma("unroll") for (int k = 0; k < 2; ++k) \
        acc[ai][bj][m][n] = __builtin_amdgcn_mfma_f32_16x16x32_bf16(Bt[n][k], At[m][k], acc[ai][bj][m][n], 0, 0, 0); __builtin_amdgcn_s_setprio(0); } while (0)
#define PG8_WAIT_V(n) asm volatile("s_waitcnt vmcnt(" #n ")" ::: "memory")
#define PG8_WAIT_L(n) asm volatile("s_waitcnt lgkmcnt(" #n ")" ::: "memory")
#define PG8_BAR __builtin_amdgcn_s_barrier()
#define PG8_SCHED __builtin_amdgcn_sched_barrier(0)
    Unit cur, nxt; int ui = 0;
    if (!S.next(0, cur)) return;
    f32x4 acc[2][2][4][2];
#pragma unroll
    for (int a = 0; a < 2; ++a)
#pragma unroll
        for (int b = 0; b < 2; ++b)
#pragma unroll
            for (int m = 0; m < 4; ++m)
#pragma unroll
                for (int n = 0; n < 2; ++n) acc[a][b][m][n] = (f32x4){0.f, 0.f, 0.f, 0.f};
    bf16x8 At[4][2], B0[2][2], B1[2][2];
    const char* cA = cur.a; const char* cB = cur.b;
    if constexpr (GATHER) { S.rows(cur, stR, stC, ga0, ga1); }
    PG8_STAGE(PG8_SB(0, 0), cB, voffB); PG8_STAGE(PG8_SB(0, 1), cB + hstep, voffB); PG8_STAGE_A(PG8_SA(0, 0), cA, 0, false); PG8_STAGE_A(PG8_SA(0, 1), cA, 1, false);
    if (wr == 1) PG8_BAR;
    PG8_WAIT_V(2); PG8_BAR;
    PG8_STAGE(PG8_SB(1, 0), cB + kstep, voffB); PG8_STAGE_A(PG8_SA(1, 0), cA + kstep, 0, false); PG8_STAGE(PG8_SB(1, 1), cB + hstep + kstep, voffB);
    PG8_WAIT_V(6); PG8_BAR;
    for (;;) {
        const bool has_next = S.next(ui + 1, nxt);
        const char* nA = has_next ? nxt.a : cA; const char* nB = has_next ? nxt.b : cB;
        if constexpr (GATHER) { if (has_next) S.rows(nxt, stR, stC, gn0, gn1); else { gn0[0] = ga0[0]; gn0[1] = ga0[1]; gn1[0] = ga1[0]; gn1[1] = ga1[1]; } }
#pragma unroll 1
        for (int t = 0; t < nt; t += 2) {
            const bool last = (t == nt - 2);
            const char* a1 = cA + (size_t)(t + 1) * kstep;
            const char* a2 = last ? nA : cA + (size_t)(t + 2) * kstep; const char* b2 = last ? nB : cB + (size_t)(t + 2) * kstep;
            const char* a3 = a2 + kstep; const char* b3 = b2 + kstep;
            PG8_LDB(B0, 0, 0); PG8_LDB(B1, 0, 1); PG8_SCHED; PG8_LDA(At, 0, 0); PG8_STAGE_A(PG8_SA(1, 1), a1, 1, false);
            PG8_WAIT_V(8); PG8_WAIT_L(0); PG8_BAR; PG8_MMA(0, 0, At, B0); PG8_MMA(0, 1, At, B1); PG8_BAR; PG8_SCHED;
            PG8_LDA(At, 0, 1); PG8_STAGE(PG8_SB(0, 0), b2, voffB); PG8_STAGE(PG8_SB(0, 1), b2 + hstep, voffB); PG8_STAGE_A(PG8_SA(0, 0), a2, 0, last);
            PG8_WAIT_V(8); PG8_WAIT_L(0); PG8_BAR; PG8_MMA(1, 0, At, B0); PG8_MMA(1, 1, At, B1); PG8_BAR; PG8_SCHED;
            PG8_LDB(B0, 1, 0); PG8_LDB(B1, 1, 1); PG8_SCHED; PG8_LDA(At, 1, 0); PG8_STAGE_A(PG8_SA(0, 1), a2, 1, last);
            PG8_WAIT_V(8); PG8_WAIT_L(0); PG8_BAR; PG8_MMA(0, 0, At, B0); PG8_MMA(0, 1, At, B1); PG8_BAR; PG8_SCHED;
            PG8_LDA(At, 1, 1); PG8_STAGE(PG8_SB(1, 0), b3, voffB); PG8_STAGE(PG8_SB(1, 1), b3 + hstep, voffB); PG8_STAGE_A(PG8_SA(1, 0), a3, 0, last);
            PG8_WAIT_V(8); PG8_WAIT_L(0); PG8_BAR; PG8_MMA(1, 0, At, B0); PG8_MMA(1, 1, At, B1); PG8_BAR; PG8_SCHED;
        }
        if constexpr (ALIGN_EPI) { if (wr == 0) PG8_BAR; }
        E(acc, cur, wr, wc, fr, fq);
        if (!has_next) break;
#pragma unroll
        for (int a = 0; a < 2; ++a)
#pragma unroll
            for (int b = 0; b < 2; ++b)
#pragma unroll
                for (int m = 0; m < 4; ++m)
#pragma unroll
                    for (int n = 0; n < 2; ++n) acc[a][b][m][n] = (f32x4){0.f, 0.f, 0.f, 0.f};
        cur = nxt; cA = nA; cB = nB; ++ui;
        if constexpr (GATHER) { ga0[0] = gn0[0]; ga0[1] = gn0[1]; ga1[0] = gn1[0]; ga1[1] = gn1[1]; }
        if constexpr (ALIGN_EPI) { if (wr == 1) PG8_BAR; }
    }
    PG8_WAIT_V(0);
    if constexpr (!ALIGN_EPI) { if (wr == 0) PG8_BAR; }
    PG8_BAR;
#undef PG8_SA
#undef PG8_SB
#undef PG8_STAGE
#undef PG8_STAGE_A
#undef PG8_LDA
#undef PG8_LDB
#undef PG8_MMA
#undef PG8_WAIT_V
#undef PG8_WAIT_L
#undef PG8_BAR
#undef PG8_SCHED
}

__device__ __forceinline__ u32x4 pack8(const f32x4 v0, const f32x4 v1) { u32x4 w; w.x = cvt_pk_bf16(v0[0], v0[1]); w.y = cvt_pk_bf16(v0[2], v0[3]); w.z = cvt_pk_bf16(v1[0], v1[1]); w.w = cvt_pk_bf16(v1[2], v1[3]); return w; }

struct EpiPlain {
    static constexpr bool PERM = true;
    bf16_t* O; int ldc;
    __device__ __forceinline__ void operator()(const f32x4 (&acc)[2][2][4][2], const Unit& u, int wr, int wc, int fr, int fq) const {
        bf16_t* base = O + (size_t)u.pm * BM * ldc + u.pn * BM;
        const unsigned lo = (unsigned)((wr * 64 + fr) * ldc + wc * 32 + 8 * fq);
#pragma unroll
        for (int ai = 0; ai < 2; ++ai)
#pragma unroll
            for (int m = 0; m < 4; ++m)
#pragma unroll
                for (int bj = 0; bj < 2; ++bj) *(u32x4*)(base + (size_t)((ai * HALF + m * 16) * ldc + bj * HALF) + lo) = pack8(acc[ai][bj][m][0], acc[ai][bj][m][1]);
    }
};
struct EpiPre {
    static constexpr bool PERM = false;
    float* out; const bf16_t* xb; float alpha;
    __device__ __forceinline__ void operator()(const f32x4 (&acc)[2][2][4][2], const Unit& u, int wr, int wc, int fr, int fq) const {
        const size_t ub = (size_t)u.pm * BM * 2048 + u.pn * BM; float* ob = out + ub; const bf16_t* xbb = xb + ub;
        const unsigned lo = (unsigned)((wr * 64 + fr) * 2048 + wc * 32 + 4 * fq);
#pragma unroll
        for (int ai = 0; ai < 2; ++ai)
#pragma unroll
            for (int m = 0; m < 4; ++m)
#pragma unroll
                for (int bj = 0; bj < 2; ++bj)
#pragma unroll
                    for (int n = 0; n < 2; ++n) { const unsigned uo = (unsigned)((ai * HALF + m * 16) * 2048 + bj * HALF + n * 16);
                        const u32x2 xw = *(const u32x2*)(xbb + uo + lo);
                        f32x4 o; o[0] = alpha * bf_lo(xw.x) + acc[ai][bj][m][n][0]; o[1] = alpha * bf_hi(xw.x) + acc[ai][bj][m][n][1]; o[2] = alpha * bf_lo(xw.y) + acc[ai][bj][m][n][2]; o[3] = alpha * bf_hi(xw.y) + acc[ai][bj][m][n][3];
                        *(f32x4*)(ob + uo + lo) = o; }
    }
};
struct EpiCinN {
    static constexpr bool PERM = true;
    bf16_t* Q; bf16_t* Kt; bf16_t* G; const float* cs; const float* sn;
    __device__ __forceinline__ void operator()(const f32x4 (&acc)[2][2][4][2], const Unit& u, int wr, int wc, int fr, int fq) const {
        if (u.pn < 16) {
            bf16_t* base = (u.pn < 8 ? Q : Kt) + (size_t)u.pm * BM * 2048 + (u.pn & 7) * 256; const float sc = u.pn < 8 ? 1.0f : 0.0625f;
            const int i0 = wc * 32 + 8 * fq; const unsigned lo = (unsigned)((wr * 64 + fr) * 2048 + i0);
            const int s0 = ((u.pm * BM) & 4095) + wr * 64 + fr;
            const unsigned to = (unsigned)(s0 * 128 + i0);
#pragma unroll
            for (int ai = 0; ai < 2; ++ai)
#pragma unroll
                for (int m = 0; m < 4; ++m) { const unsigned tt = to + (unsigned)((ai * HALF + m * 16) * 128);
                    const f32x4 c0 = *(const f32x4*)(cs + tt), c1 = *(const f32x4*)(cs + tt + 4), s0v = *(const f32x4*)(sn + tt), s1v = *(const f32x4*)(sn + tt + 4);
                    const f32x4 x10 = acc[ai][0][m][0], x11 = acc[ai][0][m][1], x20 = acc[ai][1][m][0], x21 = acc[ai][1][m][1];
                    const f32x4 o10 = (x10 * c0 - x20 * s0v) * sc, o11 = (x11 * c1 - x21 * s1v) * sc, o20 = (x20 * c0 + x10 * s0v) * sc, o21 = (x21 * c1 + x11 * s1v) * sc;
                    bf16_t* rowp = base + (size_t)((ai * HALF + m * 16) * 2048) + lo;
                    *(u32x4*)(rowp) = pack8(o10, o11); *(u32x4*)(rowp + 128) = pack8(o20, o21); }
        } else {
            bf16_t* base = G + (size_t)u.pm * BM * 4096 + (u.pn - 16) * BM; const unsigned lo = (unsigned)((wr * 64 + fr) * 4096 + wc * 32 + 8 * fq);
#pragma unroll
            for (int ai = 0; ai < 2; ++ai)
#pragma unroll
                for (int m = 0; m < 4; ++m)
#pragma unroll
                    for (int bj = 0; bj < 2; ++bj) *(u32x4*)(base + (size_t)((ai * HALF + m * 16) * 4096 + bj * HALF) + lo) = pack8(acc[ai][bj][m][0], acc[ai][bj][m][1]);
        }
    }
};
struct EpiCinT {
    static constexpr bool PERM = true;
    bf16_t* O; const float* csT; const float* snT;
    __device__ __forceinline__ void operator()(const f32x4 (&acc)[2][2][4][2], const Unit& u, int wr, int wc, int fr, int fq) const {
        bf16_t* base = O + (size_t)u.pm * BM * 16384 + u.pn * BM; const unsigned lo = (unsigned)((wr * 64 + fr) * 16384 + wc * 32 + 8 * fq);
        if (u.pm < 8) {
            const unsigned to = (unsigned)((wr * 64 + fr) * 4096 + ((u.pn * BM) & 4095) + wc * 32 + 8 * fq);
#pragma unroll
            for (int m = 0; m < 4; ++m)
#pragma unroll
                for (int bj = 0; bj < 2; ++bj) { const unsigned tt = to + (unsigned)(m * 16 * 4096 + bj * HALF);
                    const f32x4 c0 = *(const f32x4*)(csT + tt), c1 = *(const f32x4*)(csT + tt + 4), s0 = *(const f32x4*)(snT + tt), s1 = *(const f32x4*)(snT + tt + 4);
                    const f32x4 x10 = acc[0][bj][m][0], x11 = acc[0][bj][m][1], x20 = acc[1][bj][m][0], x21 = acc[1][bj][m][1];
                    const f32x4 o10 = (x10 * c0 - x20 * s0) * 0.0625f, o11 = (x11 * c1 - x21 * s1) * 0.0625f, o20 = (x20 * c0 + x10 * s0) * 0.0625f, o21 = (x21 * c1 + x11 * s1) * 0.0625f;
                    *(u32x4*)(base + (size_t)(m * 16 * 16384 + bj * HALF) + lo) = pack8(o10, o11);
                    *(u32x4*)(base + (size_t)((HALF + m * 16) * 16384 + bj * HALF) + lo) = pack8(o20, o21); }
        } else {
#pragma unroll
            for (int ai = 0; ai < 2; ++ai)
#pragma unroll
                for (int m = 0; m < 4; ++m)
#pragma unroll
                    for (int bj = 0; bj < 2; ++bj) *(u32x4*)(base + (size_t)((ai * HALF + m * 16) * 16384 + bj * HALF) + lo) = pack8(acc[ai][bj][m][0], acc[ai][bj][m][1]);
        }
    }
};
struct EpiPle {
    static constexpr bool PERM = true;
    bf16_t* PLE; const bf16_t* PROJ; const float* bias; float* LOG;
    __device__ __forceinline__ void operator()(const f32x4 (&acc)[2][2][4][2], const Unit& u, int wr, int wc, int fr, int fq) const {
        if (u.pn < 8) {
            const size_t ub = (size_t)u.pm * BM * 2048 + u.pn * BM; bf16_t* pb = PLE + ub; const bf16_t* jb = PROJ + ub; const float* bb = bias + u.pn * BM;
            const unsigned lo = (unsigned)((wr * 64 + fr) * 2048 + wc * 32 + 8 * fq), lc = (unsigned)(wc * 32 + 8 * fq);
#pragma unroll
            for (int bj = 0; bj < 2; ++bj) { const f32x4 bv0 = *(const f32x4*)(bb + lc + bj * HALF), bv1 = *(const f32x4*)(bb + lc + bj * HALF + 4);
#pragma unroll
                for (int ai = 0; ai < 2; ++ai)
#pragma unroll
                    for (int m = 0; m < 4; ++m) { const unsigned uo = (unsigned)((ai * HALF + m * 16) * 2048 + bj * HALF); const u32x4 pw = *(const u32x4*)(jb + uo + lo);
                        f32x4 v0 = acc[ai][bj][m][0] + bv0, v1 = acc[ai][bj][m][1] + bv1;
                        v0[0] = sigmoidf_(v0[0]) * bf_lo(pw.x); v0[1] = sigmoidf_(v0[1]) * bf_hi(pw.x); v0[2] = sigmoidf_(v0[2]) * bf_lo(pw.y); v0[3] = sigmoidf_(v0[3]) * bf_hi(pw.y);
                        v1[0] = sigmoidf_(v1[0]) * bf_lo(pw.z); v1[1] = sigmoidf_(v1[1]) * bf_hi(pw.z); v1[2] = sigmoidf_(v1[2]) * bf_lo(pw.w); v1[3] = sigmoidf_(v1[3]) * bf_hi(pw.w);
                        *(u32x4*)(pb + uo + lo) = pack8(v0, v1); } }
        } else if (wc < 2) {
            float* lb = LOG + (size_t)u.pm * BM * 64; const unsigned lo = (unsigned)((wr * 64 + fr) * 64 + wc * 32 + 8 * fq);
#pragma unroll
            for (int ai = 0; ai < 2; ++ai)
#pragma unroll
                for (int m = 0; m < 4; ++m) { float* rowp = lb + (ai * HALF + m * 16) * 64 + lo;
                    *(f32x4*)(rowp) = acc[ai][0][m][0]; *(f32x4*)(rowp + 4) = acc[ai][0][m][1]; }
        }
    }
};
struct EpiGU {
    static constexpr bool PERM = true;
    bf16_t* HB;
    __device__ __forceinline__ void operator()(const f32x4 (&acc)[2][2][4][2], const Unit& u, int wr, int wc, int fr, int fq) const {
        bf16_t* base = HB + (size_t)u.pm * BM * 512 + u.pn * 128; const unsigned lo = (unsigned)((wr * 64 + fr) * 512 + wc * 32 + 8 * fq);
#pragma unroll
        for (int ai = 0; ai < 2; ++ai)
#pragma unroll
            for (int m = 0; m < 4; ++m) { f32x4 h0, h1;
#pragma unroll
                for (int j = 0; j < 4; ++j) { const float g0 = acc[ai][0][m][0][j], g1 = acc[ai][0][m][1][j]; h0[j] = g0 * sigmoidf_(g0) * acc[ai][1][m][0][j]; h1[j] = g1 * sigmoidf_(g1) * acc[ai][1][m][1][j]; }
                *(u32x4*)(base + (size_t)((ai * HALF + m * 16) * 512) + lo) = pack8(h0, h1); }
    }
};
}

namespace att {
constexpr int KVBLK = 64;
constexpr int SHM_V = 16384, SHM_K = 16384, SHM_P = 8192;
constexpr int OFF_V = 0, OFF_K = 2 * SHM_V, OFF_P = OFF_K + 2 * SHM_K, OFF_WS = OFF_P + 2 * SHM_P, OFF_BIAS = OFF_WS + 8 * 64 * 4, OFF_QPE = OFF_BIAS + 512 * 4, ATT_LDS = OFF_QPE + 256 * 128;
#define KSWZ(row, colB) ((row) * 256 + ((colB) ^ (((row) & 7) << 4)))
#define PSWZ(row, colB) ((row) * 128 + ((colB) ^ (((row) & 7) << 4)))
__device__ __forceinline__ int crow(int r, int hi) { return (r & 3) + 8 * (r >> 2) + 4 * hi; }

template <int MODE> struct Cfg;
template <> struct Cfg<0> { static constexpr int NQ = 8; static constexpr float SCALE = 0.07216878364870323f; static constexpr int LDQ = 1536, LDK = 2048, LDO = 2048; };
template <> struct Cfg<1> { static constexpr int NQ = 8;  static constexpr float SCALE = 0.08838834764831845f; static constexpr int LDQ = 4096, LDK = 4096, LDO = 2048; };
constexpr float THRN = 8.f;

template <int MODE>
__device__ __forceinline__ void partialSM(f32x16& p0, f32x16& p1, float& m_reg, float& mn, float& alpha) {
  constexpr float SCALE = Cfg<MODE>::SCALE; constexpr float C = SCALE * 1.4426950408889634f;
  float pmax = p0[0];
#pragma unroll
  for (int r = 1; r < 16; ++r) pmax = fmaxf(pmax, p0[r]);
#pragma unroll
  for (int r = 0; r < 16; ++r) pmax = fmaxf(pmax, p1[r]);
  { auto rr = __builtin_amdgcn_permlane32_swap(__float_as_uint(pmax), __float_as_uint(pmax), false, false);
    pmax = fmaxf(__uint_as_float(rr[0]), __uint_as_float(rr[1])); }
  if (__builtin_expect(__all(pmax - m_reg <= THRN / SCALE), 1)) { mn = m_reg; alpha = 1.f; }
  else { mn = fmaxf(m_reg, pmax); alpha = __builtin_amdgcn_exp2f((m_reg - mn) * C); m_reg = mn; }
  float mnC = -mn * C;
#pragma unroll
  for (int r = 0; r < 16; ++r) p0[r] = fmaf(p0[r], C, mnC);
#pragma unroll
  for (int r = 0; r < 16; ++r) p1[r] = fmaf(p1[r], C, mnC);
#pragma unroll
  for (int r = 0; r < 16; ++r) p0[r] = __builtin_amdgcn_exp2f(p0[r]);
}
__device__ __forceinline__ void finishSM(f32x16& p0, f32x16& p1, float alpha, float& l_reg, bf16x8& pa0, bf16x8& pa1, bf16x8& pa2, bf16x8& pa3) {
#pragma unroll
  for (int r = 0; r < 16; ++r) p1[r] = __builtin_amdgcn_exp2f(p1[r]);
  float ps = 0;
#pragma unroll
  for (int r = 0; r < 16; ++r) ps += p0[r];
#pragma unroll
  for (int r = 0; r < 16; ++r) ps += p1[r];
  { auto rr = __builtin_amdgcn_permlane32_swap(__float_as_uint(ps), __float_as_uint(ps), false, false);
    ps = __uint_as_float(rr[0]) + __uint_as_float(rr[1]); }
  l_reg = l_reg * alpha + ps;
#define PK4(P, BASE, OUT) do { unsigned a0 = cvt_pk_bf16(P[BASE + 0], P[BASE + 1]), a1 = cvt_pk_bf16(P[BASE + 2], P[BASE + 3]);   \
    unsigned b0 = cvt_pk_bf16(P[BASE + 4], P[BASE + 5]), b1 = cvt_pk_bf16(P[BASE + 6], P[BASE + 7]);                              \
    auto r0 = __builtin_amdgcn_permlane32_swap(a0, b0, false, false); auto r1 = __builtin_amdgcn_permlane32_swap(a1, b1, false, false); \
    u32x4 w = {r0[0], r1[0], r0[1], r1[1]}; OUT = *reinterpret_cast<bf16x8*>(&w); } while (0)
  PK4(p0, 0, pa0); PK4(p0, 8, pa1); PK4(p1, 0, pa2); PK4(p1, 8, pa3);
#undef PK4
}
template <int MODE>
__device__ __forceinline__ void qkt(f32x16& p0, f32x16& p1, const char* Ks, const char* Ps, const bf16x8* qr, const char* qpe, int r32, int hi) {
  p0 = f32x16{}; p1 = f32x16{};
#pragma unroll
  for (int d0 = 0; d0 < 8; ++d0) { int cb = (d0 * 16 + hi * 8) * 2;
    bf16x8 b0 = *reinterpret_cast<const bf16x8*>(Ks + KSWZ(r32, cb));
    bf16x8 b1 = *reinterpret_cast<const bf16x8*>(Ks + KSWZ(32 + r32, cb));
    p0 = __builtin_amdgcn_mfma_f32_32x32x16_bf16(b0, qr[d0], p0, 0, 0, 0);
    p1 = __builtin_amdgcn_mfma_f32_32x32x16_bf16(b1, qr[d0], p1, 0, 0, 0); }
  if constexpr (MODE == 0) {
#pragma unroll
    for (int d0 = 0; d0 < 4; ++d0) { int cb = (d0 * 16 + hi * 8) * 2;
      bf16x8 b0 = *reinterpret_cast<const bf16x8*>(Ps + PSWZ(r32, cb));
      bf16x8 b1 = *reinterpret_cast<const bf16x8*>(Ps + PSWZ(32 + r32, cb));
      const bf16x8 qp = *reinterpret_cast<const bf16x8*>(qpe + (cb ^ ((r32 & 7) << 4)));
      p0 = __builtin_amdgcn_mfma_f32_32x32x16_bf16(b0, qp, p0, 0, 0, 0);
      p1 = __builtin_amdgcn_mfma_f32_32x32x16_bf16(b1, qp, p1, 0, 0, 0); }
  }
}
__device__ __forceinline__ int v_st(int k, int c) { const int kk = (k & ~0xC) | ((k & 4) << 1) | ((k & 8) >> 1); return ((kk >> 3) * 4 + (c >> 5)) * 512 + ((kk & 7) * 32 + (c & 31)) * 2; }
__device__ __forceinline__ int v_rd_base(int lane) { return ((lane & 3) << 3) | (((lane >> 2) & 3) << 6) | (((lane >> 4) & 1) << 5) | (((lane >> 5) & 1) << 8); }
constexpr int v_rd_off(int d0, int ks, int half) { return d0 * 512 + ks * 4096 + half * 2048; }
template <int OFF> __device__ __forceinline__ s16x4 tr_read(int vb) {
  s16x4 r; asm volatile("ds_read_b64_tr_b16 %0, %1 offset:%2" : "=&v"(r) : "v"(vb), "i"(OFF) : "memory"); return r;
}
template <int D0> __device__ __forceinline__ void pv_one(f32x16& od, int vb, bf16x8 pa0, bf16x8 pa1, bf16x8 pa2, bf16x8 pa3) {
  const s16x4 l0 = tr_read<v_rd_off(D0, 0, 0)>(vb), h0 = tr_read<v_rd_off(D0, 0, 1)>(vb), l1 = tr_read<v_rd_off(D0, 1, 0)>(vb), h1 = tr_read<v_rd_off(D0, 1, 1)>(vb);
  const s16x4 l2 = tr_read<v_rd_off(D0, 2, 0)>(vb), h2 = tr_read<v_rd_off(D0, 2, 1)>(vb), l3 = tr_read<v_rd_off(D0, 3, 0)>(vb), h3 = tr_read<v_rd_off(D0, 3, 1)>(vb);
  asm volatile("s_waitcnt lgkmcnt(0)" ::: "memory"); SBAR();
#define PKV(L, H) (bf16x8){L[0], L[1], L[2], L[3], H[0], H[1], H[2], H[3]}
  od = __builtin_amdgcn_mfma_f32_32x32x16_bf16(pa0, PKV(l0, h0), od, 0, 0, 0);
  od = __builtin_amdgcn_mfma_f32_32x32x16_bf16(pa1, PKV(l1, h1), od, 0, 0, 0);
  od = __builtin_amdgcn_mfma_f32_32x32x16_bf16(pa2, PKV(l2, h2), od, 0, 0, 0);
  od = __builtin_amdgcn_mfma_f32_32x32x16_bf16(pa3, PKV(l3, h3), od, 0, 0, 0);
#undef PKV
}
__device__ __forceinline__ void pv_d0(f32x16* o, int vb, bf16x8 pa0, bf16x8 pa1, bf16x8 pa2, bf16x8 pa3) {
  pv_one<0>(o[0], vb, pa0, pa1, pa2, pa3); pv_one<1>(o[1], vb, pa0, pa1, pa2, pa3); pv_one<2>(o[2], vb, pa0, pa1, pa2, pa3); pv_one<3>(o[3], vb, pa0, pa1, pa2, pa3);
}
__device__ __forceinline__ void na_mask(f32x16& p0, f32x16& p1, const float* biasS, int kr, int rq, int cq, int hi) {
  const int rs = min(max(rq - 4, 0), 56), cs = min(max(cq - 8, 0), 48);
  const bool rowok = (kr >= rs) && (kr <= rs + 7);
  int lo = (rowok ? cs : 1000) - 4 * hi;
  int bidx = (kr - rq + 7) * 31 - cq + 15 + 4 * hi;
  asm volatile("" : "+v"(bidx), "+v"(lo));
  const float* bp = biasS + bidx;
#pragma unroll
  for (int r = 0; r < 16; ++r) {
    const int c0 = (r & 3) + 8 * (r >> 2), c1 = 32 + c0;
    const bool ok0 = (unsigned)(c0 - lo) < 16u, ok1 = (unsigned)(c1 - lo) < 16u;
    const float b0 = bp[c0], b1 = bp[c1];
    p0[r] = ok0 ? p0[r] + b0 : -3.0e38f; p1[r] = ok1 ? p1[r] + b1 : -3.0e38f;
  }
}

struct AttnArgs {
  const bf16* Qp;
  const bf16* Kp; const bf16* Vp;
  const bf16* Pp;
  bf16* Op;
  const float* cosM; const float* sinM;
  int s0;
  int NT;
  int kr0;
  int rg;
};

template <int MODE>
__device__ __forceinline__ void attn_item(const AttnArgs& A, char* lds) {
  constexpr int NQ = Cfg<MODE>::NQ, LDQ = Cfg<MODE>::LDQ, LDK = Cfg<MODE>::LDK, LDO = Cfg<MODE>::LDO;
  int tid_ = threadIdx.x; asm volatile("" : "+v"(tid_));
  const int tid = tid_, wid = tid >> 6, lane = tid & 63, r32 = lane & 31, hi = lane >> 5;
  char* V_lds = lds + OFF_V; char* K_lds = lds + OFF_K; char* P_lds = lds + OFF_P;
  float* ws = (float*)(lds + OFF_WS) + wid * 64; float* li_l = ws; float* al_l = ws + 32;
  const float* biasS = (const float*)(lds + OFF_BIAS);
  float m_reg = -1e30f, l_reg = 0; f32x16 o[4] = {}; bf16x8 qr[NQ];
  char* qpe_row = lds + OFF_QPE + (wid * 32 + r32) * 128;
  const bf16* Qw = A.Qp + (wid * 32 + r32) * LDQ + hi * 8;
#pragma unroll
  for (int d0 = 0; d0 < 8; ++d0) qr[d0] = *reinterpret_cast<const bf16x8*>(Qw + d0 * 16);
  if constexpr (MODE == 0) {
    const int s = A.s0 + wid * 32 + r32;
#pragma unroll
    for (int c = 0; c < 2; ++c) {
      const u32x4 x1 = *reinterpret_cast<const u32x4*>(Qw + (8 + c) * 16), x2 = *reinterpret_cast<const u32x4*>(Qw + (10 + c) * 16);
      const int i0 = c * 16 + hi * 8;
      const f32x4 ca = *(const f32x4*)(A.cosM + s * 32 + i0), cb = *(const f32x4*)(A.cosM + s * 32 + i0 + 4), sa = *(const f32x4*)(A.sinM + s * 32 + i0), sb = *(const f32x4*)(A.sinM + s * 32 + i0 + 4);
      float a[8], b[8], cc[8], ss[8];
      a[0] = bf_lo(x1.x); a[1] = bf_hi(x1.x); a[2] = bf_lo(x1.y); a[3] = bf_hi(x1.y); a[4] = bf_lo(x1.z); a[5] = bf_hi(x1.z); a[6] = bf_lo(x1.w); a[7] = bf_hi(x1.w);
      b[0] = bf_lo(x2.x); b[1] = bf_hi(x2.x); b[2] = bf_lo(x2.y); b[3] = bf_hi(x2.y); b[4] = bf_lo(x2.z); b[5] = bf_hi(x2.z); b[6] = bf_lo(x2.w); b[7] = bf_hi(x2.w);
#pragma unroll
      for (int j = 0; j < 4; ++j) { cc[j] = ca[j]; cc[4 + j] = cb[j]; ss[j] = sa[j]; ss[4 + j] = sb[j]; }
      float o1[8], o2[8];
#pragma unroll
      for (int j = 0; j < 8; ++j) { o1[j] = a[j] * cc[j] - b[j] * ss[j]; o2[j] = b[j] * cc[j] + a[j] * ss[j]; }
      u32x4 w1 = {cvt_pk_bf16(o1[0], o1[1]), cvt_pk_bf16(o1[2], o1[3]), cvt_pk_bf16(o1[4], o1[5]), cvt_pk_bf16(o1[6], o1[7])};
      u32x4 w2 = {cvt_pk_bf16(o2[0], o2[1]), cvt_pk_bf16(o2[2], o2[3]), cvt_pk_bf16(o2[4], o2[5]), cvt_pk_bf16(o2[6], o2[7])};
      *reinterpret_cast<u32x4*>(qpe_row + (((c * 16 + hi * 8) * 2) ^ ((r32 & 7) << 4))) = w1; *reinterpret_cast<u32x4*>(qpe_row + (((32 + c * 16 + hi * 8) * 2) ^ ((r32 & 7) << 4))) = w2;
    }
  }
  const int rq = A.rg * 4 + (wid >> 1), cq = 32 * (wid & 1) + r32;
  const int sr = tid >> 4, sc = (tid & 15) * 8, vst0 = v_st(sr, sc), vst1 = v_st(32 + sr, sc);
  const int pr = tid >> 3, pc = (tid & 7) * 8;
  const int vb0 = (int)(uintptr_t)V_lds + v_rd_base(lane);
  bf16x8 vs0, vs1, ks0, ks1, ps0;
  const int kvo0 = sr * LDK + sc, kvo1 = (32 + sr) * LDK + sc, po0 = pr * 64 + pc;
#define SLOAD(k0) do { const bf16* Vt = A.Vp + (size_t)(k0) * LDK; const bf16* Kt = A.Kp + (size_t)(k0) * LDK; \
    vs0 = *reinterpret_cast<const bf16x8*>(Vt + kvo0); vs1 = *reinterpret_cast<const bf16x8*>(Vt + kvo1); \
    ks0 = *reinterpret_cast<const bf16x8*>(Kt + kvo0); ks1 = *reinterpret_cast<const bf16x8*>(Kt + kvo1); \
    if constexpr (MODE == 0) ps0 = *reinterpret_cast<const bf16x8*>(A.Pp + (size_t)(k0) * 64 + po0); } while (0)
#define SWRITE(b) do { *(bf16x8*)(V_lds + (b) * SHM_V + vst0) = vs0; *(bf16x8*)(V_lds + (b) * SHM_V + vst1) = vs1; int kc = sc * 2; \
    *(bf16x8*)(K_lds + (b) * SHM_K + KSWZ(sr, kc)) = ks0; *(bf16x8*)(K_lds + (b) * SHM_K + KSWZ(32 + sr, kc)) = ks1; \
    if constexpr (MODE == 0) *(bf16x8*)(P_lds + (b) * SHM_P + PSWZ(pr, pc * 2)) = ps0; } while (0)
#define SWAIT() asm volatile("s_waitcnt vmcnt(0)" ::: "memory")
#define RESC(a) do { if (__any((a) < 1.f)) { if (hi == 0) al_l[r32] = (a); asm volatile("s_waitcnt lgkmcnt(0)" ::: "memory"); \
    _Pragma("unroll") for (int d = 0; d < 4; ++d) _Pragma("unroll") for (int r = 0; r < 16; ++r) o[d][r] *= al_l[crow(r, hi)]; } } while (0)
#define NAM(P0, P1, j) do { if constexpr (MODE == 1) na_mask(P0, P1, biasS, A.kr0 + (j), rq, cq, hi); } while (0)
  f32x16 pA0, pA1, pB0, pB1; float mnA, mnB, alA, alB; bf16x8 pa0, pa1, pa2, pa3; const int NT = A.NT;
  SLOAD(0); asm volatile("s_waitcnt vmcnt(0)" ::: "memory"); SWRITE(0); __syncthreads();
  qkt<MODE>(pA0, pA1, K_lds, P_lds, qr, qpe_row, r32, hi); NAM(pA0, pA1, 0); partialSM<MODE>(pA0, pA1, m_reg, mnA, alA);
  SLOAD(KVBLK);
  SWAIT(); SWRITE(1); __syncthreads();
  for (int j = 1; j + 1 < NT; j += 2) {
    SBAR(); qkt<MODE>(pB0, pB1, K_lds + SHM_K, P_lds + SHM_P, qr, qpe_row, r32, hi); NAM(pB0, pB1, j);
    finishSM(pA0, pA1, alA, l_reg, pa0, pa1, pa2, pa3); SBAR();
    SLOAD((j + 1) * KVBLK); SBAR();
    pv_d0(o, vb0, pa0, pa1, pa2, pa3); partialSM<MODE>(pB0, pB1, m_reg, mnB, alB);
    __syncthreads(); SWAIT(); SWRITE(0);
    RESC(alB); __syncthreads();
    SBAR(); qkt<MODE>(pA0, pA1, K_lds, P_lds, qr, qpe_row, r32, hi); NAM(pA0, pA1, j + 1);
    finishSM(pB0, pB1, alB, l_reg, pa0, pa1, pa2, pa3); SBAR();
    SLOAD((j + 2) * KVBLK); SBAR();
    pv_d0(o, vb0 + SHM_V, pa0, pa1, pa2, pa3); partialSM<MODE>(pA0, pA1, m_reg, mnA, alA);
    __syncthreads(); SWAIT(); SWRITE(1);
    RESC(alA); __syncthreads();
  }
  SBAR(); qkt<MODE>(pB0, pB1, K_lds + SHM_K, P_lds + SHM_P, qr, qpe_row, r32, hi); NAM(pB0, pB1, NT - 1);
  finishSM(pA0, pA1, alA, l_reg, pa0, pa1, pa2, pa3); SBAR();
  pv_d0(o, vb0, pa0, pa1, pa2, pa3); partialSM<MODE>(pB0, pB1, m_reg, mnB, alB);
  __syncthreads(); RESC(alB);
  finishSM(pB0, pB1, alB, l_reg, pa0, pa1, pa2, pa3); SBAR();
  pv_d0(o, vb0 + SHM_V, pa0, pa1, pa2, pa3);
  if (hi == 0) li_l[r32] = l_reg; asm volatile("s_waitcnt lgkmcnt(0)" ::: "memory");
  float rli[16];
#pragma unroll
  for (int r = 0; r < 16; ++r) rli[r] = __builtin_amdgcn_rcpf(li_l[crow(r, hi)]);
  bf16* Ow = A.Op + (wid * 32) * LDO + r32;
#pragma unroll
  for (int r = 0; r < 16; ++r) { const int orow = crow(r, hi);
#pragma unroll
    for (int d0 = 0; d0 < 4; ++d0) Ow[orow * LDO + d0 * 32] = f2bf(o[d0][r] * rli[r]); }
  __syncthreads();
#undef SLOAD
#undef SWRITE
#undef SWAIT
#undef RESC
#undef NAM
}
}

namespace ret {
constexpr int ST_PITCH = 528;
constexpr int OFF_VT = 0, VT_BYTES = 128 * 256, OFF_ST = 2 * VT_BYTES, ST_BYTES = 128 * ST_PITCH, RET_LDS = OFF_ST + ST_BYTES;
__device__ __forceinline__ int crow(int r, int hi) { return (r & 3) + 8 * (r >> 2) + 4 * hi; }

__device__ __forceinline__ void pprime_item(int item, const bf16* Qm, const bf16* Km, bf16* PP, const float* lg2f, const float* lg2b) {
  int tid_ = threadIdx.x; asm volatile("" : "+v"(tid_));
  const int tid = tid_, wid = tid >> 6, lane = tid & 63, r32 = lane & 31, hi = lane >> 5;
  const int bh = item >> 5, n = item & 31, b = bh >> 3, h = bh & 7;
  const int T0 = b * 4096 + n * 128;
  const int kb = wid >> 1, qb0 = 2 * (wid & 1);
  const bf16* Kr = Km + (size_t)(T0 + 32 * kb + r32) * 2048 + h * 256 + 8 * hi;
  const bf16* Q0 = Qm + (size_t)(T0 + 32 * qb0 + r32) * 2048 + h * 256 + 8 * hi;
  const bf16* Q1 = Q0 + (size_t)32 * 2048;
  f32x16 acc0 = {}, acc1 = {};
#pragma unroll 4
  for (int s = 0; s < 16; ++s) {
    const bf16x8 a = *reinterpret_cast<const bf16x8*>(Kr + 16 * s), b0 = *reinterpret_cast<const bf16x8*>(Q0 + 16 * s), b1 = *reinterpret_cast<const bf16x8*>(Q1 + 16 * s);
    acc0 = __builtin_amdgcn_mfma_f32_32x32x16_bf16(a, b0, acc0, 0, 0, 0);
    acc1 = __builtin_amdgcn_mfma_f32_32x32x16_bf16(a, b1, acc1, 0, 0, 0);
  }
  const float lf = lg2f[h], lb = lg2b[h];
  bf16* Pf = PP + ((size_t)(bh * 32 + n) * 128) * 128;
  bf16* Pb = Pf + (size_t)1024 * 128 * 128;
#pragma unroll
  for (int t = 0; t < 2; ++t) {
    const int q = 32 * (qb0 + t) + r32;
#pragma unroll
    for (int g = 0; g < 4; ++g) {
      const int k0 = 32 * kb + 8 * g + 4 * hi;
      float vf[4], vb[4];
#pragma unroll
      for (int j = 0; j < 4; ++j) { const int k = k0 + j; const float sc = t ? acc1[4 * g + j] : acc0[4 * g + j];
        vf[j] = (k <= q) ? sc * __builtin_amdgcn_exp2f(-lf * (float)(k + 1)) : 0.f;
        vb[j] = (k > q) ? sc * __builtin_amdgcn_exp2f(lb * (float)(k - 128)) : 0.f; }
      u32x2 wf = {cvt_pk_bf16(vf[0], vf[1]), cvt_pk_bf16(vf[2], vf[3])}, wb = {cvt_pk_bf16(vb[0], vb[1]), cvt_pk_bf16(vb[2], vb[3])};
      *reinterpret_cast<u32x2*>(Pf + (size_t)q * 128 + k0) = wf;
      *reinterpret_cast<u32x2*>(Pb + (size_t)q * 128 + k0) = wb;
    }
  }
}

__device__ __forceinline__ void chain_item(int item, const bf16* Qm, const bf16* KVT, const bf16* PP, bf16* Rf, bf16* Rb, const float* lg2f, const float* lg2b, char* lds) {
  int tid_ = threadIdx.x; asm volatile("" : "+v"(tid_));
  const int tid = tid_, wid = __builtin_amdgcn_readfirstlane(tid >> 6), lane = tid & 63, r32 = lane & 31, hi = lane >> 5;
  const int j = item & 3, dir = (item >> 2) & 1, bh = item >> 3, b = bh >> 3, h = bh & 7;
  const float lg2 = dir ? lg2b[h] : lg2f[h];
  const float cdec = __builtin_amdgcn_exp2f(lg2 * 128.f);
  bf16* Rout = dir ? Rb : Rf;
  const bf16* VTg = KVT + (size_t)(2048 + h * 512 + 128 * j) * 16384;
  const bf16* KTg = KVT + (size_t)(h * 256) * 16384;
  const bf16* PPd = PP + (size_t)dir * 1024 * 128 * 128 + (size_t)(bh * 32) * 128 * 128;
  char* STl = lds + OFF_ST;
  { unsigned z = 0u; asm volatile("" : "+v"(z));
    for (int i = tid; i < ST_BYTES / 16; i += 512) *reinterpret_cast<u32x4*>(STl + i * 16) = (u32x4){z, z, z, z}; }
  unsigned vsrc[4];
#pragma unroll
  for (int i = 0; i < 4; ++i) { const int v = 16 * wid + 4 * i + (lane >> 4); vsrc[i] = (unsigned)v * 32768u + (unsigned)(((lane & 15) ^ (v & 15)) * 16); }
#define VDMA(T0, buf) do { const char* vg = (const char*)(VTg + (T0)); _Pragma("unroll") for (int i = 0; i < 4; ++i) \
      __builtin_amdgcn_global_load_lds((const unsigned*)(vg + vsrc[i]), (LAS unsigned*)(ldsl + OFF_VT + (buf) * VT_BYTES + (4 * wid + i) * 1024), 16, 0, 0); } while (0)
  LAS unsigned char* ldsl = (LAS unsigned char*)lds;
  { const int n0 = dir ? 31 : 0; VDMA(b * 4096 + n0 * 128, 0); asm volatile("s_waitcnt vmcnt(0)" ::: "memory"); }
#define WGBAR() do { asm volatile("s_waitcnt lgkmcnt(0)" ::: "memory"); __builtin_amdgcn_s_barrier(); asm volatile("" ::: "memory"); } while (0)
  WGBAR();
  if (wid < 4) {
#ifndef RET_NO_Q
    const int qb = wid; int buf = 0;
    bf16x8 pf[8], qf[16];
    { const int n = dir ? 31 : 0; const int T0 = b * 4096 + n * 128;
      const bf16* Qr = Qm + (size_t)(T0 + 32 * qb + r32) * 2048 + h * 256 + 8 * hi; const bf16* Pr = PPd + ((size_t)n * 128 + 32 * qb + r32) * 128 + 8 * hi;
#pragma unroll
      for (int s = 0; s < 8; ++s) pf[s] = *reinterpret_cast<const bf16x8*>(Pr + 16 * s);
#pragma unroll
      for (int s = 0; s < 16; ++s) qf[s] = *reinterpret_cast<const bf16x8*>(Qr + 16 * s); }
    const int vrow = r32 * 256 + ((hi ^ (r32 & 1)) << 4), vx = (r32 & 14) << 4, srow = r32 * ST_PITCH + 16 * hi;
    for (int ci = 0; ci < 32; ++ci) {
      const int n = dir ? 31 - ci : ci; const int T0 = b * 4096 + n * 128;
      const int nn = dir ? n - 1 : n + 1; const int T1 = b * 4096 + nn * 128;
      if (ci < 31) VDMA(T1, buf ^ 1);
      const char* VTl = lds + OFF_VT + buf * VT_BYTES + vrow; const char* STr = STl + srow;
      f32x16 o[4];
#pragma unroll
      for (int v = 0; v < 4; ++v) o[v] = f32x16{};
      bf16x8 b0[4];
#define RB(dst, t) do { _Pragma("unroll") for (int v = 0; v < 4; ++v) dst[v] = ((t) < 8) ? *reinterpret_cast<const bf16x8*>(VTl + (32 * v) * 256 + ((32 * (t)) ^ vx)) : *reinterpret_cast<const bf16x8*>(STr + (32 * v) * ST_PITCH + 32 * ((t) - 8)); } while (0)
#define RA(t) (((t) < 8) ? pf[(t) & 7] : qf[((t) - 8) & 15])
#pragma unroll
      for (int t = 0; t < 24; ++t) {
        RB(b0, t);
#pragma unroll
        for (int v = 0; v < 4; ++v) o[v] = __builtin_amdgcn_mfma_f32_32x32x16_bf16(RA(t), b0[v], o[v], 0, 0, 0);
        SBAR();
        if (t == 7 && ci < 31) {
          const bf16* Pr = PPd + ((size_t)nn * 128 + 32 * qb + r32) * 128 + 8 * hi;
#pragma unroll
          for (int s = 0; s < 8; ++s) pf[s] = *reinterpret_cast<const bf16x8*>(Pr + 16 * s);
          SBAR(); }
      }
#undef RB
#undef RA
      if (ci < 31) {
        const bf16* Qr = Qm + (size_t)(T1 + 32 * qb + r32) * 2048 + h * 256 + 8 * hi;
#pragma unroll
        for (int s = 0; s < 16; ++s) qf[s] = *reinterpret_cast<const bf16x8*>(Qr + 16 * s); }
      WGBAR();
      float lgc = lg2; asm volatile("" : "+v"(lgc));
#pragma unroll
      for (int r = 0; r < 16; ++r) { const int q = 32 * qb + crow(r, hi);
        const float qd = __builtin_amdgcn_exp2f(dir ? lgc * (float)(128 - q) : lgc * (float)(q + 1));
        bf16* orow = Rout + (size_t)(T0 + q) * 4096 + h * 512 + 128 * j + r32;
#pragma unroll
        for (int v = 0; v < 4; ++v) orow[32 * v] = f2bf(o[v][r] * qd); }
      asm volatile("s_waitcnt vmcnt(0)" ::: "memory");
      WGBAR();
      buf ^= 1;
    }
#endif
  } else {
#ifndef RET_NO_S
    const int sw = wid - 4; int buf = 0;
    f32x16 st[2][4];
#pragma unroll
    for (int a = 0; a < 2; ++a)
#pragma unroll
      for (int v = 0; v < 4; ++v) st[a][v] = f32x16{};
    u32x4 kr0[8], kr1[8];
    const bf16* Kl = KTg + (size_t)(64 * sw + r32) * 16384 + 8 * hi;
    { const int n = dir ? 31 : 0; const bf16* K0 = Kl + b * 4096 + n * 128;
#pragma unroll
      for (int s = 0; s < 8; ++s) { kr0[s] = *reinterpret_cast<const u32x4*>(K0 + 16 * s); kr1[s] = *reinterpret_cast<const u32x4*>(K0 + (size_t)32 * 16384 + 16 * s); } }
    const int vrow = r32 * 256 + ((hi ^ (r32 & 1)) << 4), vx = (r32 & 14) << 4;
    for (int ci = 0; ci < 32; ++ci) {
      const int n = dir ? 31 - ci : ci;
      const int nn = dir ? n - 1 : n + 1; const int T1 = b * 4096 + nn * 128;
      if (ci < 31) VDMA(T1, buf ^ 1);
      const char* VTl = lds + OFF_VT + buf * VT_BYTES + vrow;
      float lgc = lg2; asm volatile("" : "+v"(lgc));
      const float hb = lgc * (float)(8 * hi);
#pragma unroll
      for (int s = 0; s < 8; ++s) {
        const u32x4 a0 = kr0[s], a1 = kr1[s];
        float kf[8];
#pragma unroll
        for (int e = 0; e < 8; ++e) kf[e] = __builtin_amdgcn_exp2f(dir ? (lgc * (float)(16 * s + e - 128) + hb) : -(lgc * (float)(16 * s + e + 1) + hb));
        u32x4 w0, w1;
        w0.x = cvt_pk_bf16(bf_lo(a0.x) * kf[0], bf_hi(a0.x) * kf[1]); w0.y = cvt_pk_bf16(bf_lo(a0.y) * kf[2], bf_hi(a0.y) * kf[3]); w0.z = cvt_pk_bf16(bf_lo(a0.z) * kf[4], bf_hi(a0.z) * kf[5]); w0.w = cvt_pk_bf16(bf_lo(a0.w) * kf[6], bf_hi(a0.w) * kf[7]);
        w1.x = cvt_pk_bf16(bf_lo(a1.x) * kf[0], bf_hi(a1.x) * kf[1]); w1.y = cvt_pk_bf16(bf_lo(a1.y) * kf[2], bf_hi(a1.y) * kf[3]); w1.z = cvt_pk_bf16(bf_lo(a1.z) * kf[4], bf_hi(a1.z) * kf[5]); w1.w = cvt_pk_bf16(bf_lo(a1.w) * kf[6], bf_hi(a1.w) * kf[7]);
        const bf16x8 f0 = __builtin_bit_cast(bf16x8, w0), f1 = __builtin_bit_cast(bf16x8, w1);
#pragma unroll
        for (int v = 0; v < 4; ++v) { const bf16x8 bv = *reinterpret_cast<const bf16x8*>(VTl + (32 * v) * 256 + ((32 * s) ^ vx));
          st[0][v] = __builtin_amdgcn_mfma_f32_32x32x16_bf16(f0, bv, st[0][v], 0, 0, 0);
          st[1][v] = __builtin_amdgcn_mfma_f32_32x32x16_bf16(f1, bv, st[1][v], 0, 0, 0); }
        SBAR();
      }
      if (ci < 31) { const bf16* K0 = Kl + T1;
#pragma unroll
        for (int s = 0; s < 8; ++s) { kr0[s] = *reinterpret_cast<const u32x4*>(K0 + 16 * s); kr1[s] = *reinterpret_cast<const u32x4*>(K0 + (size_t)32 * 16384 + 16 * s); } }
#pragma unroll
      for (int a = 0; a < 2; ++a)
#pragma unroll
        for (int v = 0; v < 4; ++v) st[a][v] = st[a][v] * cdec;
      WGBAR();
#pragma unroll
      for (int a = 0; a < 2; ++a)
#pragma unroll
        for (int v = 0; v < 4; ++v)
#pragma unroll
          for (int g = 0; g < 4; ++g) { const int d = 64 * sw + 32 * a + 8 * g + 4 * hi;
            u32x2 w = {cvt_pk_bf16(st[a][v][4 * g + 0], st[a][v][4 * g + 1]), cvt_pk_bf16(st[a][v][4 * g + 2], st[a][v][4 * g + 3])};
            *reinterpret_cast<u32x2*>(STl + (32 * v + r32) * ST_PITCH + d * 2) = w; }
      asm volatile("s_waitcnt vmcnt(0)" ::: "memory");
      WGBAR();
      buf ^= 1;
    }
#endif
  }
  WGBAR();
#undef WGBAR
#undef VDMA
}
}

#ifndef PHMASK
#define PHMASK 0xFFFFFFFFu
#endif
#define PH(k) ((PHMASK >> (k)) & 1u)
constexpr int NTOK = 16384, SEQ = 4096, DM = 2048, NWAVES = 8;
constexpr float DN_ALPHA = 1.4142135623730951f;
constexpr float LN_EPS = 1e-5f, RMS_EPS = 1e-6f;
constexpr size_t MiB = 1u << 20;
constexpr size_t WS_CTL = 0, CTL_ZERO_BYTES = 1 * MiB;
constexpr int CW_BAR = 4096;
constexpr int CW_CNT = 8192;
constexpr size_t WS_ABIN = 1 * MiB;
constexpr size_t WS_UQ   = 17 * MiB;
constexpr size_t WS_UKV  = WS_UQ + 1536 * 512 * 2;
constexpr size_t WS_ABOUT = WS_UKV + 2048 * 256 * 2;
constexpr size_t WS_CIN  = WS_ABOUT + 8 * MiB;
constexpr size_t WS_COUT = WS_CIN + 48 * MiB;
constexpr size_t WS_PLEG = WS_COUT + 16 * MiB;
constexpr size_t WS_PLEP = WS_PLEG + 18 * MiB;
constexpr size_t WS_TAB  = WS_PLEP + 2 * MiB;
constexpr size_t WS_PB   = WS_TAB + 10 * MiB;
constexpr size_t WS_GU   = WS_PB + 16 * MiB;
constexpr size_t WS_DN   = WS_GU + 128 * MiB;
constexpr size_t WS_XB   = WS_DN + 64 * MiB;
constexpr size_t WS_AR   = WS_XB + 64 * MiB;
static_assert(WS_AR == 393 * MiB + 512 * 1024, "map");
constexpr size_t A_H = WS_AR, A_Q = A_H + 128 * MiB, A_KV = A_Q + 48 * MiB, A_AO = A_KV + 64 * MiB, A_KPE = A_AO + 64 * MiB, A_CQN = A_KPE + 2 * MiB, A_CKVN = A_CQN + 16 * MiB;
constexpr size_t C_HB = WS_AR, C_PROJ = WS_AR + 128 * MiB, C_YB = C_PROJ + 64 * MiB, C_PLE = C_YB + 160 * MiB, C_LOG = C_PLE + 64 * MiB, C_RT = C_LOG + 4 * MiB;
static_assert(C_RT + 2 * MiB <= WS_AR + 704 * MiB, "arena");
constexpr size_t B_Q = WS_AR, B_KVT = B_Q + 64 * MiB, B_G = B_KVT + 192 * MiB, B_PP = B_G + 128 * MiB, B_K = B_PP + 64 * MiB, B_RF = B_K, B_RB = B_RF + 128 * MiB, B_A = WS_AR, WS_END = B_RB + 128 * MiB;
constexpr int MAXSLOT = 40960;
constexpr size_t RT_E = 0, RT_W = RT_E + 16384 * 8, RT_R = RT_W + 16384 * 8, RT_S = RT_R + 16384 * 8, RT_ST = RT_S + 16384 * 8;
constexpr int RING_BYTES = 143360, MISC_OFF = RING_BYTES, LDS_BYTES = 147456;
static_assert(ret::RET_LDS <= RING_BYTES && att::ATT_LDS <= RING_BYTES && pg8::STAGE_BYTES <= RING_BYTES, "LDS map");

struct Frame {
    LAS unsigned char* lds; volatile LAS unsigned* MISC; unsigned* ctl;
    int tid, lane, wave, vcu, G;
};
__device__ __forceinline__ unsigned long long ld_ptr(const Frame& F, int k) {
    volatile LAS unsigned* p = F.MISC + 256 + 2 * k; const unsigned lo = __builtin_amdgcn_readfirstlane(p[0]), hi = __builtin_amdgcn_readfirstlane(p[1]);
    return ((unsigned long long)hi << 32) | lo;
}
#define INP(k) ((const float*)(GAS const float*)ld_ptr(F, (k)))
#define WSB() ((unsigned char*)(GAS unsigned char*)ld_ptr(F, 28))
#define OUTP() ((float*)(GAS float*)ld_ptr(F, 27))
struct Args { const float* in[27]; float* out; unsigned char* ws; };

__device__ __forceinline__ void transpose_item(const float* W, int ldw, bf16* WT, int ldt, int k0, int n0, int dst_row0, LAS float* scr, int lane) {
#pragma unroll 8
    for (int i = 0; i < 32; ++i) { const int kk = 2 * i + (lane >> 5); scr[kk * 33 + (lane & 31)] = W[(size_t)(k0 + kk) * ldw + n0 + (lane & 31)]; }
    LDS_WAIT(); asm volatile("" ::: "memory");
    const int c = lane & 7;
#pragma unroll
    for (int j = 0; j < 4; ++j) { const int n = (lane >> 3) + 8 * j; const LAS float* s = scr + (8 * c) * 33 + n;
        v4u o; o.x = cvt_pk_bf16(s[0 * 33], s[1 * 33]); o.y = cvt_pk_bf16(s[2 * 33], s[3 * 33]); o.z = cvt_pk_bf16(s[4 * 33], s[5 * 33]); o.w = cvt_pk_bf16(s[6 * 33], s[7 * 33]);
        *(v4u*)(WT + (size_t)(dst_row0 + n) * ldt + k0 + 8 * c) = o; }
    LDS_WAIT(); asm volatile("" ::: "memory");
}
__device__ __forceinline__ void transpose_plain(const float* W, int K, int N, bf16* WT, int item, LAS float* scr, int lane) {
    const int nblk = N / 32, kb = item / nblk, nb = item % nblk;
    transpose_item(W, N, WT, K, 64 * kb, 32 * nb, 32 * nb, scr, lane);
}
__device__ __forceinline__ void moe_convert(const Frame& F, int lane, const float* wg, const float* wu, const float* wd, bf16* GU, bf16* DN) {
    LAS float* scr = (LAS float*)(F.lds + F.wave * 16384);
    const int gw = F.vcu * NWAVES + F.wave, NGW = F.G * NWAVES;
    for (int it = gw; it < 3 * 16384; it += NGW) {
        const int which = it >> 14, r = it & 16383, e = r >> 9, q = r & 511;
        if (which < 2) { const int kb = q >> 4, nb = q & 15, n0 = 32 * nb;
            transpose_item((which ? wu : wg) + (size_t)e * 2048 * 512, 512, GU, 2048, 64 * kb, n0, e * 1024 + (n0 >> 7) * 256 + (which ? 128 : 0) + (n0 & 127), scr, lane); }
        else { const int kb = q >> 6, nb = q & 63;
            transpose_item(wd + (size_t)e * 512 * 2048, 2048, DN, 512, 64 * kb, 32 * nb, e * 2048 + 32 * nb, scr, lane); }
    }
}
__device__ __forceinline__ void cvt_rows(const Frame& F, int tid, const float* src, bf16* dst, size_t n8) {
    for (size_t i = (size_t)(F.vcu * 512 + tid); i < n8; i += (size_t)F.G * 512) {
        const f32x4 a = *(const f32x4*)(src + i * 8), b = *(const f32x4*)(src + i * 8 + 4);
        *(u32x4*)(dst + i * 8) = pg8::pack8(a, b); }
}
__device__ __forceinline__ void sincos_acc(int pos, float inv, float& c, float& s) {
    const double a = (double)pos * (double)inv; const double k = __builtin_rint(a * 0.15915494309189535); const float r = (float)(a - k * 6.283185307179586);
    s = sinf(r); c = cosf(r);
}

#define x_in INP(0)
#define p_in INP(1)
#define ab_w_in INP(2)
#define ab_rpb INP(3)
#define ab_q_norm INP(4)
#define ab_w_uq INP(5)
#define ab_kv_norm INP(6)
#define ab_w_ukv INP(7)
#define ab_w_out INP(8)
#define c_w_in INP(9)
#define c_lrf INP(10)
#define c_lrb INP(11)
#define c_w_out INP(12)
#define ln1_g INP(13)
#define ln1_b INP(14)
#define moe_w_group INP(15)
#define moe_b_group INP(16)
#define moe_w_router INP(17)
#define moe_b_router INP(18)
#define moe_w_gate INP(19)
#define moe_w_up INP(20)
#define moe_w_down INP(21)
#define ple_w_proj INP(22)
#define ple_w_gate INP(23)
#define ple_b_gate INP(24)
#define ln2_g INP(25)
#define ln2_b INP(26)
#define W_ABIN ((bf16*)(WSB() + WS_ABIN))
#define W_UQ ((bf16*)(WSB() + WS_UQ))
#define W_UKV ((bf16*)(WSB() + WS_UKV))
#define W_ABOUT ((bf16*)(WSB() + WS_ABOUT))
#define W_CIN ((bf16*)(WSB() + WS_CIN))
#define W_COUT ((bf16*)(WSB() + WS_COUT))
#define W_PLEG ((bf16*)(WSB() + WS_PLEG))
#define W_PLEP ((bf16*)(WSB() + WS_PLEP))
#define T_COSM ((float*)(WSB() + WS_TAB))
#define T_SINM (T_COSM + 4096 * 32)
#define T_COSR (T_COSM + 2 * 4096 * 32)
#define T_SINR (T_COSR + 4096 * 128)
#define T_COSRT (T_COSR + 2 * 4096 * 128)
#define T_SINRT (T_COSR + 3 * 4096 * 128)
#define T_LG (T_COSR + 4 * 4096 * 128)
#define PB ((bf16*)(WSB() + WS_PB))
#define W_GU ((bf16*)(WSB() + WS_GU))
#define W_DN ((bf16*)(WSB() + WS_DN))
#define XB ((bf16*)(WSB() + WS_XB))
#define PRE OUTP()
#define H ((bf16*)(WSB() + A_H))
#define Qb ((bf16*)(WSB() + A_Q))
#define KVb ((bf16*)(WSB() + A_KV))
#define AO ((bf16*)(WSB() + A_AO))
#define KPE ((bf16*)(WSB() + A_KPE))
#define CQN ((bf16*)(WSB() + A_CQN))
#define CKVN ((bf16*)(WSB() + A_CKVN))
#define Qm ((bf16*)(WSB() + B_Q))
#define KVT ((bf16*)(WSB() + B_KVT))
#define Gm ((bf16*)(WSB() + B_G))
#define PP ((bf16*)(WSB() + B_PP))
#define Km ((bf16*)(WSB() + B_K))
#define Rf ((bf16*)(WSB() + B_RF))
#define Rb ((bf16*)(WSB() + B_RB))
#define Am ((bf16*)(WSB() + B_A))
#define PROJ ((bf16*)(WSB() + C_PROJ))
#define HB ((bf16*)(WSB() + C_HB))
#define YB ((bf16*)(WSB() + C_YB))
#define PLE ((bf16*)(WSB() + C_PLE))
#define LOG ((float*)(WSB() + C_LOG))
#define TOK_E ((int*)(WSB() + C_RT + RT_E))
#define TOK_W ((float*)(WSB() + C_RT + RT_W))
#define TOK_R ((int*)(WSB() + C_RT + RT_R))
#define TOK_S ((int*)(WSB() + C_RT + RT_S))
#define SLOT_TOK ((int*)(WSB() + C_RT + RT_ST))
__global__ void __launch_bounds__(512, 2) fwd_kernel(Args args) {
    extern __shared__ __attribute__((aligned(16))) unsigned char lds[];
    Frame F;
    F.lds = (LAS unsigned char*)lds; F.MISC = (volatile LAS unsigned*)(F.lds + MISC_OFF);
    F.tid = threadIdx.x; F.lane = F.tid & 63; F.wave = __builtin_amdgcn_readfirstlane(F.tid >> 6);
    F.G = gridDim.x; { const int bx = blockIdx.x; F.vcu = (F.G % 8 == 0) ? (bx % 8) * (F.G / 8) + bx / 8 : bx; }
    F.ctl = (unsigned*)(args.ws + WS_CTL);
    for (int u = F.tid; u < (LDS_BYTES - MISC_OFF) / 4; u += 512) ((LAS unsigned*)(F.lds + MISC_OFF))[u] = 0u;
    __syncthreads();
    if (F.tid == 0) {
#pragma unroll
        for (int i = 0; i < 27; ++i) { const unsigned long long v = (unsigned long long)args.in[i]; F.MISC[256 + 2 * i] = (unsigned)v; F.MISC[257 + 2 * i] = (unsigned)(v >> 32); }
        { const unsigned long long v = (unsigned long long)args.out; F.MISC[256 + 54] = (unsigned)v; F.MISC[257 + 54] = (unsigned)(v >> 32); }
        { const unsigned long long v = (unsigned long long)args.ws; F.MISC[256 + 56] = (unsigned)v; F.MISC[257 + 56] = (unsigned)(v >> 32); }
    }
    __syncthreads();
    XcdBarrier bar = xcd_barrier_post(F.ctl + CW_BAR, F.MISC + 8);
    const int gw = F.vcu * NWAVES + F.wave, NGW = F.G * NWAVES;
    char* ldsg = (char*)lds;


        if (PH(0)) {
        int tid_o = threadIdx.x; asm volatile("" : "+v"(tid_o)); const int ptid = tid_o, plane = tid_o & 63; (void)ptid; (void)plane; int gwp = gw; asm volatile("" : "+s"(gwp)); (void)gwp;
    {
        LAS float* scr = (LAS float*)(F.lds + F.wave * 16384);
        constexpr int I_ABIN = 32 * 122, I_UQ = 8 * 48, I_UKV = 4 * 64, I_ABOUT = 32 * 64, I_CIN = 32 * 384, I_COUT = 64 * 64, I_PLEG = 32 * 64, I_PLEP = 4 * 64;
        constexpr int NIT = I_ABIN + I_UQ + I_UKV + I_ABOUT + I_CIN + I_COUT + 2 * I_PLEG + 2 * I_PLEP;
        for (int it = gwp; it < NIT; it += NGW) {
            int r = it;
            if (r < I_ABIN) { transpose_plain(ab_w_in, 2048, 3904, W_ABIN, r, scr, plane); continue; } r -= I_ABIN;
            if (r < I_UQ) { transpose_plain(ab_w_uq, 512, 1536, W_UQ, r, scr, plane); continue; } r -= I_UQ;
            if (r < I_UKV) { transpose_plain(ab_w_ukv, 256, 2048, W_UKV, r, scr, plane); continue; } r -= I_UKV;
            if (r < I_ABOUT) { transpose_plain(ab_w_out, 2048, 2048, W_ABOUT, r, scr, plane); continue; } r -= I_ABOUT;
            if (r < I_CIN) { transpose_plain(c_w_in, 2048, 12288, W_CIN, r, scr, plane); continue; } r -= I_CIN;
            if (r < I_COUT) { transpose_plain(c_w_out, 4096, 2048, W_COUT, r, scr, plane); continue; } r -= I_COUT;
            if (r < 2 * I_PLEG) { const int L = r / I_PLEG; transpose_plain(ple_w_gate + (size_t)L * 2048 * 2048, 2048, 2048, W_PLEG + (size_t)L * 2304 * 2048, r % I_PLEG, scr, plane); continue; } r -= 2 * I_PLEG;
            { const int L = r / I_PLEP; transpose_plain(ple_w_proj + (size_t)L * 256 * 2048, 256, 2048, W_PLEP + (size_t)L * 2048 * 256, r % I_PLEP, scr, plane); }
        }
        moe_convert(F, plane, moe_w_gate, moe_w_up, moe_w_down, W_GU, W_DN);
        const size_t gt = (size_t)F.vcu * 512 + ptid, GT = (size_t)F.G * 512;
        for (size_t i = gt; i < (size_t)192 * 2048 / 8; i += GT) *(u32x4*)(W_ABIN + (size_t)3904 * 2048 + i * 8) = (u32x4){0u, 0u, 0u, 0u};
        for (size_t i = gt; i < (size_t)2 * 220 * 2048 / 8; i += GT) { const size_t L = i / (220 * 2048 / 8), r = i % (220 * 2048 / 8); *(u32x4*)(W_PLEG + (L * 2304 + 2084) * 2048 + r * 8) = (u32x4){0u, 0u, 0u, 0u}; }
        for (size_t i = gt; i < (size_t)2 * 36 * 2048; i += GT) { const int L = (int)(i / (36 * 2048)), r = (int)(i % (36 * 2048)), row = r / 2048, k = r % 2048;
            const float v = row < 4 ? moe_w_group[((size_t)L * 2048 + k) * 4 + row] : moe_w_router[(((size_t)L * 4 + ((row - 4) >> 3)) * 2048 + k) * 8 + ((row - 4) & 7)];
            W_PLEG[((size_t)L * 2304 + 2048 + row) * 2048 + k] = f2bf(v); }
        cvt_rows(F, ptid, x_in, XB, (size_t)NTOK * DM / 8);
        cvt_rows(F, ptid, p_in, PB, (size_t)2 * NTOK * 256 / 8);
        for (size_t i = gt; i < (size_t)4096 * 32; i += GT) { const int s = (int)(i >> 5), f = (int)(i & 31); float c, sn; sincos_acc(s, expf((float)(2 * f) * (-9.210340371976184f / 64.f)), c, sn); T_COSM[i] = c; T_SINM[i] = sn; }
        for (size_t i = gt; i < (size_t)4096 * 128; i += GT) { const int s = (int)(i >> 7), f = (int)(i & 127); float c, sn; sincos_acc(s, expf((float)(2 * f) * (-9.210340371976184f / 256.f)), c, sn);
            T_COSR[i] = c; T_SINR[i] = sn; T_COSRT[(size_t)f * 4096 + s] = c; T_SINRT[(size_t)f * 4096 + s] = sn; }
        if (gt < 16) { const float lr = gt < 8 ? c_lrf[gt] : c_lrb[gt - 8]; T_LG[gt] = log1pf(-expf(lr)) * 1.4426950408889634f; }
    }
        }
    xcd_barrier(bar);

#pragma unroll 1
    for (int L = 0; L < 2; ++L) {
        if (L == 0) {
        if (PH(1)) {
        int tid_o = threadIdx.x; asm volatile("" : "+v"(tid_o)); const int ptid = tid_o, plane = tid_o & 63; (void)ptid; (void)plane; int gwp = gw; asm volatile("" : "+s"(gwp)); (void)gwp;
            { pg8::DenseOrder S{(const char*)XB, (const char*)W_ABIN, 2048, 64, 16, F.G, (int)blockIdx.x, 1 << 30, 0}; pg8::EpiPlain E{H, 4096};
              pg8::gemm_phase<pg8::EpiPlain, pg8::DenseOrder, true, false>(F.lds, 2048, S, E); }
        }
            xcd_barrier(bar);
        if (PH(2)) {
        int tid_o = threadIdx.x; asm volatile("" : "+v"(tid_o)); const int ptid = tid_o, plane = tid_o & 63; (void)ptid; (void)plane; int gwp = gw; asm volatile("" : "+s"(gwp)); (void)gwp;
            for (int m = gwp; m < NTOK; m += NGW) {
                const bf16* hr = H + (size_t)m * 4096;
                { const u32x4 w = *(const u32x4*)(hr + 3072 + 8 * plane); float v[8] = {bf_lo(w.x), bf_hi(w.x), bf_lo(w.y), bf_hi(w.y), bf_lo(w.z), bf_hi(w.z), bf_lo(w.w), bf_hi(w.w)};
                  float ss = 0.f;
#pragma unroll
                  for (int j = 0; j < 8; ++j) ss += v[j] * v[j];
                  const float rs = 1.0f / sqrtf(wave_sum(ss, plane) * (1.f / 512.f) + RMS_EPS);
                  const f32x4 g0 = *(const f32x4*)(ab_q_norm + 8 * plane), g1 = *(const f32x4*)(ab_q_norm + 8 * plane + 4);
                  const f32x4 o0 = {v[0] * rs * g0[0], v[1] * rs * g0[1], v[2] * rs * g0[2], v[3] * rs * g0[3]}, o1 = {v[4] * rs * g1[0], v[5] * rs * g1[1], v[6] * rs * g1[2], v[7] * rs * g1[3]};
                  *(u32x4*)(CQN + (size_t)m * 512 + 8 * plane) = pg8::pack8(o0, o1); }
                { const u32x2 w = *(const u32x2*)(hr + 3584 + 4 * plane); float v[4] = {bf_lo(w.x), bf_hi(w.x), bf_lo(w.y), bf_hi(w.y)};
                  const float ss = v[0] * v[0] + v[1] * v[1] + v[2] * v[2] + v[3] * v[3];
                  const float rs = 1.0f / sqrtf(wave_sum(ss, plane) * (1.f / 256.f) + RMS_EPS);
                  const f32x4 g0 = *(const f32x4*)(ab_kv_norm + 4 * plane);
                  u32x2 o; o.x = cvt_pk_bf16(v[0] * rs * g0[0], v[1] * rs * g0[1]); o.y = cvt_pk_bf16(v[2] * rs * g0[2], v[3] * rs * g0[3]);
                  *(u32x2*)(CKVN + (size_t)m * 256 + 4 * plane) = o; }
                { const int i = plane & 31, s = m & 4095; const float x1 = bf2f(hr[3840 + i]), x2 = bf2f(hr[3872 + i]); const float c = T_COSM[s * 32 + i], sn = T_SINM[s * 32 + i];
                  KPE[(size_t)m * 64 + plane] = f2bf(plane < 32 ? x1 * c - x2 * sn : x2 * c + x1 * sn); }
            }
        }
            xcd_barrier(bar);
        if (PH(3)) {
        int tid_o = threadIdx.x; asm volatile("" : "+v"(tid_o)); const int ptid = tid_o, plane = tid_o & 63; (void)ptid; (void)plane; int gwp = gw; asm volatile("" : "+s"(gwp)); (void)gwp;
            { pg8::DenseOrder S{(const char*)CQN, (const char*)W_UQ, 512, 64, 6, F.G, (int)blockIdx.x, 1 << 30, 0}; pg8::EpiPlain E{Qb, 1536};
              pg8::gemm_phase<pg8::EpiPlain, pg8::DenseOrder, true, false>(F.lds, 512, S, E); }
            { pg8::DenseOrder S{(const char*)CKVN, (const char*)W_UKV, 256, 64, 8, F.G, (int)blockIdx.x, 1 << 30, 0}; pg8::EpiPlain E{KVb, 2048};
              pg8::gemm_phase<pg8::EpiPlain, pg8::DenseOrder, true, false>(F.lds, 256, S, E); }
        }
            xcd_barrier(bar);
        if (PH(4)) {
        int tid_o = threadIdx.x; asm volatile("" : "+v"(tid_o)); const int ptid = tid_o, plane = tid_o & 63; (void)ptid; (void)plane; int gwp = gw; asm volatile("" : "+s"(gwp)); (void)gwp;
            if (PH(20)) for (int it = F.vcu; it < 512; it += F.G) {
                const int bh = it >> 4, qb = it & 15, b = bh >> 3, h = bh & 7; const size_t t0 = (size_t)b * 4096 + qb * 256;
                att::AttnArgs A; A.Qp = Qb + t0 * 1536 + h * 192; A.Kp = KVb + (size_t)b * 4096 * 2048 + h * 256; A.Vp = A.Kp + 128;
                A.Pp = KPE + (size_t)b * 4096 * 64; A.Op = AO + t0 * 2048 + 1024 + h * 128; A.cosM = T_COSM; A.sinM = T_SINM; A.s0 = qb * 256; A.NT = 64; A.kr0 = 0; A.rg = 0;
                att::attn_item<0>(A, ldsg);
            }
            if (PH(21)) for (int it = F.vcu; it < 512; it += F.G) {
                const int bh = it >> 4, rg = it & 15, b = bh >> 3, h = bh & 7; const size_t t0 = (size_t)b * 4096 + rg * 256;
                int klo = min(max(4 * rg - 4, 0), 56), khi = min(max(4 * rg - 1, 0), 56) + 7;
                if ((khi - klo + 1) & 1) { if (khi < 63) ++khi; else --klo; }
                for (int i = ptid; i < 465; i += 512) ((float*)(ldsg + att::OFF_BIAS))[i] = ab_rpb[h * 465 + i] * 11.313708498984761f;
                att::AttnArgs A; A.Qp = H + t0 * 4096 + h * 128; A.Kp = H + ((size_t)b * 4096 + klo * 64) * 4096 + 1024 + h * 128; A.Vp = A.Kp + 1024;
                A.Pp = nullptr; A.Op = AO + t0 * 2048 + h * 128; A.cosM = nullptr; A.sinM = nullptr; A.s0 = 0; A.NT = khi - klo + 1; A.kr0 = klo; A.rg = rg;
                att::attn_item<1>(A, ldsg);
            }
        }
            xcd_barrier(bar);
        } else {
        if (PH(6)) {
        int tid_o = threadIdx.x; asm volatile("" : "+v"(tid_o)); const int ptid = tid_o, plane = tid_o & 63; (void)ptid; (void)plane; int gwp = gw; asm volatile("" : "+s"(gwp)); (void)gwp;
            { pg8::DenseOrder S{(const char*)XB, (const char*)W_CIN, 2048, 64, 32, F.G, (int)blockIdx.x, 16, 16}; pg8::EpiCinN E{Qm, Km, Gm, T_COSR, T_SINR};
              pg8::gemm_phase<pg8::EpiCinN, pg8::DenseOrder, true, false>(F.lds, 2048, S, E); }
            { pg8::DenseOrder S{(const char*)(W_CIN + (size_t)2048 * 2048), (const char*)XB, 2048, 24, 64, F.G, (int)blockIdx.x, 1 << 30, 0}; pg8::EpiCinT E{KVT, T_COSRT, T_SINRT};
              pg8::gemm_phase<pg8::EpiCinT, pg8::DenseOrder, true, false>(F.lds, 2048, S, E); }
        }
            xcd_barrier(bar);
        if (PH(7)) {
        int tid_o = threadIdx.x; asm volatile("" : "+v"(tid_o)); const int ptid = tid_o, plane = tid_o & 63; (void)ptid; (void)plane; int gwp = gw; asm volatile("" : "+s"(gwp)); (void)gwp;
            for (int it = F.vcu; it < 1024; it += F.G) ret::pprime_item(it, Qm, Km, PP, T_LG, T_LG + 8);
            __syncthreads();
            { int tid_q = threadIdx.x; asm volatile("" : "+v"(tid_q)); const int plane = tid_q & 63;
            moe_convert(F, plane, moe_w_gate + (size_t)32 * 2048 * 512, moe_w_up + (size_t)32 * 2048 * 512, moe_w_down + (size_t)32 * 512 * 2048, W_GU, W_DN); }
        }
            xcd_barrier(bar);
        if (PH(8)) {
        int tid_o = threadIdx.x; asm volatile("" : "+v"(tid_o)); const int ptid = tid_o, plane = tid_o & 63; (void)ptid; (void)plane; int gwp = gw; asm volatile("" : "+s"(gwp)); (void)gwp;
            for (int it = F.vcu; it < 256; it += F.G) ret::chain_item(it, Qm, KVT, PP, Rf, Rb, T_LG, T_LG + 8, ldsg);
        }
            xcd_barrier(bar);
        if (PH(9)) {
        int tid_o = threadIdx.x; asm volatile("" : "+v"(tid_o)); const int ptid = tid_o, plane = tid_o & 63; (void)ptid; (void)plane; int gwp = gw; asm volatile("" : "+s"(gwp)); (void)gwp;
            for (int u = gwp; u < NTOK * 8; u += NGW) {
                const size_t off = (size_t)(u >> 3) * 4096 + (u & 7) * 512 + 8 * plane;
                const u32x4 a = *(const u32x4*)(Rf + off), bq = *(const u32x4*)(Rb + off), gq = *(const u32x4*)(Gm + off);
                float r[8] = {bf_lo(a.x) + bf_lo(bq.x), bf_hi(a.x) + bf_hi(bq.x), bf_lo(a.y) + bf_lo(bq.y), bf_hi(a.y) + bf_hi(bq.y), bf_lo(a.z) + bf_lo(bq.z), bf_hi(a.z) + bf_hi(bq.z), bf_lo(a.w) + bf_lo(bq.w), bf_hi(a.w) + bf_hi(bq.w)};
                float g[8] = {bf_lo(gq.x), bf_hi(gq.x), bf_lo(gq.y), bf_hi(gq.y), bf_lo(gq.z), bf_hi(gq.z), bf_lo(gq.w), bf_hi(gq.w)};
                float s = 0.f;
#pragma unroll
                for (int j = 0; j < 8; ++j) s += r[j];
                const float mean = wave_sum(s, plane) * (1.f / 512.f); float s2 = 0.f;
#pragma unroll
                for (int j = 0; j < 8; ++j) { r[j] -= mean; s2 += r[j] * r[j]; }
                const float rstd = 1.0f / sqrtf(wave_sum(s2, plane) * (1.f / 512.f) + LN_EPS);
                f32x4 o0, o1;
#pragma unroll
                for (int j = 0; j < 4; ++j) { o0[j] = g[j] * sigmoidf_(g[j]) * r[j] * rstd; o1[j] = g[4 + j] * sigmoidf_(g[4 + j]) * r[4 + j] * rstd; }
                *(u32x4*)(Am + off) = pg8::pack8(o0, o1);
            }
        }
            xcd_barrier(bar);
        }
        unsigned* CNT = F.ctl + CW_CNT + L * 64;
        if (PH(5)) {
        { pg8::DenseOrder S{(const char*)(L ? Am : AO), (const char*)(L ? W_COUT : W_ABOUT), L ? 4096 : 2048, 64, 8, F.G, (int)blockIdx.x, 1 << 30, 0}; pg8::EpiPre E{PRE, XB, DN_ALPHA};
          pg8::gemm_phase<pg8::EpiPre, pg8::DenseOrder, true, false>(F.lds, L ? 4096 : 2048, S, E); }
        { pg8::DenseOrder S{(const char*)(PB + (size_t)L * NTOK * 256), (const char*)(W_PLEP + (size_t)L * 2048 * 256), 256, 64, 8, F.G, (int)blockIdx.x, 1 << 30, 0}; pg8::EpiPlain E{PROJ, 2048};
          pg8::gemm_phase<pg8::EpiPlain, pg8::DenseOrder, true, false>(F.lds, 256, S, E); }
        }
        xcd_barrier(bar);
        if (PH(11)) {
        { int tid_q = threadIdx.x; asm volatile("" : "+v"(tid_q)); const int plane = tid_q & 63; int gwp = gw; asm volatile("" : "+s"(gwp));
        for (int m = gwp; m < NTOK; m += NGW) {
            const f32x4* xr = (const f32x4*)(PRE + (size_t)m * DM) + plane; f32x4 v[8]; float s = 0.f;
#pragma unroll
            for (int j = 0; j < 8; ++j) { v[j] = xr[64 * j]; s += (v[j][0] + v[j][1]) + (v[j][2] + v[j][3]); }
            const float mean = wave_sum(s, plane) * (1.f / DM); float s2 = 0.f;
#pragma unroll
            for (int j = 0; j < 8; ++j) { v[j] = v[j] - mean; s2 += (v[j][0] * v[j][0] + v[j][1] * v[j][1]) + (v[j][2] * v[j][2] + v[j][3] * v[j][3]); }
            const float rstd = 1.0f / sqrtf(wave_sum(s2, plane) * (1.f / DM) + LN_EPS);
            const f32x4* gr = (const f32x4*)(ln1_g + L * DM) + plane; const f32x4* br = (const f32x4*)(ln1_b + L * DM) + plane;
            u32x2* o8 = (u32x2*)(XB + (size_t)m * DM) + plane;
#pragma unroll
            for (int j = 0; j < 8; ++j) { const f32x4 y = v[j] * rstd * gr[64 * j] + br[64 * j]; u32x2 w; w.x = cvt_pk_bf16(y[0], y[1]); w.y = cvt_pk_bf16(y[2], y[3]); o8[64 * j] = w; }
        } }
        }
        xcd_barrier(bar);
        if (PH(12)) {
        int tid_o = threadIdx.x; asm volatile("" : "+v"(tid_o)); const int ptid = tid_o, plane = tid_o & 63; (void)ptid; (void)plane; int gwp = gw; asm volatile("" : "+s"(gwp)); (void)gwp;
        { pg8::DenseOrder S{(const char*)XB, (const char*)(W_PLEG + (size_t)L * 2304 * 2048), 2048, 64, 9, F.G, (int)blockIdx.x, 1 << 30, 0}; pg8::EpiPle E{PLE, PROJ, ple_b_gate + L * DM, LOG};
          pg8::gemm_phase<pg8::EpiPle, pg8::DenseOrder, true, false>(F.lds, 2048, S, E); }
        }
        xcd_barrier(bar);
        if (PH(13)) {
        int tid_o = threadIdx.x; asm volatile("" : "+v"(tid_o)); const int ptid = tid_o, plane = tid_o & 63; (void)ptid; (void)plane; int gwp = gw; asm volatile("" : "+s"(gwp)); (void)gwp;
        for (int n = F.vcu * 512 + ptid; n < NTOK; n += F.G * 512) {
            const float* lg = LOG + (size_t)n * 64;
            float gl[4]; int gi = 0;
#pragma unroll
            for (int g = 0; g < 4; ++g) gl[g] = lg[g] + moe_b_group[L * 4 + g];
            float gm = gl[0];
#pragma unroll
            for (int g = 1; g < 4; ++g) if (gl[g] > gm) { gm = gl[g]; gi = g; }
            float gs = 0.f;
#pragma unroll
            for (int g = 0; g < 4; ++g) gs += expf(gl[g] - gm);
            const float pg = 1.0f / gs;
            float el[8];
#pragma unroll
            for (int e = 0; e < 8; ++e) el[e] = lg[4 + gi * 8 + e] + moe_b_router[(L * 4 + gi) * 8 + e];
            int i0 = 0; float m0 = el[0];
#pragma unroll
            for (int e = 1; e < 8; ++e) if (el[e] > m0) { m0 = el[e]; i0 = e; }
            int i1 = -1; float m1 = -3.0e38f;
#pragma unroll
            for (int e = 0; e < 8; ++e) if (e != i0 && el[e] > m1) { m1 = el[e]; i1 = e; }
            const float t1 = expf(m1 - m0), den = 1.0f / (1.0f + t1);
            const int e0 = gi * 8 + i0, e1 = gi * 8 + i1;
            const unsigned r0 = atomicAdd(CNT + e0, 1u), r1 = atomicAdd(CNT + e1, 1u);
            TOK_E[2 * n] = e0; TOK_E[2 * n + 1] = e1; TOK_W[2 * n] = pg * den; TOK_W[2 * n + 1] = pg * t1 * den; TOK_R[2 * n] = (int)r0; TOK_R[2 * n + 1] = (int)r1;
        }
        }
        xcd_barrier(bar);
        volatile LAS int* EOFF = (volatile LAS int*)(F.MISC + 16);
        if (PH(14)) {
        int tid_o = threadIdx.x; asm volatile("" : "+v"(tid_o)); const int ptid = tid_o, plane = tid_o & 63; (void)ptid; (void)plane; int gwp = gw; asm volatile("" : "+s"(gwp)); (void)gwp;
        if (ptid == 0) { int acc = 0; for (int e = 0; e < 32; ++e) { EOFF[e] = acc; const int c = (int)__hip_atomic_load(CNT + e, __ATOMIC_RELAXED, __HIP_MEMORY_SCOPE_AGENT); acc += (c + 255) & ~255; } EOFF[32] = acc; }
        __syncthreads();
        for (int n = F.vcu * 512 + ptid; n < NTOK; n += F.G * 512) {
#pragma unroll
            for (int k = 0; k < 2; ++k) { const int e = TOK_E[2 * n + k]; const int slot = EOFF[e] + TOK_R[2 * n + k]; SLOT_TOK[slot] = n; TOK_S[2 * n + k] = slot; }
        }
        for (int e = F.vcu; e < 32; e += F.G) { const int c = (int)__hip_atomic_load(CNT + e, __ATOMIC_RELAXED, __HIP_MEMORY_SCOPE_AGENT); const int pe = (c + 255) & ~255;
            for (int i = c + ptid; i < pe; i += 512) SLOT_TOK[EOFF[e] + i] = 0; }
        }
        xcd_barrier(bar);
        const int ntiles = EOFF[32] >> 8;
        if (PH(15)) {
        int tid_o = threadIdx.x; asm volatile("" : "+v"(tid_o)); const int ptid = tid_o, plane = tid_o & 63; (void)ptid; (void)plane; int gwp = gw; asm volatile("" : "+s"(gwp)); (void)gwp;
        {
            struct MoeGU { const char* A; const char* Bt; const int* slot_tok; volatile LAS int* eoff; int nun, G, c;
                __device__ __forceinline__ bool next(int i, pg8::Unit& u) const { const long Lq = (long)i * G + c; if (Lq >= nun) return false; const int t = (int)(Lq >> 2), pn = (int)(Lq & 3);
                    int e = 0;
#pragma unroll 1
                    for (int q = 1; q < 32; ++q) if (eoff[q] <= t * 256) e = q;
                    u.pm = t; u.pn = pn; u.a = A; u.b = Bt + ((size_t)e * 1024 + pn * 256) * 2048 * 2; return true; }
                __device__ __forceinline__ void rows(const pg8::Unit& u, int R, int C, unsigned (&o0)[2], unsigned (&o1)[2]) const {
                    int Ro = R; asm volatile("" : "+v"(Ro));
                    const int* st = slot_tok + u.pm * 256 + Ro;
                    o0[0] = (unsigned)st[0] * 4096u + (unsigned)C * 2u; o0[1] = (unsigned)st[64] * 4096u + (unsigned)C * 2u; o1[0] = (unsigned)st[128] * 4096u + (unsigned)C * 2u; o1[1] = (unsigned)st[192] * 4096u + (unsigned)C * 2u; }
            } S{(const char*)XB, (const char*)W_GU, SLOT_TOK, EOFF, ntiles * 4, F.G, F.vcu};
            pg8::EpiGU E{HB};
            pg8::gemm_phase<pg8::EpiGU, MoeGU, true, true>(F.lds, 2048, S, E);
        }
        }
        xcd_barrier(bar);
        if (PH(16)) {
        int tid_o = threadIdx.x; asm volatile("" : "+v"(tid_o)); const int ptid = tid_o, plane = tid_o & 63; (void)ptid; (void)plane; int gwp = gw; asm volatile("" : "+s"(gwp)); (void)gwp;
        {
            struct MoeDN { const char* A; const char* Bt; volatile LAS int* eoff; int nun, G, c;
                __device__ __forceinline__ bool next(int i, pg8::Unit& u) const { const long Lq = (long)i * G + c; if (Lq >= nun) return false; const int t = (int)(Lq >> 3), pn = (int)(Lq & 7);
                    int e = 0;
#pragma unroll 1
                    for (int q = 1; q < 32; ++q) if (eoff[q] <= t * 256) e = q;
                    u.pm = t; u.pn = pn; u.a = A + (size_t)t * 256 * 512 * 2; u.b = Bt + ((size_t)e * 2048 + pn * 256) * 512 * 2; return true; }
                __device__ __forceinline__ void rows(const pg8::Unit&, int, int, unsigned (&)[2], unsigned (&)[2]) const {}
            } S{(const char*)HB, (const char*)W_DN, EOFF, ntiles * 8, F.G, F.vcu};
            pg8::EpiPlain E{YB, 2048};
            pg8::gemm_phase<pg8::EpiPlain, MoeDN, true, false>(F.lds, 512, S, E);
        }
        }
        xcd_barrier(bar);
        if (PH(17)) {
        int tid_o = threadIdx.x; asm volatile("" : "+v"(tid_o)); const int ptid = tid_o, plane = tid_o & 63; (void)ptid; (void)plane; int gwp = gw; asm volatile("" : "+s"(gwp)); (void)gwp;
        for (int m = gwp; m < NTOK; m += NGW) {
            const int s0 = TOK_S[2 * m], s1 = TOK_S[2 * m + 1]; const float w0 = TOK_W[2 * m], w1 = TOK_W[2 * m + 1];
            const u32x4* xr = (const u32x4*)(XB + (size_t)m * DM) + plane; const u32x4* y0 = (const u32x4*)(YB + (size_t)s0 * DM) + plane; const u32x4* y1 = (const u32x4*)(YB + (size_t)s1 * DM) + plane;
            const u32x4* pr = (const u32x4*)(PLE + (size_t)m * DM) + plane;
            float v[4][8]; float s = 0.f;
#pragma unroll
            for (int j = 0; j < 4; ++j) { const u32x4 a = xr[64 * j], b0 = y0[64 * j], b1 = y1[64 * j], c = pr[64 * j];
                const unsigned aw[4] = {a.x, a.y, a.z, a.w}, b0w[4] = {b0.x, b0.y, b0.z, b0.w}, b1w[4] = {b1.x, b1.y, b1.z, b1.w}, cw[4] = {c.x, c.y, c.z, c.w};
#pragma unroll
                for (int q = 0; q < 4; ++q) { v[j][2 * q] = DN_ALPHA * bf_lo(aw[q]) + w0 * bf_lo(b0w[q]) + w1 * bf_lo(b1w[q]) + bf_lo(cw[q]); v[j][2 * q + 1] = DN_ALPHA * bf_hi(aw[q]) + w0 * bf_hi(b0w[q]) + w1 * bf_hi(b1w[q]) + bf_hi(cw[q]);
                    s += v[j][2 * q] + v[j][2 * q + 1]; } }
            const float mean = wave_sum(s, plane) * (1.f / DM); float s2 = 0.f;
#pragma unroll
            for (int j = 0; j < 4; ++j)
#pragma unroll
                for (int q = 0; q < 8; ++q) { v[j][q] -= mean; s2 += v[j][q] * v[j][q]; }
            const float rstd = 1.0f / sqrtf(wave_sum(s2, plane) * (1.f / DM) + LN_EPS);
            u32x4* ox = (u32x4*)(XB + (size_t)m * DM) + plane;
#pragma unroll
            for (int j = 0; j < 4; ++j) { const int c0 = 512 * j + 8 * plane;
                const f32x4 g0 = *(const f32x4*)(ln2_g + L * DM + c0), g1 = *(const f32x4*)(ln2_g + L * DM + c0 + 4), b0 = *(const f32x4*)(ln2_b + L * DM + c0), b1 = *(const f32x4*)(ln2_b + L * DM + c0 + 4);
                f32x4 y0v, y1v;
#pragma unroll
                for (int q = 0; q < 4; ++q) { y0v[q] = v[j][q] * rstd * g0[q] + b0[q]; y1v[q] = v[j][4 + q] * rstd * g1[q] + b1[q]; }
                if (L == 1) { *(f32x4*)(OUTP() + (size_t)m * DM + c0) = y0v; *(f32x4*)(OUTP() + (size_t)m * DM + c0 + 4) = y1v; }
                else ox[64 * j] = pg8::pack8(y0v, y1v); }
        }
        }
        if (L == 0) xcd_barrier(bar);
    }
}

extern "C" void kernel_launch(void* const* d_in, const int* in_sizes, int n_in, void* d_out, int out_size, void* d_ws, size_t ws_size, hipStream_t stream) {
    static int grid = 0;
    if (grid == 0) {
        if (n_in != 27 || out_size != NTOK * DM || ws_size < WS_END) { fprintf(stderr, "kernel_launch: unexpected shapes (n_in %d out %d ws %zu need %zu)\n", n_in, out_size, ws_size, (size_t)WS_END); grid = -1; return; }
        int dev = 0, cus = 0;
        if (hipGetDevice(&dev) != hipSuccess || hipDeviceGetAttribute(&cus, hipDeviceAttributeMultiprocessorCount, dev) != hipSuccess) { grid = -1; return; }
        if (hipFuncSetAttribute((const void*)fwd_kernel, hipFuncAttributeMaxDynamicSharedMemorySize, LDS_BYTES) != hipSuccess) { grid = -1; return; }
        grid = cus;
    }
    if (grid < 0) return;
    (void)hipMemsetAsync((char*)d_ws + WS_CTL, 0, CTL_ZERO_BYTES, stream);
    Args a{};
    for (int i = 0; i < 27; ++i) a.in[i] = (const float*)d_in[i];
    a.out = (float*)d_out; a.ws = (unsigned char*)d_ws;
    hipLaunchKernelGGL(fwd_kernel, dim3(grid), dim3(512), LDS_BYTES, stream, a);
}
```

```cpp
#include <hip/hip_runtime.h>
#include <cstdio>
#include <cstdint>

#define GAS __attribute__((address_space(1)))
#define LAS __attribute__((address_space(3)))
typedef unsigned short bf16;
typedef unsigned short bf16_t;
typedef short bf16x8 __attribute__((ext_vector_type(8)));
typedef short s16x4 __attribute__((ext_vector_type(4)));
typedef float f32x4 __attribute__((ext_vector_type(4)));
typedef float f32x2 __attribute__((ext_vector_type(2)));
typedef float f32x8 __attribute__((ext_vector_type(8)));
typedef float f32x16 __attribute__((ext_vector_type(16)));
typedef unsigned u32x4 __attribute__((ext_vector_type(4)));
typedef unsigned u32x2 __attribute__((ext_vector_type(2)));
typedef unsigned v4u __attribute__((ext_vector_type(4)));

#define LDS_WAIT() asm volatile("s_waitcnt lgkmcnt(0)" ::: "memory")
#define VM_WAIT() asm volatile("s_waitcnt vmcnt(0)" ::: "memory")
#define SBAR() __builtin_amdgcn_sched_barrier(0)

__device__ __forceinline__ unsigned cvt_pk_bf16(float lo, float hi) { unsigned r; asm volatile("v_cvt_pk_bf16_f32 %0, %1, %2" : "=v"(r) : "v"(lo), "v"(hi)); return r; }
__device__ __forceinline__ float bf_lo(unsigned w) { return __uint_as_float(w << 16); }
__device__ __forceinline__ float bf_hi(unsigned w) { return __uint_as_float(w & 0xffff0000u); }
__device__ __forceinline__ float bf2f(bf16 h) { return __uint_as_float(((unsigned)h) << 16); }
__device__ __forceinline__ bf16 f2bf(float f) { return (bf16)(cvt_pk_bf16(f, 0.f) & 0xffffu); }
__device__ __forceinline__ float dpp_add(float v, const int ctrl, const int row_mask) { return v; }
#define DPP_ADD(v, ctrl, rmask) ((v) + __int_as_float(__builtin_amdgcn_update_dpp(0, __float_as_int(v), (ctrl), (rmask), 0xF, false)))
__device__ __forceinline__ float wave_sum(float v, int) {
    v = DPP_ADD(v, 0xB1, 0xF);
    v = DPP_ADD(v, 0x4E, 0xF);
    v = DPP_ADD(v, 0x141, 0xF);
    v = DPP_ADD(v, 0x140, 0xF);
    v = DPP_ADD(v, 0x142, 0xA);
    v = DPP_ADD(v, 0x143, 0xC);
    return __int_as_float(__builtin_amdgcn_readlane(__float_as_int(v), 63));
}
__device__ __forceinline__ float fast_exp(float x) { return __builtin_amdgcn_exp2f(x * 1.4426950408889634f); }
__device__ __forceinline__ float sigmoidf_(float x) { return __builtin_amdgcn_rcpf(1.0f + fast_exp(-x)); }

#define XB_TMO      128
#define XB_XCNT(j)  (256  + 64 * (j))
#define XB_XSUB(j)  (1280 + 64 * (j))
#define XB_XGEN(j)  (2304 + 64 * (j))
#define XB_TOP      3328
#define XB_TOPGEN   3392
#define XCD_BAR_WORDS 3456
#define XB_SPIN_CAP (1u << 18)

__device__ __forceinline__ unsigned xb_ld(unsigned* p)              { return __hip_atomic_load(p, __ATOMIC_RELAXED, __HIP_MEMORY_SCOPE_AGENT); }
__device__ __forceinline__ unsigned xb_add(unsigned* p, unsigned v) { return __hip_atomic_fetch_add(p, v, __ATOMIC_RELAXED, __HIP_MEMORY_SCOPE_AGENT); }
__device__ __forceinline__ unsigned xb_xcc_id() { return (unsigned)__builtin_amdgcn_s_getreg((3 << 11) | 20) & 0xFu; }
#define XB_SPIN(cond, bar) do { unsigned _sp = 0; while (cond) { __builtin_amdgcn_s_sleep(1); \
    if ((++_sp & 255u) == 0u) { if (xb_ld(&(bar)[XB_TMO])) break; if (_sp > XB_SPIN_CAP) { atomicAdd(&(bar)[XB_TMO], 1u); break; } } } } while (0)

struct XcdBarrier { unsigned* bar; unsigned x; volatile LAS unsigned* st; };

__device__ __forceinline__ XcdBarrier xcd_barrier_post(unsigned* bar, volatile LAS unsigned* st) {
    XcdBarrier b; b.bar = bar; b.x = xb_xcc_id(); b.st = st;
    if (threadIdx.x == 0) (void)xb_add(&bar[XB_XCNT(b.x)], 1u);
    return b;
}
__device__ __forceinline__ void xcd_barrier_complete(unsigned* bar, unsigned x, unsigned& nloc, unsigned& nx) {
    const unsigned G = gridDim.x * gridDim.y * gridDim.z;
    unsigned sum, cnt, mine, sp = 0u;
    for (;;) {
        sum = 0u; cnt = 0u; mine = 0u;
#pragma unroll
        for (unsigned j = 0; j < 16; ++j) { const unsigned c = xb_ld(&bar[XB_XCNT(j)]); sum += c; cnt += (c > 0u) ? 1u : 0u; mine = (j == x) ? c : mine; }
        if (sum == G) break;
        __builtin_amdgcn_s_sleep(1);
        if ((++sp & 255u) == 0u) { if (xb_ld(&bar[XB_TMO])) break; if (sp > XB_SPIN_CAP) { atomicAdd(&bar[XB_TMO], 1u); break; } }
    }
    nloc = mine > 0u ? mine : 1u; nx = cnt > 0u ? cnt : 1u;
}
__device__ __forceinline__ void xcd_barrier(const XcdBarrier& b) {
    asm volatile("s_waitcnt vmcnt(0)" ::: "memory");
    __syncthreads();
    if (threadIdx.x == 0) {
        unsigned* bar = b.bar; asm volatile("" : "+s"(bar));
        __builtin_amdgcn_s_waitcnt(0);
        unsigned nloc = b.st[0], nx = b.st[1]; unsigned bx = b.x; asm volatile("" : "+s"(bx));
        if (nloc == 0u) { xcd_barrier_complete(bar, bx, nloc, nx); b.st[0] = nloc; b.st[1] = nx; }
        const unsigned old = xb_add(&bar[XB_XSUB(bx)], 1u);
        const unsigned gen = old / nloc;
        if (old + 1u == (gen + 1u) * nloc) {
            __builtin_amdgcn_fence(__ATOMIC_RELEASE, "agent");
            asm volatile("s_waitcnt vmcnt(0)" ::: "memory");
            const unsigned og = xb_add(&bar[XB_TOP], 1u);
            const unsigned tg = og / nx;
            if (og + 1u == (tg + 1u) * nx) xb_add(&bar[XB_TOPGEN], 1u);
            else XB_SPIN(xb_ld(&bar[XB_TOPGEN]) == tg, bar);
            __builtin_amdgcn_fence(__ATOMIC_ACQUIRE, "agent");
            xb_add(&bar[XB_XGEN(bx)], 1u);
            asm volatile("s_waitcnt vmcnt(0)" ::: "memory");
        } else {
            XB_SPIN(xb_ld(&bar[XB_XGEN(bx)]) == gen, bar);
            __builtin_amdgcn_fence(__ATOMIC_ACQUIRE, "agent");
            asm volatile("s_waitcnt vmcnt(0)" ::: "memory");
        }
    }
    __syncthreads();
}

namespace pg8 {
constexpr int BM = 256, BK = 64, HALF = 128, HTB = HALF * BK * 2, STAGE_BYTES = 8 * HTB, NXCD = 8, WGM = 8;
__host__ __device__ __forceinline__ int lds_byte(int r, int c) { const int st = (r >> 4) * 2 + (c >> 5), rr = r & 15, cc = c & 31, ob = rr * 64 + cc * 2; return st * 1024 + (ob ^ (((ob >> 9) & 1) << 5)); }
__host__ __device__ __forceinline__ void stage_rc(int b, int& R, int& C) { const int st = b / 1024, sb = b % 1024, swz = sb ^ (((sb >> 9) & 1) << 5); R = (st >> 1) * 16 + swz / 64; C = (st & 1) * 32 + (swz % 64) / 2; }
__host__ __device__ __forceinline__ int perm32(int rho) { const int n = rho >> 4, i = rho & 15; return 8 * (i >> 2) + 4 * n + (i & 3); }

struct Unit { const char* a; const char* b; int pm, pn; };

__device__ __forceinline__ bool static_tile(int i, int G, int c, int nM, int nN, int& pm, int& pn) {
    const int nwg = nM * nN; const long L = (long)i * G + c; if (L >= nwg) return false;
    int wgid = (int)L; { const int q = nwg / NXCD, r = nwg % NXCD, xcd = wgid % NXCD, off = wgid / NXCD; wgid = (xcd < r ? xcd * (q + 1) : r * (q + 1) + (xcd - r) * q) + off; }
    const int nig = WGM * nN, gid = wgid / nig, fm = gid * WGM, gsz = (nM - fm) < WGM ? (nM - fm) : WGM;
    pm = fm + ((wgid % nig) % gsz); pn = (wgid % nig) / gsz; return true;
}
struct DenseOrder {
    const char* A; const char* Bt; int K, nM, nN, G, c, split, skip;
    __device__ __forceinline__ bool next(int i, Unit& u) const {
        int pm, pn; if (!static_tile(i, G, c, nM, nN, pm, pn)) return false;
        const int pp = pn < split ? pn : pn + skip;
        u.pm = pm; u.pn = pn; u.a = A + (size_t)pm * 256 * K * 2; u.b = Bt + (size_t)pp * 256 * K * 2; return true;
    }
    __device__ __forceinline__ void rows(const Unit&, int, int, unsigned (&)[2], unsigned (&)[2]) const {}
};

template <class Epi, class Sched, bool ALIGN_EPI, bool GATHER>
__device__ __forceinline__ void gemm_phase(LAS unsigned char* lds, const int K, const Sched& S, const Epi& E) {
    int tid_ = threadIdx.x; asm volatile("" : "+v"(tid_));
    const int tid = tid_, wid = __builtin_amdgcn_readfirstlane(tid >> 6), lane = tid & 63, wr = wid >> 2, wc = wid & 3, fr = lane & 15, fq = lane >> 4;
    const int nt = K / BK;
    unsigned voffA[2], voffB[2]; int stR = 0, stC = 0;
#pragma unroll
    for (int i = 0; i < 2; ++i) { int R, C; stage_rc(tid * 16 + i * 8192, R, C); const int Rb = Epi::PERM ? ((R & ~31) + perm32(R & 31)) : R;
        voffA[i] = (unsigned)(R * K + C) * 2u; voffB[i] = (unsigned)(Rb * K + C) * 2u; if (i == 0) { stR = R; stC = C; } }
    const size_t kstep = (size_t)(BK * 2);
    const size_t hstep = (size_t)HALF * K * 2;
    const unsigned ldsw = (unsigned)wid * 1024u;
    const int aoff = lds_byte(wr * 64 + fr, fq * 8), boff = lds_byte(wc * 32 + fr, fq * 8);
    unsigned ga0[2] = {0u, 0u}, ga1[2] = {0u, 0u};
#define PG8_SA(b, h) (((b) * 2 + (h)) * HTB)
#define PG8_SB(b, h) ((4 + (b) * 2 + (h)) * HTB)
#define PG8_STAGE(bufoff, gbase, voff) do { _Pragma("unroll") for (int _i = 0; _i < 2; ++_i) \
        __builtin_amdgcn_global_load_lds((const unsigned*)((const char*)(gbase) + (voff)[_i]), (LAS unsigned*)(lds + (bufoff) + ldsw + _i * 8192), 16, 0, 0); } while (0)
#define PG8_STAGE_A(bufoff, gbase, h, nx) do { if constexpr (GATHER) { if (h) PG8_STAGE(bufoff, gbase, ga1); else PG8_STAGE(bufoff, gbase, ga0); } \
        else { PG8_STAGE(bufoff, (gbase) + (h) * hstep, voffA); } } while (0)
#define PG8_LDA(dst, b, h) do { _Pragma("unroll") for (int m = 0; m < 4; ++m) _Pragma("unroll") for (int k = 0; k < 2; ++k) dst[m][k] = *(const LAS bf16x8*)(lds + PG8_SA(b, h) + aoff + m * 2048 + k * 1024); } while (0)
#define PG8_LDB(dst, b, h) do { _Pragma("unroll") for (int n = 0; n < 2; ++n) _Pragma("unroll") for (int k = 0; k < 2; ++k) dst[n][k] = *(const LAS bf16x8*)(lds + PG8_SB(b, h) + boff + n * 2048 + k * 1024); } while (0)
#define PG8_MMA(ai, bj, At, Bt) do { __builtin_amdgcn_s_setprio(1); _Pragma("unroll") for (int m = 0; m < 4; ++m) _Pragma("unroll") for (int n = 0; n < 2; ++n) _Pragma("unroll") for (int k = 0; k < 2; ++k) \
        acc[ai][bj][m][n] = __builtin_amdgcn_mfma_f32_16x16x32_bf16(Bt[n][k], At[m][k], acc[ai][bj][m][n], 0, 0, 0); __builtin_amdgcn_s_setprio(0); } while (0)
#define PG8_WAIT_V(n) asm volatile("s_waitcnt vmcnt(" #n ")" ::: "memory")
#define PG8_WAIT_L(n) asm volatile("s_waitcnt lgkmcnt(" #n ")" ::: "memory")
#define PG8_BAR __builtin_amdgcn_s_barrier()
#define PG8_SCHED __builtin_amdgcn_sched_barrier(0)
    Unit cur, nxt; int ui = 0;
    if (!S.next(0, cur)) return;
    f32x4 acc[2][2][4][2];
#pragma unroll
    for (int a = 0; a < 2; ++a)
#pragma unroll
        for (int b = 0; b < 2; ++b)
#pragma unroll
            for (int m = 0; m < 4; ++m)
#pragma unroll
                for (int n = 0; n < 2; ++n) acc[a][b][m][n] = (f32x4){0.f, 0.f, 0.f, 0.f};
    bf16x8 At[4][2], B0[2][2], B1[2][2];
    const char* cA = cur.a; const char* cB = cur.b;
    if constexpr (GATHER) { S.rows(cur, stR, stC, ga0, ga1); }
    PG8_STAGE(PG8_SB(0, 0), cB, voffB); PG8_STAGE(PG8_SB(0, 1), cB + hstep, voffB); PG8_STAGE_A(PG8_SA(0, 0), cA, 0, false); PG8_STAGE_A(PG8_SA(0, 1), cA, 1, false);
    if (wr == 1) PG8_BAR;
    PG8_WAIT_V(2); PG8_BAR;
    PG8_STAGE(PG8_SB(1, 0), cB + kstep, voffB); PG8_STAGE_A(PG8_SA(1, 0), cA + kstep, 0, false); PG8_STAGE(PG8_SB(1, 1), cB + hstep + kstep, voffB);
    PG8_WAIT_V(6); PG8_BAR;
    for (;;) {
        const bool has_next = S.next(ui + 1, nxt);
        const char* nA = has_next ? nxt.a : cA; const char* nB = has_next ? nxt.b : cB;
#pragma unroll 1
        for (int t = 0; t < nt; t += 2) {
            const bool last = (t == nt - 2);
            const char* a1 = cA + (size_t)(t + 1) * kstep;
            const char* a2 = last ? nA : cA + (size_t)(t + 2) * kstep; const char* b2 = last ? nB : cB + (size_t)(t + 2) * kstep;
            const char* a3 = a2 + kstep; const char* b3 = b2 + kstep;
            PG8_LDB(B0, 0, 0); PG8_LDB(B1, 0, 1); PG8_SCHED; PG8_LDA(At, 0, 0); PG8_STAGE_A(PG8_SA(1, 1), a1, 1, false);
            if constexpr (GATHER) { if (last && has_next) S.rows(nxt, stR, stC, ga0, ga1); }
            PG8_WAIT_V(8); PG8_WAIT_L(0); PG8_BAR; PG8_MMA(0, 0, At, B0); PG8_MMA(0, 1, At, B1); PG8_BAR; PG8_SCHED;
            PG8_LDA(At, 0, 1); PG8_STAGE(PG8_SB(0, 0), b2, voffB); PG8_STAGE(PG8_SB(0, 1), b2 + hstep, voffB); PG8_STAGE_A(PG8_SA(0, 0), a2, 0, last);
            PG8_WAIT_V(8); PG8_WAIT_L(0); PG8_BAR; PG8_MMA(1, 0, At, B0); PG8_MMA(1, 1, At, B1); PG8_BAR; PG8_SCHED;
            PG8_LDB(B0, 1, 0); PG8_LDB(B1, 1, 1); PG8_SCHED; PG8_LDA(At, 1, 0); PG8_STAGE_A(PG8_SA(0, 1), a2, 1, last);
            PG8_WAIT_V(8); PG8_WAIT_L(0); PG8_BAR; PG8_MMA(0, 0, At, B0); PG8_MMA(0, 1, At, B1); PG8_BAR; PG8_SCHED;
            PG8_LDA(At, 1, 1); PG8_STAGE(PG8_SB(1, 0), b3, voffB); PG8_STAGE(PG8_SB(1, 1), b3 + hstep, voffB); PG8_STAGE_A(PG8_SA(1, 0), a3, 0, last);
            PG8_WAIT_V(8); PG8_WAIT_L(0); PG8_BAR; PG8_MMA(1, 0, At, B0); PG8_MMA(1, 1, At, B1); PG8_BAR; PG8_SCHED;
        }
        if constexpr (ALIGN_EPI) { if (wr == 0) PG8_BAR; }
        E(acc, cur, wr, wc, fr, fq);
        if (!has_next) break;
#pragma unroll
        for (int a = 0; a < 2; ++a)
#pragma unroll
            for (int b = 0; b < 2; ++b)
#pragma unroll
                for (int m = 0; m < 4; ++m)
#pragma unroll
                    for (int n = 0; n < 2; ++n) acc[a][b][m][n] = (f32x4){0.f, 0.f, 0.f, 0.f};
        cur = nxt; cA = nA; cB = nB; ++ui;
        if constexpr (ALIGN_EPI) { if (wr == 1) PG8_BAR; }
    }
    PG8_WAIT_V(0);
    if constexpr (!ALIGN_EPI) { if (wr == 0) PG8_BAR; }
    PG8_BAR;
#undef PG8_SA
#undef PG8_SB
#undef PG8_STAGE
#undef PG8_STAGE_A
#undef PG8_LDA
#undef PG8_LDB
#undef PG8_MMA
#undef PG8_WAIT_V
#undef PG8_WAIT_L
#undef PG8_BAR
#undef PG8_SCHED
}

__device__ __forceinline__ u32x4 pack8(const f32x4 v0, const f32x4 v1) { u32x4 w; w.x = cvt_pk_bf16(v0[0], v0[1]); w.y = cvt_pk_bf16(v0[2], v0[3]); w.z = cvt_pk_bf16(v1[0], v1[1]); w.w = cvt_pk_bf16(v1[2], v1[3]); return w; }

struct EpiPlain {
    static constexpr bool PERM = true;
    bf16_t* O; int ldc;
    __device__ __forceinline__ void operator()(const f32x4 (&acc)[2][2][4][2], const Unit& u, int wr, int wc, int fr, int fq) const {
        bf16_t* base = O + (size_t)u.pm * BM * ldc + u.pn * BM;
        const unsigned lo = (unsigned)((wr * 64 + fr) * ldc + wc * 32 + 8 * fq);
#pragma unroll
        for (int ai = 0; ai < 2; ++ai)
#pragma unroll
            for (int m = 0; m < 4; ++m)
#pragma unroll
                for (int bj = 0; bj < 2; ++bj) *(u32x4*)(base + (size_t)((ai * HALF + m * 16) * ldc + bj * HALF) + lo) = pack8(acc[ai][bj][m][0], acc[ai][bj][m][1]);
    }
};
struct EpiPre {
    static constexpr bool PERM = false;
    float* out; const bf16_t* xb; float alpha;
    __device__ __forceinline__ void operator()(const f32x4 (&acc)[2][2][4][2], const Unit& u, int wr, int wc, int fr, int fq) const {
        const size_t ub = (size_t)u.pm * BM * 2048 + u.pn * BM; float* ob = out + ub; const bf16_t* xbb = xb + ub;
        const unsigned lo = (unsigned)((wr * 64 + fr) * 2048 + wc * 32 + 4 * fq);
#pragma unroll
        for (int ai = 0; ai < 2; ++ai)
#pragma unroll
            for (int m = 0; m < 4; ++m)
#pragma unroll
                for (int bj = 0; bj < 2; ++bj)
#pragma unroll
                    for (int n = 0; n < 2; ++n) { const unsigned uo = (unsigned)((ai * HALF + m * 16) * 2048 + bj * HALF + n * 16);
                        const u32x2 xw = *(const u32x2*)(xbb + uo + lo);
                        f32x4 o; o[0] = alpha * bf_lo(xw.x) + acc[ai][bj][m][n][0]; o[1] = alpha * bf_hi(xw.x) + acc[ai][bj][m][n][1]; o[2] = alpha * bf_lo(xw.y) + acc[ai][bj][m][n][2]; o[3] = alpha * bf_hi(xw.y) + acc[ai][bj][m][n][3];
                        *(f32x4*)(ob + uo + lo) = o; }
    }
};
struct EpiCinN {
    static constexpr bool PERM = true;
    bf16_t* Q; bf16_t* G; const float* cs; const float* sn;
    __device__ __forceinline__ void operator()(const f32x4 (&acc)[2][2][4][2], const Unit& u, int wr, int wc, int fr, int fq) const {
        if (u.pn < 8) {
            bf16_t* base = Q + (size_t)u.pm * BM * 2048 + u.pn * 256;
            const int i0 = wc * 32 + 8 * fq; const unsigned lo = (unsigned)((wr * 64 + fr) * 2048 + i0);
            const int s0 = ((u.pm * BM) & 4095) + wr * 64 + fr;
            const unsigned to = (unsigned)(s0 * 128 + i0);
#pragma unroll
            for (int ai = 0; ai < 2; ++ai)
#pragma unroll
                for (int m = 0; m < 4; ++m) { const unsigned tt = to + (unsigned)((ai * HALF + m * 16) * 128);
                    const f32x4 c0 = *(const f32x4*)(cs + tt), c1 = *(const f32x4*)(cs + tt + 4), s0v = *(const f32x4*)(sn + tt), s1v = *(const f32x4*)(sn + tt + 4);
                    const f32x4 x10 = acc[ai][0][m][0], x11 = acc[ai][0][m][1], x20 = acc[ai][1][m][0], x21 = acc[ai][1][m][1];
                    const f32x4 o10 = x10 * c0 - x20 * s0v, o11 = x11 * c1 - x21 * s1v, o20 = x20 * c0 + x10 * s0v, o21 = x21 * c1 + x11 * s1v;
                    bf16_t* rowp = base + (size_t)((ai * HALF + m * 16) * 2048) + lo;
                    *(u32x4*)(rowp) = pack8(o10, o11); *(u32x4*)(rowp + 128) = pack8(o20, o21); }
        } else {
            bf16_t* base = G + (size_t)u.pm * BM * 4096 + (u.pn - 8) * BM; const unsigned lo = (unsigned)((wr * 64 + fr) * 4096 + wc * 32 + 8 * fq);
#pragma unroll
            for (int ai = 0; ai < 2; ++ai)
#pragma unroll
                for (int m = 0; m < 4; ++m)
#pragma unroll
                    for (int bj = 0; bj < 2; ++bj) *(u32x4*)(base + (size_t)((ai * HALF + m * 16) * 4096 + bj * HALF) + lo) = pack8(acc[ai][bj][m][0], acc[ai][bj][m][1]);
        }
    }
};
struct EpiCinT {
    static constexpr bool PERM = true;
    bf16_t* O; const float* csT; const float* snT;
    __device__ __forceinline__ void operator()(const f32x4 (&acc)[2][2][4][2], const Unit& u, int wr, int wc, int fr, int fq) const {
        bf16_t* base = O + (size_t)u.pm * BM * 16384 + u.pn * BM; const unsigned lo = (unsigned)((wr * 64 + fr) * 16384 + wc * 32 + 8 * fq);
        if (u.pm < 8) {
            const unsigned to = (unsigned)((wr * 64 + fr) * 4096 + ((u.pn * BM) & 4095) + wc * 32 + 8 * fq);
#pragma unroll
            for (int m = 0; m < 4; ++m)
#pragma unroll
                for (int bj = 0; bj < 2; ++bj) { const unsigned tt = to + (unsigned)(m * 16 * 4096 + bj * HALF);
                    const f32x4 c0 = *(const f32x4*)(csT + tt), c1 = *(const f32x4*)(csT + tt + 4), s0 = *(const f32x4*)(snT + tt), s1 = *(const f32x4*)(snT + tt + 4);
                    const f32x4 x10 = acc[0][bj][m][0], x11 = acc[0][bj][m][1], x20 = acc[1][bj][m][0], x21 = acc[1][bj][m][1];
                    const f32x4 o10 = (x10 * c0 - x20 * s0) * 0.0625f, o11 = (x11 * c1 - x21 * s1) * 0.0625f, o20 = (x20 * c0 + x10 * s0) * 0.0625f, o21 = (x21 * c1 + x11 * s1) * 0.0625f;
                    *(u32x4*)(base + (size_t)(m * 16 * 16384 + bj * HALF) + lo) = pack8(o10, o11);
                    *(u32x4*)(base + (size_t)((HALF + m * 16) * 16384 + bj * HALF) + lo) = pack8(o20, o21); }
        } else {
#pragma unroll
            for (int ai = 0; ai < 2; ++ai)
#pragma unroll
                for (int m = 0; m < 4; ++m)
#pragma unroll
                    for (int bj = 0; bj < 2; ++bj) *(u32x4*)(base + (size_t)((ai * HALF + m * 16) * 16384 + bj * HALF) + lo) = pack8(acc[ai][bj][m][0], acc[ai][bj][m][1]);
        }
    }
};
struct EpiPle {
    static constexpr bool PERM = true;
    bf16_t* PLE; const bf16_t* PROJ; const float* bias; float* LOG;
    __device__ __forceinline__ void operator()(const f32x4 (&acc)[2][2][4][2], const Unit& u, int wr, int wc, int fr, int fq) const {
        if (u.pn < 8) {
            const size_t ub = (size_t)u.pm * BM * 2048 + u.pn * BM; bf16_t* pb = PLE + ub; const bf16_t* jb = PROJ + ub; const float* bb = bias + u.pn * BM;
            const unsigned lo = (unsigned)((wr * 64 + fr) * 2048 + wc * 32 + 8 * fq), lc = (unsigned)(wc * 32 + 8 * fq);
#pragma unroll
            for (int bj = 0; bj < 2; ++bj) { const f32x4 bv0 = *(const f32x4*)(bb + lc + bj * HALF), bv1 = *(const f32x4*)(bb + lc + bj * HALF + 4);
#pragma unroll
                for (int ai = 0; ai < 2; ++ai)
#pragma unroll
                    for (int m = 0; m < 4; ++m) { const unsigned uo = (unsigned)((ai * HALF + m * 16) * 2048 + bj * HALF); const u32x4 pw = *(const u32x4*)(jb + uo + lo);
                        f32x4 v0 = acc[ai][bj][m][0] + bv0, v1 = acc[ai][bj][m][1] + bv1;
                        v0[0] = sigmoidf_(v0[0]) * bf_lo(pw.x); v0[1] = sigmoidf_(v0[1]) * bf_hi(pw.x); v0[2] = sigmoidf_(v0[2]) * bf_lo(pw.y); v0[3] = sigmoidf_(v0[3]) * bf_hi(pw.y);
                        v1[0] = sigmoidf_(v1[0]) * bf_lo(pw.z); v1[1] = sigmoidf_(v1[1]) * bf_hi(pw.z); v1[2] = sigmoidf_(v1[2]) * bf_lo(pw.w); v1[3] = sigmoidf_(v1[3]) * bf_hi(pw.w);
                        *(u32x4*)(pb + uo + lo) = pack8(v0, v1); } }
        } else if (wc < 2) {
            float* lb = LOG + (size_t)u.pm * BM * 64; const unsigned lo = (unsigned)((wr * 64 + fr) * 64 + wc * 32 + 8 * fq);
#pragma unroll
            for (int ai = 0; ai < 2; ++ai)
#pragma unroll
                for (int m = 0; m < 4; ++m) { float* rowp = lb + (ai * HALF + m * 16) * 64 + lo;
                    *(f32x4*)(rowp) = acc[ai][0][m][0]; *(f32x4*)(rowp + 4) = acc[ai][0][m][1]; }
        }
    }
};
struct EpiGU {
    static constexpr bool PERM = true;
    bf16_t* HB;
    __device__ __forceinline__ void operator()(const f32x4 (&acc)[2][2][4][2], const Unit& u, int wr, int wc, int fr, int fq) const {
        bf16_t* base = HB + (size_t)u.pm * BM * 512 + u.pn * 128; const unsigned lo = (unsigned)((wr * 64 + fr) * 512 + wc * 32 + 8 * fq);
#pragma unroll
        for (int ai = 0; ai < 2; ++ai)
#pragma unroll
            for (int m = 0; m < 4; ++m) { f32x4 h0, h1;
#pragma unroll
                for (int j = 0; j < 4; ++j) { const float g0 = acc[ai][0][m][0][j], g1 = acc[ai][0][m][1][j]; h0[j] = g0 * sigmoidf_(g0) * acc[ai][1][m][0][j]; h1[j] = g1 * sigmoidf_(g1) * acc[ai][1][m][1][j]; }
                *(u32x4*)(base + (size_t)((ai * HALF + m * 16) * 512) + lo) = pack8(h0, h1); }
    }
};
}

namespace att {
constexpr int KVBLK = 64;
constexpr int SHM_V = 16384, SHM_K = 16384, SHM_P = 8192;
constexpr int OFF_V = 0, OFF_K = 2 * SHM_V, OFF_P = OFF_K + 2 * SHM_K, OFF_WS = OFF_P + 2 * SHM_P, OFF_BIAS = OFF_WS + 8 * 64 * 4, OFF_QPE = OFF_BIAS + 512 * 4, ATT_LDS = OFF_QPE + 256 * 128;
#define KSWZ(row, colB) ((row) * 256 + ((colB) ^ (((row) & 7) << 4)))
#define PSWZ(row, colB) ((row) * 128 + ((colB) ^ (((row) & 7) << 4)))
__device__ __forceinline__ int crow(int r, int hi) { return (r & 3) + 8 * (r >> 2) + 4 * hi; }

template <int MODE> struct Cfg;
template <> struct Cfg<0> { static constexpr int NQ = 8; static constexpr float SCALE = 0.07216878364870323f; static constexpr int LDQ = 1536, LDK = 2048, LDO = 2048; };
template <> struct Cfg<1> { static constexpr int NQ = 8;  static constexpr float SCALE = 0.08838834764831845f; static constexpr int LDQ = 4096, LDK = 4096, LDO = 2048; };
constexpr float THRN = 8.f;

template <int MODE>
__device__ __forceinline__ void partialSM(f32x16& p0, f32x16& p1, float& m_reg, float& mn, float& alpha) {
  constexpr float SCALE = Cfg<MODE>::SCALE; constexpr float C = SCALE * 1.4426950408889634f;
  float pmax = p0[0];
#pragma unroll
  for (int r = 1; r < 16; ++r) pmax = fmaxf(pmax, p0[r]);
#pragma unroll
  for (int r = 0; r < 16; ++r) pmax = fmaxf(pmax, p1[r]);
  { auto rr = __builtin_amdgcn_permlane32_swap(__float_as_uint(pmax), __float_as_uint(pmax), false, false);
    pmax = fmaxf(__uint_as_float(rr[0]), __uint_as_float(rr[1])); }
  if (__builtin_expect(__all(pmax - m_reg <= THRN / SCALE), 1)) { mn = m_reg; alpha = 1.f; }
  else { mn = fmaxf(m_reg, pmax); alpha = __builtin_amdgcn_exp2f((m_reg - mn) * C); m_reg = mn; }
  float mnC = -mn * C;
#pragma unroll
  for (int r = 0; r < 16; ++r) p0[r] = fmaf(p0[r], C, mnC);
#pragma unroll
  for (int r = 0; r < 16; ++r) p1[r] = fmaf(p1[r], C, mnC);
#pragma unroll
  for (int r = 0; r < 16; ++r) p0[r] = __builtin_amdgcn_exp2f(p0[r]);
}
__device__ __forceinline__ void finishSM(f32x16& p0, f32x16& p1, float alpha, float& l_reg, bf16x8& pa0, bf16x8& pa1, bf16x8& pa2, bf16x8& pa3) {
#pragma unroll
  for (int r = 0; r < 16; ++r) p1[r] = __builtin_amdgcn_exp2f(p1[r]);
  float ps = 0;
#pragma unroll
  for (int r = 0; r < 16; ++r) ps += p0[r];
#pragma unroll
  for (int r = 0; r < 16; ++r) ps += p1[r];
  { auto rr = __builtin_amdgcn_permlane32_swap(__float_as_uint(ps), __float_as_uint(ps), false, false);
    ps = __uint_as_float(rr[0]) + __uint_as_float(rr[1]); }
  l_reg = l_reg * alpha + ps;
#define PK4(P, BASE, OUT) do { unsigned a0 = cvt_pk_bf16(P[BASE + 0], P[BASE + 1]), a1 = cvt_pk_bf16(P[BASE + 2], P[BASE + 3]);   \
    unsigned b0 = cvt_pk_bf16(P[BASE + 4], P[BASE + 5]), b1 = cvt_pk_bf16(P[BASE + 6], P[BASE + 7]);                              \
    auto r0 = __builtin_amdgcn_permlane32_swap(a0, b0, false, false); auto r1 = __builtin_amdgcn_permlane32_swap(a1, b1, false, false); \
    u32x4 w = {r0[0], r1[0], r0[1], r1[1]}; OUT = *reinterpret_cast<bf16x8*>(&w); } while (0)
  PK4(p0, 0, pa0); PK4(p0, 8, pa1); PK4(p1, 0, pa2); PK4(p1, 8, pa3);
#undef PK4
}
template <int MODE>
__device__ __forceinline__ void qkt(f32x16& p0, f32x16& p1, const char* Ks, const char* Ps, const bf16x8* qr, const char* qpe, int r32, int hi) {
  p0 = f32x16{}; p1 = f32x16{};
#pragma unroll
  for (int d0 = 0; d0 < 8; ++d0) { int cb = (d0 * 16 + hi * 8) * 2;
    bf16x8 b0 = *reinterpret_cast<const bf16x8*>(Ks + KSWZ(r32, cb));
    bf16x8 b1 = *reinterpret_cast<const bf16x8*>(Ks + KSWZ(32 + r32, cb));
    p0 = __builtin_amdgcn_mfma_f32_32x32x16_bf16(b0, qr[d0], p0, 0, 0, 0);
    p1 = __builtin_amdgcn_mfma_f32_32x32x16_bf16(b1, qr[d0], p1, 0, 0, 0); }
  if constexpr (MODE == 0) {
#pragma unroll
    for (int d0 = 0; d0 < 4; ++d0) { int cb = (d0 * 16 + hi * 8) * 2;
      bf16x8 b0 = *reinterpret_cast<const bf16x8*>(Ps + PSWZ(r32, cb));
      bf16x8 b1 = *reinterpret_cast<const bf16x8*>(Ps + PSWZ(32 + r32, cb));
      const bf16x8 qp = *reinterpret_cast<const bf16x8*>(qpe + (cb ^ ((r32 & 7) << 4)));
      p0 = __builtin_amdgcn_mfma_f32_32x32x16_bf16(b0, qp, p0, 0, 0, 0);
      p1 = __builtin_amdgcn_mfma_f32_32x32x16_bf16(b1, qp, p1, 0, 0, 0); }
  }
}
__device__ __forceinline__ int v_st(int k, int c) { const int kk = (k & ~0xC) | ((k & 4) << 1) | ((k & 8) >> 1); return ((kk >> 3) * 4 + (c >> 5)) * 512 + ((kk & 7) * 32 + (c & 31)) * 2; }
__device__ __forceinline__ int v_rd_base(int lane) { return ((lane & 3) << 3) | (((lane >> 2) & 3) << 6) | (((lane >> 4) & 1) << 5) | (((lane >> 5) & 1) << 8); }
constexpr int v_rd_off(int d0, int ks, int half) { return d0 * 512 + ks * 4096 + half * 2048; }
template <int OFF> __device__ __forceinline__ s16x4 tr_read(int vb) {
  s16x4 r; asm volatile("ds_read_b64_tr_b16 %0, %1 offset:%2" : "=&v"(r) : "v"(vb), "i"(OFF) : "memory"); return r;
}
template <int D0> __device__ __forceinline__ void pv_one(f32x16& od, int vb, bf16x8 pa0, bf16x8 pa1, bf16x8 pa2, bf16x8 pa3) {
  const s16x4 l0 = tr_read<v_rd_off(D0, 0, 0)>(vb), h0 = tr_read<v_rd_off(D0, 0, 1)>(vb), l1 = tr_read<v_rd_off(D0, 1, 0)>(vb), h1 = tr_read<v_rd_off(D0, 1, 1)>(vb);
  const s16x4 l2 = tr_read<v_rd_off(D0, 2, 0)>(vb), h2 = tr_read<v_rd_off(D0, 2, 1)>(vb), l3 = tr_read<v_rd_off(D0, 3, 0)>(vb), h3 = tr_read<v_rd_off(D0, 3, 1)>(vb);
  asm volatile("s_waitcnt lgkmcnt(0)" ::: "memory"); SBAR();
#define PKV(L, H) (bf16x8){L[0], L[1], L[2], L[3], H[0], H[1], H[2], H[3]}
  od = __builtin_amdgcn_mfma_f32_32x32x16_bf16(pa0, PKV(l0, h0), od, 0, 0, 0);
  od = __builtin_amdgcn_mfma_f32_32x32x16_bf16(pa1, PKV(l1, h1), od, 0, 0, 0);
  od = __builtin_amdgcn_mfma_f32_32x32x16_bf16(pa2, PKV(l2, h2), od, 0, 0, 0);
  od = __builtin_amdgcn_mfma_f32_32x32x16_bf16(pa3, PKV(l3, h3), od, 0, 0, 0);
#undef PKV
}
__device__ __forceinline__ void pv_d0(f32x16* o, int vb, bf16x8 pa0, bf16x8 pa1, bf16x8 pa2, bf16x8 pa3) {
  pv_one<0>(o[0], vb, pa0, pa1, pa2, pa3); pv_one<1>(o[1], vb, pa0, pa1, pa2, pa3); pv_one<2>(o[2], vb, pa0, pa1, pa2, pa3); pv_one<3>(o[3], vb, pa0, pa1, pa2, pa3);
}
__device__ __forceinline__ void na_mask(f32x16& p0, f32x16& p1, const float* biasS, int kr, int rq, int cq, int hi) {
  const int rs = min(max(rq - 4, 0), 56), cs = min(max(cq - 8, 0), 48);
  const bool rowok = (kr >= rs) && (kr <= rs + 7);
  int lo = (rowok ? cs : 1000) - 4 * hi;
  int bidx = (kr - rq + 7) * 31 - cq + 15 + 4 * hi;
  asm volatile("" : "+v"(bidx), "+v"(lo));
  const float* bp = biasS + bidx;
#pragma unroll
  for (int r = 0; r < 16; ++r) {
    const int c0 = (r & 3) + 8 * (r >> 2), c1 = 32 + c0;
    const bool ok0 = (unsigned)(c0 - lo) < 16u, ok1 = (unsigned)(c1 - lo) < 16u;
    const float b0 = bp[c0], b1 = bp[c1];
    p0[r] = ok0 ? p0[r] + b0 : -3.0e38f; p1[r] = ok1 ? p1[r] + b1 : -3.0e38f;
  }
}

struct AttnArgs {
  const bf16* Qp;
  const bf16* Kp; const bf16* Vp;
  const bf16* Pp;
  bf16* Op;
  const float* cosM; const float* sinM;
  int s0;
  int NT;
  int kr0;
  int rg;
};

template <int MODE>
__device__ __forceinline__ void attn_item(const AttnArgs& A, char* lds) {
  constexpr int NQ = Cfg<MODE>::NQ, LDQ = Cfg<MODE>::LDQ, LDK = Cfg<MODE>::LDK, LDO = Cfg<MODE>::LDO;
  int tid_ = threadIdx.x; asm volatile("" : "+v"(tid_));
  const int tid = tid_, wid = tid >> 6, lane = tid & 63, r32 = lane & 31, hi = lane >> 5;
  char* V_lds = lds + OFF_V; char* K_lds = lds + OFF_K; char* P_lds = lds + OFF_P;
  float* ws = (float*)(lds + OFF_WS) + wid * 64; float* li_l = ws; float* al_l = ws + 32;
  const float* biasS = (const float*)(lds + OFF_BIAS);
  float m_reg = -1e30f, l_reg = 0; f32x16 o[4] = {}; bf16x8 qr[NQ];
  char* qpe_row = lds + OFF_QPE + (wid * 32 + r32) * 128;
  const bf16* Qw = A.Qp + (wid * 32 + r32) * LDQ + hi * 8;
#pragma unroll
  for (int d0 = 0; d0 < 8; ++d0) qr[d0] = *reinterpret_cast<const bf16x8*>(Qw + d0 * 16);
  if constexpr (MODE == 0) {
    const int s = A.s0 + wid * 32 + r32;
#pragma unroll
    for (int c = 0; c < 2; ++c) {
      const u32x4 x1 = *reinterpret_cast<const u32x4*>(Qw + (8 + c) * 16), x2 = *reinterpret_cast<const u32x4*>(Qw + (10 + c) * 16);
      const int i0 = c * 16 + hi * 8;
      const f32x4 ca = *(const f32x4*)(A.cosM + s * 32 + i0), cb = *(const f32x4*)(A.cosM + s * 32 + i0 + 4), sa = *(const f32x4*)(A.sinM + s * 32 + i0), sb = *(const f32x4*)(A.sinM + s * 32 + i0 + 4);
      float a[8], b[8], cc[8], ss[8];
      a[0] = bf_lo(x1.x); a[1] = bf_hi(x1.x); a[2] = bf_lo(x1.y); a[3] = bf_hi(x1.y); a[4] = bf_lo(x1.z); a[5] = bf_hi(x1.z); a[6] = bf_lo(x1.w); a[7] = bf_hi(x1.w);
      b[0] = bf_lo(x2.x); b[1] = bf_hi(x2.x); b[2] = bf_lo(x2.y); b[3] = bf_hi(x2.y); b[4] = bf_lo(x2.z); b[5] = bf_hi(x2.z); b[6] = bf_lo(x2.w); b[7] = bf_hi(x2.w);
#pragma unroll
      for (int j = 0; j < 4; ++j) { cc[j] = ca[j]; cc[4 + j] = cb[j]; ss[j] = sa[j]; ss[4 + j] = sb[j]; }
      float o1[8], o2[8];
#pragma unroll
      for (int j = 0; j < 8; ++j) { o1[j] = a[j] * cc[j] - b[j] * ss[j]; o2[j] = b[j] * cc[j] + a[j] * ss[j]; }
      u32x4 w1 = {cvt_pk_bf16(o1[0], o1[1]), cvt_pk_bf16(o1[2], o1[3]), cvt_pk_bf16(o1[4], o1[5]), cvt_pk_bf16(o1[6], o1[7])};
      u32x4 w2 = {cvt_pk_bf16(o2[0], o2[1]), cvt_pk_bf16(o2[2], o2[3]), cvt_pk_bf16(o2[4], o2[5]), cvt_pk_bf16(o2[6], o2[7])};
      *reinterpret_cast<u32x4*>(qpe_row + (((c * 16 + hi * 8) * 2) ^ ((r32 & 7) << 4))) = w1; *reinterpret_cast<u32x4*>(qpe_row + (((32 + c * 16 + hi * 8) * 2) ^ ((r32 & 7) << 4))) = w2;
    }
  }
  const int rq = A.rg * 4 + (wid >> 1), cq = 32 * (wid & 1) + r32;
  const int sr = tid >> 4, sc = (tid & 15) * 8, vst0 = v_st(sr, sc), vst1 = v_st(32 + sr, sc);
  const int pr = tid >> 3, pc = (tid & 7) * 8;
  const int vb0 = (int)(uintptr_t)V_lds + v_rd_base(lane);
  bf16x8 vs0, vs1, ks0, ks1, ps0;
  const int kvo0 = sr * LDK + sc, kvo1 = (32 + sr) * LDK + sc, po0 = pr * 64 + pc;
#define SLOAD(k0) do { const bf16* Vt = A.Vp + (size_t)(k0) * LDK; const bf16* Kt = A.Kp + (size_t)(k0) * LDK; \
    vs0 = *reinterpret_cast<const bf16x8*>(Vt + kvo0); vs1 = *reinterpret_cast<const bf16x8*>(Vt + kvo1); \
    ks0 = *reinterpret_cast<const bf16x8*>(Kt + kvo0); ks1 = *reinterpret_cast<const bf16x8*>(Kt + kvo1); \
    if constexpr (MODE == 0) ps0 = *reinterpret_cast<const bf16x8*>(A.Pp + (size_t)(k0) * 64 + po0); } while (0)
#define SWRITE(b) do { *(bf16x8*)(V_lds + (b) * SHM_V + vst0) = vs0; *(bf16x8*)(V_lds + (b) * SHM_V + vst1) = vs1; int kc = sc * 2; \
    *(bf16x8*)(K_lds + (b) * SHM_K + KSWZ(sr, kc)) = ks0; *(bf16x8*)(K_lds + (b) * SHM_K + KSWZ(32 + sr, kc)) = ks1; \
    if constexpr (MODE == 0) *(bf16x8*)(P_lds + (b) * SHM_P + PSWZ(pr, pc * 2)) = ps0; } while (0)
#define SWAIT() asm volatile("s_waitcnt vmcnt(0)" ::: "memory")
#define RESC(a) do { if (__any((a) < 1.f)) { if (hi == 0) al_l[r32] = (a); asm volatile("s_waitcnt lgkmcnt(0)" ::: "memory"); \
    _Pragma("unroll") for (int d = 0; d < 4; ++d) _Pragma("unroll") for (int r = 0; r < 16; ++r) o[d][r] *= al_l[crow(r, hi)]; } } while (0)
#define NAM(P0, P1, j) do { if constexpr (MODE == 1) na_mask(P0, P1, biasS, A.kr0 + (j), rq, cq, hi); } while (0)
  f32x16 pA0, pA1, pB0, pB1; float mnA, mnB, alA, alB; bf16x8 pa0, pa1, pa2, pa3; const int NT = A.NT;
  SLOAD(0); asm volatile("s_waitcnt vmcnt(0)" ::: "memory"); SWRITE(0); __syncthreads();
  qkt<MODE>(pA0, pA1, K_lds, P_lds, qr, qpe_row, r32, hi); NAM(pA0, pA1, 0); partialSM<MODE>(pA0, pA1, m_reg, mnA, alA);
  SLOAD(KVBLK);
  SWAIT(); SWRITE(1); __syncthreads();
  for (int j = 1; j + 1 < NT; j += 2) {
    SBAR(); qkt<MODE>(pB0, pB1, K_lds + SHM_K, P_lds + SHM_P, qr, qpe_row, r32, hi); NAM(pB0, pB1, j);
    finishSM(pA0, pA1, alA, l_reg, pa0, pa1, pa2, pa3); SBAR();
    SLOAD((j + 1) * KVBLK); SBAR();
    pv_d0(o, vb0, pa0, pa1, pa2, pa3); partialSM<MODE>(pB0, pB1, m_reg, mnB, alB);
    __syncthreads(); SWAIT(); SWRITE(0);
    RESC(alB); __syncthreads();
    SBAR(); qkt<MODE>(pA0, pA1, K_lds, P_lds, qr, qpe_row, r32, hi); NAM(pA0, pA1, j + 1);
    finishSM(pB0, pB1, alB, l_reg, pa0, pa1, pa2, pa3); SBAR();
    SLOAD((j + 2) * KVBLK); SBAR();
    pv_d0(o, vb0 + SHM_V, pa0, pa1, pa2, pa3); partialSM<MODE>(pA0, pA1, m_reg, mnA, alA);
    __syncthreads(); SWAIT(); SWRITE(1);
    RESC(alA); __syncthreads();
  }
  SBAR(); qkt<MODE>(pB0, pB1, K_lds + SHM_K, P_lds + SHM_P, qr, qpe_row, r32, hi); NAM(pB0, pB1, NT - 1);
  finishSM(pA0, pA1, alA, l_reg, pa0, pa1, pa2, pa3); SBAR();
  pv_d0(o, vb0, pa0, pa1, pa2, pa3); partialSM<MODE>(pB0, pB1, m_reg, mnB, alB);
  __syncthreads(); RESC(alB);
  finishSM(pB0, pB1, alB, l_reg, pa0, pa1, pa2, pa3); SBAR();
  pv_d0(o, vb0 + SHM_V, pa0, pa1, pa2, pa3);
  if (hi == 0) li_l[r32] = l_reg; asm volatile("s_waitcnt lgkmcnt(0)" ::: "memory");
  float rli[16];
#pragma unroll
  for (int r = 0; r < 16; ++r) rli[r] = __builtin_amdgcn_rcpf(li_l[crow(r, hi)]);
  bf16* Ow = A.Op + (wid * 32) * LDO + r32;
#pragma unroll
  for (int r = 0; r < 16; ++r) { const int orow = crow(r, hi);
#pragma unroll
    for (int d0 = 0; d0 < 4; ++d0) Ow[orow * LDO + d0 * 32] = f2bf(o[d0][r] * rli[r]); }
  __syncthreads();
#undef SLOAD
#undef SWRITE
#undef SWAIT
#undef RESC
#undef NAM
}
}

namespace ret {
constexpr int ST_PITCH = 528;
constexpr int OFF_VT = 0, VT_BYTES = 128 * 256, OFF_ST = 2 * VT_BYTES, ST_BYTES = 128 * ST_PITCH, RET_LDS = OFF_ST + ST_BYTES;
__device__ __forceinline__ int crow(int r, int hi) { return (r & 3) + 8 * (r >> 2) + 4 * hi; }

__device__ __forceinline__ unsigned ktoff(unsigned row, unsigned ch) { return 256u * row + 16u * (ch ^ (((row & 3u) << 2) | ((row >> 2) & 3u))); }
__device__ __forceinline__ void pprime_item(int item, const bf16* Qm, const bf16* KVT, bf16* PP, const float* lg2f, const float* lg2b, char* lds) {
  int tid_ = threadIdx.x; asm volatile("" : "+v"(tid_));
  const int tid = tid_, wid = __builtin_amdgcn_readfirstlane(tid >> 6), lane = tid & 63, r32 = lane & 31, hi = lane >> 5;
  const int bh = item >> 5, n = item & 31, b = bh >> 3, h = bh & 7;
  const int T0 = b * 4096 + n * 128;
  const int kb = wid >> 1, qb0 = 2 * (wid & 1);
  LAS unsigned char* ldsl = (LAS unsigned char*)lds;
  const char* kg = (const char*)(KVT + (size_t)(h * 256) * 16384 + T0);
#pragma unroll
  for (int i = 0; i < 8; ++i) { const unsigned d = 32u * wid + 4u * i + (lane >> 4); const unsigned ch = (lane & 15u) ^ (((d & 3u) << 2) | ((d >> 2) & 3u));
    __builtin_amdgcn_global_load_lds((const unsigned*)(kg + (size_t)d * 32768 + ch * 16), (LAS unsigned*)(ldsl + (8 * wid + i) * 1024), 16, 0, 0); }
  const bf16* Q0 = Qm + (size_t)(T0 + 32 * qb0 + r32) * 2048 + h * 256 + 8 * hi;
  bf16x8 q0[16], q1[16];
#pragma unroll
  for (int s = 0; s < 16; ++s) { q0[s] = *reinterpret_cast<const bf16x8*>(Q0 + 16 * s); q1[s] = *reinterpret_cast<const bf16x8*>(Q0 + (size_t)32 * 2048 + 16 * s); }
  asm volatile("s_waitcnt vmcnt(0)" ::: "memory");
  __builtin_amdgcn_s_barrier(); asm volatile("" ::: "memory");
  const unsigned blk = (lane >> 4) & 1u, qq = (lane & 15u) >> 2, pp = lane & 3u;
  const unsigned ldsb = (unsigned)(size_t)ldsl;
  f32x16 acc0 = {}, acc1 = {};
#pragma unroll
  for (int ks = 0; ks < 16; ++ks) {
    const unsigned a0 = ldsb + ktoff(16u * ks + 8u * hi + qq, 4u * kb + 2u * blk + (pp >> 1)) + 8u * (pp & 1u);
    const unsigned a1 = ldsb + ktoff(16u * ks + 8u * hi + 4u + qq, 4u * kb + 2u * blk + (pp >> 1)) + 8u * (pp & 1u);
    s16x4 lo, hi4;
    asm volatile("ds_read_b64_tr_b16 %0, %2\n\tds_read_b64_tr_b16 %1, %3\n\ts_waitcnt lgkmcnt(0)" : "=&v"(lo), "=&v"(hi4) : "v"(a0), "v"(a1) : "memory");
    const bf16x8 a = (bf16x8){lo[0], lo[1], lo[2], lo[3], hi4[0], hi4[1], hi4[2], hi4[3]};
    acc0 = __builtin_amdgcn_mfma_f32_32x32x16_bf16(a, q0[ks], acc0, 0, 0, 0);
    acc1 = __builtin_amdgcn_mfma_f32_32x32x16_bf16(a, q1[ks], acc1, 0, 0, 0);
  }
  const float lf = lg2f[h], lb = lg2b[h];
  bf16* Pf = PP + ((size_t)(bh * 32 + n) * 128) * 128;
  bf16* Pb = Pf + (size_t)1024 * 128 * 128;
#pragma unroll
  for (int t = 0; t < 2; ++t) {
    const int q = 32 * (qb0 + t) + r32;
#pragma unroll
    for (int g = 0; g < 4; ++g) {
      const int k0 = 32 * kb + 8 * g + 4 * hi;
      float vf[4], vb[4];
#pragma unroll
      for (int j = 0; j < 4; ++j) { const int k = k0 + j; const float sc = t ? acc1[4 * g + j] : acc0[4 * g + j];
        vf[j] = (k <= q) ? sc * __builtin_amdgcn_exp2f(-lf * (float)(k + 1)) : 0.f;
        vb[j] = (k > q) ? sc * __builtin_amdgcn_exp2f(lb * (float)(k - 128)) : 0.f; }
      u32x2 wf = {cvt_pk_bf16(vf[0], vf[1]), cvt_pk_bf16(vf[2], vf[3])}, wb = {cvt_pk_bf16(vb[0], vb[1]), cvt_pk_bf16(vb[2], vb[3])};
      *reinterpret_cast<u32x2*>(Pf + (size_t)q * 128 + k0) = wf;
      *reinterpret_cast<u32x2*>(Pb + (size_t)q * 128 + k0) = wb;
    }
  }
  asm volatile("s_waitcnt lgkmcnt(0)" ::: "memory"); __builtin_amdgcn_s_barrier(); asm volatile("" ::: "memory");
}

__device__ __forceinline__ void chain_item(int item, const bf16* Qm, const bf16* KVT, const bf16* PP, bf16* Rf, bf16* Rb, const float* lg2f, const float* lg2b, char* lds) {
  int tid_ = threadIdx.x; asm volatile("" : "+v"(tid_));
  const int tid = tid_, wid = __builtin_amdgcn_readfirstlane(tid >> 6), lane = tid & 63, r32 = lane & 31, hi = lane >> 5;
  const int j = item & 3, dir = (item >> 2) & 1, bh = item >> 3, b = bh >> 3, h = bh & 7;
  const float lg2 = dir ? lg2b[h] : lg2f[h];
  const float cdec = __builtin_amdgcn_exp2f(lg2 * 128.f);
  bf16* Rout = dir ? Rb : Rf;
  const bf16* VTg = KVT + (size_t)(2048 + h * 512 + 128 * j) * 16384;
  const bf16* KTg = KVT + (size_t)(h * 256) * 16384;
  const bf16* PPd = PP + (size_t)dir * 1024 * 128 * 128 + (size_t)(bh * 32) * 128 * 128;
  char* STl = lds + OFF_ST;
  { unsigned z = 0u; asm volatile("" : "+v"(z));
    for (int i = tid; i < ST_BYTES / 16; i += 512) *reinterpret_cast<u32x4*>(STl + i * 16) = (u32x4){z, z, z, z}; }
  unsigned vsrc[4];
#pragma unroll
  for (int i = 0; i < 4; ++i) { const int v = 16 * wid + 4 * i + (lane >> 4); vsrc[i] = (unsigned)v * 32768u + (unsigned)(((lane & 15) ^ (v & 15)) * 16); }
#define VDMA(T0, buf) do { const char* vg = (const char*)(VTg + (T0)); _Pragma("unroll") for (int i = 0; i < 4; ++i) \
      __builtin_amdgcn_global_load_lds((const unsigned*)(vg + vsrc[i]), (LAS unsigned*)(ldsl + OFF_VT + (buf) * VT_BYTES + (4 * wid + i) * 1024), 16, 0, 0); } while (0)
  LAS unsigned char* ldsl = (LAS unsigned char*)lds;
  { const int n0 = dir ? 31 : 0; VDMA(b * 4096 + n0 * 128, 0); asm volatile("s_waitcnt vmcnt(0)" ::: "memory"); }
#define WGBAR() do { asm volatile("s_waitcnt lgkmcnt(0)" ::: "memory"); __builtin_amdgcn_s_barrier(); asm volatile("" ::: "memory"); } while (0)
  WGBAR();
  if (wid < 4) {
#ifndef RET_NO_Q
    const int qb = wid; int buf = 0;
    bf16x8 pf[8], qf[16];
    { const int n = dir ? 31 : 0; const int T0 = b * 4096 + n * 128;
      const bf16* Qr = Qm + (size_t)(T0 + 32 * qb + r32) * 2048 + h * 256 + 8 * hi; const bf16* Pr = PPd + ((size_t)n * 128 + 32 * qb + r32) * 128 + 8 * hi;
#pragma unroll
      for (int s = 0; s < 8; ++s) pf[s] = *reinterpret_cast<const bf16x8*>(Pr + 16 * s);
#pragma unroll
      for (int s = 0; s < 16; ++s) qf[s] = *reinterpret_cast<const bf16x8*>(Qr + 16 * s); }
    const int vrow = r32 * 256 + ((hi ^ (r32 & 1)) << 4), vx = (r32 & 14) << 4, srow = r32 * ST_PITCH + 16 * hi;
    for (int ci = 0; ci < 32; ++ci) {
      const int n = dir ? 31 - ci : ci; const int T0 = b * 4096 + n * 128;
      const int nn = dir ? n - 1 : n + 1; const int T1 = b * 4096 + nn * 128;
      if (ci < 31) VDMA(T1, buf ^ 1);
      const char* VTl = lds + OFF_VT + buf * VT_BYTES + vrow; const char* STr = STl + srow;
      f32x16 o[4];
#pragma unroll
      for (int v = 0; v < 4; ++v) o[v] = f32x16{};
      bf16x8 b0[4];
#define RB(dst, t) do { _Pragma("unroll") for (int v = 0; v < 4; ++v) dst[v] = ((t) < 8) ? *reinterpret_cast<const bf16x8*>(VTl + (32 * v) * 256 + ((32 * (t)) ^ vx)) : *reinterpret_cast<const bf16x8*>(STr + (32 * v) * ST_PITCH + 32 * ((t) - 8)); } while (0)
#define RA(t) (((t) < 8) ? pf[(t) & 7] : qf[((t) - 8) & 15])
#pragma unroll
      for (int t = 0; t < 24; ++t) {
        RB(b0, t);
#pragma unroll
        for (int v = 0; v < 4; ++v) o[v] = __builtin_amdgcn_mfma_f32_32x32x16_bf16(RA(t), b0[v], o[v], 0, 0, 0);
        SBAR();
        if (t == 7 && ci < 31) {
          const bf16* Pr = PPd + ((size_t)nn * 128 + 32 * qb + r32) * 128 + 8 * hi;
#pragma unroll
          for (int s = 0; s < 8; ++s) pf[s] = *reinterpret_cast<const bf16x8*>(Pr + 16 * s);
          asm volatile("s_waitcnt vmcnt(8)" ::: "memory");
          SBAR(); }
      }
#undef RB
#undef RA
      if (ci < 31) {
        const bf16* Qr = Qm + (size_t)(T1 + 32 * qb + r32) * 2048 + h * 256 + 8 * hi;
#pragma unroll
        for (int s = 0; s < 16; ++s) qf[s] = *reinterpret_cast<const bf16x8*>(Qr + 16 * s); }
      WGBAR();
      float lgc = lg2; asm volatile("" : "+v"(lgc));
#pragma unroll
      for (int r = 0; r < 16; ++r) { const int q = 32 * qb + crow(r, hi);
        const float qd = __builtin_amdgcn_exp2f(dir ? lgc * (float)(128 - q) : lgc * (float)(q + 1));
        bf16* orow = Rout + (size_t)(T0 + q) * 4096 + h * 512 + 128 * j + r32;
#pragma unroll
        for (int v = 0; v < 4; ++v) orow[32 * v] = f2bf(o[v][r] * qd); }
      WGBAR();
      buf ^= 1;
    }
#endif
  } else {
#ifndef RET_NO_S
    const int sw = wid - 4; int buf = 0;
    f32x16 st[2][4];
#pragma unroll
    for (int a = 0; a < 2; ++a)
#pragma unroll
      for (int v = 0; v < 4; ++v) st[a][v] = f32x16{};
    u32x4 kr0[8], kr1[8];
    const bf16* Kl = KTg + (size_t)(64 * sw + r32) * 16384 + 8 * hi;
    { const int n = dir ? 31 : 0; const bf16* K0 = Kl + b * 4096 + n * 128;
#pragma unroll
      for (int s = 0; s < 4; ++s) { kr0[s] = *reinterpret_cast<const u32x4*>(K0 + 16 * s); kr1[s] = *reinterpret_cast<const u32x4*>(K0 + (size_t)32 * 16384 + 16 * s); } }
    const int vrow = r32 * 256 + ((hi ^ (r32 & 1)) << 4), vx = (r32 & 14) << 4;
    for (int ci = 0; ci < 32; ++ci) {
      const int n = dir ? 31 - ci : ci;
      const int nn = dir ? n - 1 : n + 1; const int T1 = b * 4096 + nn * 128;
      if (ci < 31) VDMA(T1, buf ^ 1);
      const char* VTl = lds + OFF_VT + buf * VT_BYTES + vrow;
      { const bf16* K0 = Kl + b * 4096 + n * 128;
#pragma unroll
        for (int s = 4; s < 8; ++s) { kr0[s] = *reinterpret_cast<const u32x4*>(K0 + 16 * s); kr1[s] = *reinterpret_cast<const u32x4*>(K0 + (size_t)32 * 16384 + 16 * s); } }
      float lgc = lg2; asm volatile("" : "+v"(lgc));
      const float hb = lgc * (float)(8 * hi);
#pragma unroll
      for (int s = 0; s < 8; ++s) {
        const u32x4 a0 = kr0[s], a1 = kr1[s];
        float kf[8];
#pragma unroll
        for (int e = 0; e < 8; ++e) kf[e] = __builtin_amdgcn_exp2f(dir ? (lgc * (float)(16 * s + e - 128) + hb) : -(lgc * (float)(16 * s + e + 1) + hb));
        u32x4 w0, w1;
        w0.x = cvt_pk_bf16(bf_lo(a0.x) * kf[0], bf_hi(a0.x) * kf[1]); w0.y = cvt_pk_bf16(bf_lo(a0.y) * kf[2], bf_hi(a0.y) * kf[3]); w0.z = cvt_pk_bf16(bf_lo(a0.z) * kf[4], bf_hi(a0.z) * kf[5]); w0.w = cvt_pk_bf16(bf_lo(a0.w) * kf[6], bf_hi(a0.w) * kf[7]);
        w1.x = cvt_pk_bf16(bf_lo(a1.x) * kf[0], bf_hi(a1.x) * kf[1]); w1.y = cvt_pk_bf16(bf_lo(a1.y) * kf[2], bf_hi(a1.y) * kf[3]); w1.z = cvt_pk_bf16(bf_lo(a1.z) * kf[4], bf_hi(a1.z) * kf[5]); w1.w = cvt_pk_bf16(bf_lo(a1.w) * kf[6], bf_hi(a1.w) * kf[7]);
        const bf16x8 f0 = __builtin_bit_cast(bf16x8, w0), f1 = __builtin_bit_cast(bf16x8, w1);
#pragma unroll
        for (int v = 0; v < 4; ++v) { const bf16x8 bv = *reinterpret_cast<const bf16x8*>(VTl + (32 * v) * 256 + ((32 * s) ^ vx));
          st[0][v] = __builtin_amdgcn_mfma_f32_32x32x16_bf16(f0, bv, st[0][v], 0, 0, 0);
          st[1][v] = __builtin_amdgcn_mfma_f32_32x32x16_bf16(f1, bv, st[1][v], 0, 0, 0); }
        SBAR();
      }
      asm volatile("s_waitcnt vmcnt(0)" ::: "memory");
      if (ci < 31) { const bf16* K0 = Kl + T1;
#pragma unroll
        for (int s = 0; s < 4; ++s) { kr0[s] = *reinterpret_cast<const u32x4*>(K0 + 16 * s); kr1[s] = *reinterpret_cast<const u32x4*>(K0 + (size_t)32 * 16384 + 16 * s); } }
#pragma unroll
      for (int a = 0; a < 2; ++a)
#pragma unroll
        for (int v = 0; v < 4; ++v) st[a][v] = st[a][v] * cdec;
      WGBAR();
#pragma unroll
      for (int a = 0; a < 2; ++a)
#pragma unroll
        for (int v = 0; v < 4; ++v)
#pragma unroll
          for (int g = 0; g < 4; ++g) { const int d = 64 * sw + 32 * a + 8 * g + 4 * hi;
            u32x2 w = {cvt_pk_bf16(st[a][v][4 * g + 0], st[a][v][4 * g + 1]), cvt_pk_bf16(st[a][v][4 * g + 2], st[a][v][4 * g + 3])};
            *reinterpret_cast<u32x2*>(STl + (32 * v + r32) * ST_PITCH + d * 2) = w; }
      WGBAR();
      buf ^= 1;
    }
#endif
  }
  WGBAR();
#undef WGBAR
#undef VDMA
}
}

#ifndef PHMASK
#define PHMASK 0xFFFFFFFFu
#endif
#define PH(k) ((PHMASK >> (k)) & 1u)
#ifndef REPMASK
#define REPMASK 0u
#endif
#define PHASE_OPQ int tid_o = threadIdx.x; asm volatile("" : "+v"(tid_o)); const int ptid = tid_o, plane = tid_o & 63; (void)ptid; (void)plane; int gwp = gw, ngwp = NGW, pbx = blockIdx.x, pvcu = F.vcu, pG = F.G; asm volatile("" : "+s"(gwp), "+s"(ngwp), "+s"(pbx), "+s"(pvcu), "+s"(pG)); (void)gwp; (void)ngwp; (void)pbx; (void)pvcu; (void)pG;
#if REPMASK == 0u
#define PHASE_BEGIN(k) if (PH(k)) { PHASE_OPQ
#else
#define PHASE_BEGIN(k) if (PH(k)) for (int rep_ = 0; rep_ <= (int)((REPMASK >> (k)) & 1u); ++rep_) { if (rep_) xcd_barrier(bar); PHASE_OPQ
#endif
#if defined(STAMP_A) && defined(STAMP_B)
#ifndef STAMP_AMP
#define STAMP_AMP 8
#endif
#define STAMP() do { if (threadIdx.x == 0 && blockIdx.x == 0) { const unsigned n_ = F.MISC[400]; F.MISC[401 + n_] = (unsigned)__builtin_amdgcn_s_memrealtime(); F.MISC[400] = n_ + 1u; } } while (0)
#else
#define STAMP() do { } while (0)
#endif
#define GBAR() do { xcd_barrier(bar); STAMP(); } while (0)
constexpr int NTOK = 16384, SEQ = 4096, DM = 2048, NWAVES = 8;
constexpr float DN_ALPHA = 1.4142135623730951f;
constexpr float LN_EPS = 1e-5f, RMS_EPS = 1e-6f;
constexpr size_t MiB = 1u << 20;
constexpr size_t WS_CTL = 0, CTL_ZERO_BYTES = 1 * MiB;
constexpr int CW_BAR = 4096;
constexpr int CW_CNT = 8192;
constexpr size_t WS_ABIN = 1 * MiB;
constexpr size_t WS_UQ   = 17 * MiB;
constexpr size_t WS_UKV  = WS_UQ + 1536 * 512 * 2;
constexpr size_t WS_ABOUT = WS_UKV + 2048 * 256 * 2;
constexpr size_t WS_CIN  = WS_ABOUT + 8 * MiB;
constexpr size_t WS_COUT = WS_CIN + 48 * MiB;
constexpr size_t WS_PLEG = WS_COUT + 16 * MiB;
constexpr size_t WS_PLEP = WS_PLEG + 18 * MiB;
constexpr size_t WS_TAB  = WS_PLEP + 2 * MiB;
constexpr size_t WS_PB   = WS_TAB + 10 * MiB;
constexpr size_t WS_GU   = WS_PB + 16 * MiB;
constexpr size_t WS_DN   = WS_GU + 128 * MiB;
constexpr size_t WS_XB   = WS_DN + 64 * MiB;
constexpr size_t WS_AR   = WS_XB + 64 * MiB;
static_assert(WS_AR == 393 * MiB + 512 * 1024, "map");
constexpr size_t A_H = WS_AR, A_Q = A_H + 128 * MiB, A_KV = A_Q + 48 * MiB, A_AO = A_KV + 64 * MiB, A_KPE = A_AO + 64 * MiB, A_CQN = A_KPE + 2 * MiB, A_CKVN = A_CQN + 16 * MiB;
constexpr size_t C_HB = WS_AR, C_PROJ = WS_AR + 128 * MiB, C_YB = C_PROJ + 64 * MiB, C_PLE = C_YB + 160 * MiB, C_LOG = C_PLE + 64 * MiB, C_RT = C_LOG + 4 * MiB;
static_assert(C_RT + 2 * MiB <= WS_AR + 704 * MiB, "arena");
constexpr size_t B_Q = WS_AR, B_KVT = B_Q + 64 * MiB, B_G = B_KVT + 192 * MiB, B_PP = B_G + 128 * MiB, B_K = B_PP + 64 * MiB, B_RF = B_K, B_RB = B_RF + 128 * MiB, B_A = WS_AR, WS_END = B_RB + 128 * MiB;
constexpr int MAXSLOT = 40960;
constexpr size_t RT_E = 0, RT_W = RT_E + 16384 * 8, RT_R = RT_W + 16384 * 8, RT_S = RT_R + 16384 * 8, RT_ST = RT_S + 16384 * 8, RT_BC = RT_ST + 40960 * 4;
constexpr int RING_BYTES = 143360, MISC_OFF = RING_BYTES, LDS_BYTES = 147456;
static_assert(ret::RET_LDS <= RING_BYTES && att::ATT_LDS <= RING_BYTES && pg8::STAGE_BYTES <= RING_BYTES, "LDS map");

struct Frame {
    LAS unsigned char* lds; volatile LAS unsigned* MISC; unsigned* ctl;
    int tid, lane, wave, vcu, G;
};
__device__ __forceinline__ unsigned long long ld_ptr(const Frame& F, int k) {
    volatile LAS unsigned* p = F.MISC + 256 + 2 * k; const unsigned lo = __builtin_amdgcn_readfirstlane(p[0]), hi = __builtin_amdgcn_readfirstlane(p[1]);
    return ((unsigned long long)hi << 32) | lo;
}
#define INP(k) ((const float*)(GAS const float*)ld_ptr(F, (k)))
#define WSB() ((unsigned char*)(GAS unsigned char*)ld_ptr(F, 28))
#define OUTP() ((float*)(GAS float*)ld_ptr(F, 27))
struct Args { const float* in[27]; float* out; unsigned char* ws; };

constexpr int TR_WAVE_BYTES = 64 * 68 * 4;
__device__ __forceinline__ void transpose_item(const float* W, int ldw, bf16* WT, int ldt, int k0, int n0, int dst_row0, LAS float* scr, int lane) {
    const float* src = W + (size_t)(k0 + (lane >> 4)) * ldw + n0 + 4 * (lane & 15);
#pragma unroll
    for (int i = 0; i < 16; ++i) { const int kk = 4 * i + (lane >> 4); const f32x4 v = *(const f32x4*)(src + (size_t)(4 * i) * ldw);
        *(LAS f32x4*)(scr + kk * 68 + ((4 * (lane & 15)) ^ (((kk >> 3) & 7) << 2))) = v; }
    LDS_WAIT(); asm volatile("" ::: "memory");
    const int c = lane & 7;
#pragma unroll
    for (int j = 0; j < 8; ++j) { const int n = (lane >> 3) + 8 * j; const LAS float* p = scr + (8 * c) * 68 + (n ^ (c << 2));
        v4u o; o.x = cvt_pk_bf16(p[0 * 68], p[1 * 68]); o.y = cvt_pk_bf16(p[2 * 68], p[3 * 68]); o.z = cvt_pk_bf16(p[4 * 68], p[5 * 68]); o.w = cvt_pk_bf16(p[6 * 68], p[7 * 68]);
        *(v4u*)(WT + (size_t)(dst_row0 + n) * ldt + k0 + 8 * c) = o; }
    LDS_WAIT(); asm volatile("" ::: "memory");
}
__device__ __forceinline__ void transpose_plain(const float* W, int K, int N, bf16* WT, int item, LAS float* scr, int lane) {
    const int nblk = N / 64, kb = item / nblk, nb = item % nblk;
    transpose_item(W, N, WT, K, 64 * kb, 64 * nb, 64 * nb, scr, lane);
}
__device__ __forceinline__ void moe_item(int it, int lane, const float* wg, const float* wu, const float* wd, bf16* GU, bf16* DN, LAS float* scr) {
    const int which = it >> 13, r = it & 8191, e = r >> 8, q = r & 255;
    if (which < 2) { const int kb = q >> 3, n0 = 64 * (q & 7);
        transpose_item((which ? wu : wg) + (size_t)e * 2048 * 512, 512, GU, 2048, 64 * kb, n0, e * 1024 + (n0 >> 7) * 256 + (which ? 128 : 0) + (n0 & 127), scr, lane); }
    else { const int kb = q >> 5, n0 = 64 * (q & 31);
        transpose_item(wd + (size_t)e * 512 * 2048, 2048, DN, 512, 64 * kb, n0, e * 2048 + n0, scr, lane); }
}
__device__ __forceinline__ void cvt_rows(const Frame& F, int tid, const float* src, bf16* dst, size_t n8) {
    for (size_t i = (size_t)(F.vcu * 512 + tid); i < n8; i += (size_t)F.G * 512) {
        const f32x4 a = *(const f32x4*)(src + i * 8), b = *(const f32x4*)(src + i * 8 + 4);
        *(u32x4*)(dst + i * 8) = pg8::pack8(a, b); }
}
__device__ __forceinline__ void sincos_acc(int pos, float inv, float& c, float& s) {
    const double a = (double)pos * (double)inv; const double k = __builtin_rint(a * 0.15915494309189535); const float r = (float)(a - k * 6.283185307179586);
    s = sinf(r); c = cosf(r);
}

#define x_in INP(0)
#define p_in INP(1)
#define ab_w_in INP(2)
#define ab_rpb INP(3)
#define ab_q_norm INP(4)
#define ab_w_uq INP(5)
#define ab_kv_norm INP(6)
#define ab_w_ukv INP(7)
#define ab_w_out INP(8)
#define c_w_in INP(9)
#define c_lrf INP(10)
#define c_lrb INP(11)
#define c_w_out INP(12)
#define ln1_g INP(13)
#define ln1_b INP(14)
#define moe_w_group INP(15)
#define moe_b_group INP(16)
#define moe_w_router INP(17)
#define moe_b_router INP(18)
#define moe_w_gate INP(19)
#define moe_w_up INP(20)
#define moe_w_down INP(21)
#define ple_w_proj INP(22)
#define ple_w_gate INP(23)
#define ple_b_gate INP(24)
#define ln2_g INP(25)
#define ln2_b INP(26)
#define W_ABIN ((bf16*)(WSB() + WS_ABIN))
#define W_UQ ((bf16*)(WSB() + WS_UQ))
#define W_UKV ((bf16*)(WSB() + WS_UKV))
#define W_ABOUT ((bf16*)(WSB() + WS_ABOUT))
#define W_CIN ((bf16*)(WSB() + WS_CIN))
#define W_COUT ((bf16*)(WSB() + WS_COUT))
#define W_PLEG ((bf16*)(WSB() + WS_PLEG))
#define W_PLEP ((bf16*)(WSB() + WS_PLEP))
#define T_COSM ((float*)(WSB() + WS_TAB))
#define T_SINM (T_COSM + 4096 * 32)
#define T_COSR (T_COSM + 2 * 4096 * 32)
#define T_SINR (T_COSR + 4096 * 128)
#define T_COSRT (T_COSR + 2 * 4096 * 128)
#define T_SINRT (T_COSR + 3 * 4096 * 128)
#define T_LG (T_COSR + 4 * 4096 * 128)
#define PB ((bf16*)(WSB() + WS_PB))
#define W_GU ((bf16*)(WSB() + WS_GU))
#define W_DN ((bf16*)(WSB() + WS_DN))
#define XB ((bf16*)(WSB() + WS_XB))
#define PRE OUTP()
#define H ((bf16*)(WSB() + A_H))
#define Qb ((bf16*)(WSB() + A_Q))
#define KVb ((bf16*)(WSB() + A_KV))
#define AO ((bf16*)(WSB() + A_AO))
#define KPE ((bf16*)(WSB() + A_KPE))
#define CQN ((bf16*)(WSB() + A_CQN))
#define CKVN ((bf16*)(WSB() + A_CKVN))
#define Qm ((bf16*)(WSB() + B_Q))
#define KVT ((bf16*)(WSB() + B_KVT))
#define Gm ((bf16*)(WSB() + B_G))
#define PP ((bf16*)(WSB() + B_PP))
#define Km ((bf16*)(WSB() + B_K))
#define Rf ((bf16*)(WSB() + B_RF))
#define Rb ((bf16*)(WSB() + B_RB))
#define Am ((bf16*)(WSB() + B_A))
#define PROJ ((bf16*)(WSB() + C_PROJ))
#define HB ((bf16*)(WSB() + C_HB))
#define YB ((bf16*)(WSB() + C_YB))
#define PLE ((bf16*)(WSB() + C_PLE))
#define LOG ((float*)(WSB() + C_LOG))
#define TOK_E ((int*)(WSB() + C_RT + RT_E))
#define TOK_W ((float*)(WSB() + C_RT + RT_W))
#define TOK_R ((int*)(WSB() + C_RT + RT_R))
#define TOK_S ((int*)(WSB() + C_RT + RT_S))
#define SLOT_TOK ((int*)(WSB() + C_RT + RT_ST))
#define BLKCNT ((int*)(WSB() + C_RT + RT_BC))
__global__ void __launch_bounds__(512, 2) fwd_kernel(Args args) {
    extern __shared__ __attribute__((aligned(16))) unsigned char lds[];
    Frame F;
    F.lds = (LAS unsigned char*)lds; F.MISC = (volatile LAS unsigned*)(F.lds + MISC_OFF);
    F.tid = threadIdx.x; F.lane = F.tid & 63; F.wave = __builtin_amdgcn_readfirstlane(F.tid >> 6);
    F.G = gridDim.x; { const int bx = blockIdx.x; F.vcu = (F.G % 8 == 0) ? (bx % 8) * (F.G / 8) + bx / 8 : bx; }
    F.ctl = (unsigned*)(args.ws + WS_CTL);
    for (int u = F.tid; u < (LDS_BYTES - MISC_OFF) / 4; u += 512) ((LAS unsigned*)(F.lds + MISC_OFF))[u] = 0u;
    __syncthreads();
    if (F.tid == 0) {
#pragma unroll
        for (int i = 0; i < 27; ++i) { const unsigned long long v = (unsigned long long)args.in[i]; F.MISC[256 + 2 * i] = (unsigned)v; F.MISC[257 + 2 * i] = (unsigned)(v >> 32); }
        { const unsigned long long v = (unsigned long long)args.out; F.MISC[256 + 54] = (unsigned)v; F.MISC[257 + 54] = (unsigned)(v >> 32); }
        { const unsigned long long v = (unsigned long long)args.ws; F.MISC[256 + 56] = (unsigned)v; F.MISC[257 + 56] = (unsigned)(v >> 32); }
    }
    __syncthreads();
    XcdBarrier bar = xcd_barrier_post(F.ctl + CW_BAR, F.MISC + 8);
    STAMP();
    const int gw = F.vcu * NWAVES + F.wave, NGW = F.G * NWAVES;
    char* ldsg = (char*)lds;


        PHASE_BEGIN(0)
    {
        LAS float* scr = (LAS float*)(F.lds + F.wave * TR_WAVE_BYTES);
        constexpr int I_ABIN = 32 * 61, I_UQ = 8 * 24, I_UKV = 4 * 32, I_ABOUT = 32 * 32, I_CIN = 32 * 192, I_COUT = 64 * 32, I_PLEG = 32 * 32, I_PLEP = 4 * 32;
        constexpr int NIT = I_ABIN + I_UQ + I_UKV + I_ABOUT + I_CIN + I_COUT + 2 * I_PLEG + 2 * I_PLEP;
        for (int it = gwp; it < NIT + 3 * 8192; it += ngwp) {
            int r = it;
            if (r >= NIT) { moe_item(r - NIT, plane, moe_w_gate, moe_w_up, moe_w_down, W_GU, W_DN, scr); continue; }
            if (r < I_ABIN) { transpose_plain(ab_w_in, 2048, 3904, W_ABIN, r, scr, plane); continue; } r -= I_ABIN;
            if (r < I_UQ) { transpose_plain(ab_w_uq, 512, 1536, W_UQ, r, scr, plane); continue; } r -= I_UQ;
            if (r < I_UKV) { transpose_plain(ab_w_ukv, 256, 2048, W_UKV, r, scr, plane); continue; } r -= I_UKV;
            if (r < I_ABOUT) { transpose_plain(ab_w_out, 2048, 2048, W_ABOUT, r, scr, plane); continue; } r -= I_ABOUT;
            if (r < I_CIN) { transpose_plain(c_w_in, 2048, 12288, W_CIN, r, scr, plane); continue; } r -= I_CIN;
            if (r < I_COUT) { transpose_plain(c_w_out, 4096, 2048, W_COUT, r, scr, plane); continue; } r -= I_COUT;
            if (r < 2 * I_PLEG) { const int L = r / I_PLEG; transpose_plain(ple_w_gate + (size_t)L * 2048 * 2048, 2048, 2048, W_PLEG + (size_t)L * 2304 * 2048, r % I_PLEG, scr, plane); continue; } r -= 2 * I_PLEG;
            { const int L = r / I_PLEP; transpose_plain(ple_w_proj + (size_t)L * 256 * 2048, 256, 2048, W_PLEP + (size_t)L * 2048 * 256, r % I_PLEP, scr, plane); }
        }
        const size_t gt = (size_t)pvcu * 512 + ptid, GT = (size_t)pG * 512;
        for (size_t i = gt; i < (size_t)192 * 2048 / 8; i += GT) *(u32x4*)(W_ABIN + (size_t)3904 * 2048 + i * 8) = (u32x4){0u, 0u, 0u, 0u};
        for (size_t i = gt; i < (size_t)2 * 220 * 2048 / 8; i += GT) { const size_t L = i / (220 * 2048 / 8), r = i % (220 * 2048 / 8); *(u32x4*)(W_PLEG + (L * 2304 + 2084) * 2048 + r * 8) = (u32x4){0u, 0u, 0u, 0u}; }
        for (size_t i = gt; i < (size_t)2 * 36 * 2048; i += GT) { const int L = (int)(i / (36 * 2048)), r = (int)(i % (36 * 2048)), row = r / 2048, k = r % 2048;
            const float v = row < 4 ? moe_w_group[((size_t)L * 2048 + k) * 4 + row] : moe_w_router[(((size_t)L * 4 + ((row - 4) >> 3)) * 2048 + k) * 8 + ((row - 4) & 7)];
            W_PLEG[((size_t)L * 2304 + 2048 + row) * 2048 + k] = f2bf(v); }
        cvt_rows(F, ptid, x_in, XB, (size_t)NTOK * DM / 8);
        cvt_rows(F, ptid, p_in, PB, (size_t)2 * NTOK * 256 / 8);
        for (size_t i = gt; i < (size_t)4096 * 32; i += GT) { const int s = (int)(i >> 5), f = (int)(i & 31); float c, sn; sincos_acc(s, expf((float)(2 * f) * (-9.210340371976184f / 64.f)), c, sn); T_COSM[i] = c; T_SINM[i] = sn; }
        for (size_t i = gt; i < (size_t)4096 * 128; i += GT) { const int s = (int)(i >> 7), f = (int)(i & 127); float c, sn; sincos_acc(s, expf((float)(2 * f) * (-9.210340371976184f / 256.f)), c, sn);
            T_COSR[i] = c; T_SINR[i] = sn; T_COSRT[(size_t)f * 4096 + s] = c; T_SINRT[(size_t)f * 4096 + s] = sn; }
        if (gt < 16) { const float lr = gt < 8 ? c_lrf[gt] : c_lrb[gt - 8]; T_LG[gt] = log1pf(-expf(lr)) * 1.4426950408889634f; }
    }
        }
    GBAR();

#pragma unroll 1
    for (int L = 0; L < 2; ++L) {
        if (L == 0) {
        PHASE_BEGIN(1)
            { pg8::DenseOrder S{(const char*)XB, (const char*)W_ABIN, 2048, 64, 16, pG, pbx, 1 << 30, 0}; pg8::EpiPlain E{H, 4096};
              pg8::gemm_phase<pg8::EpiPlain, pg8::DenseOrder, true, false>(F.lds, 2048, S, E); }
        }
            GBAR();
        PHASE_BEGIN(2)
            for (int m = gwp; m < NTOK; m += ngwp) {
                const bf16* hr = H + (size_t)m * 4096;
                { const u32x4 w = *(const u32x4*)(hr + 3072 + 8 * plane); float v[8] = {bf_lo(w.x), bf_hi(w.x), bf_lo(w.y), bf_hi(w.y), bf_lo(w.z), bf_hi(w.z), bf_lo(w.w), bf_hi(w.w)};
                  float ss = 0.f;
#pragma unroll
                  for (int j = 0; j < 8; ++j) ss += v[j] * v[j];
                  const float rs = 1.0f / sqrtf(wave_sum(ss, plane) * (1.f / 512.f) + RMS_EPS);
                  const f32x4 g0 = *(const f32x4*)(ab_q_norm + 8 * plane), g1 = *(const f32x4*)(ab_q_norm + 8 * plane + 4);
                  const f32x4 o0 = {v[0] * rs * g0[0], v[1] * rs * g0[1], v[2] * rs * g0[2], v[3] * rs * g0[3]}, o1 = {v[4] * rs * g1[0], v[5] * rs * g1[1], v[6] * rs * g1[2], v[7] * rs * g1[3]};
                  *(u32x4*)(CQN + (size_t)m * 512 + 8 * plane) = pg8::pack8(o0, o1); }
                { const u32x2 w = *(const u32x2*)(hr + 3584 + 4 * plane); float v[4] = {bf_lo(w.x), bf_hi(w.x), bf_lo(w.y), bf_hi(w.y)};
                  const float ss = v[0] * v[0] + v[1] * v[1] + v[2] * v[2] + v[3] * v[3];
                  const float rs = 1.0f / sqrtf(wave_sum(ss, plane) * (1.f / 256.f) + RMS_EPS);
                  const f32x4 g0 = *(const f32x4*)(ab_kv_norm + 4 * plane);
                  u32x2 o; o.x = cvt_pk_bf16(v[0] * rs * g0[0], v[1] * rs * g0[1]); o.y = cvt_pk_bf16(v[2] * rs * g0[2], v[3] * rs * g0[3]);
                  *(u32x2*)(CKVN + (size_t)m * 256 + 4 * plane) = o; }
                { const int i = plane & 31, s = m & 4095; const float x1 = bf2f(hr[3840 + i]), x2 = bf2f(hr[3872 + i]); const float c = T_COSM[s * 32 + i], sn = T_SINM[s * 32 + i];
                  KPE[(size_t)m * 64 + plane] = f2bf(plane < 32 ? x1 * c - x2 * sn : x2 * c + x1 * sn); }
            }
        }
            GBAR();
        PHASE_BEGIN(3)
            { pg8::DenseOrder S{(const char*)CQN, (const char*)W_UQ, 512, 64, 6, pG, pbx, 1 << 30, 0}; pg8::EpiPlain E{Qb, 1536};
              pg8::gemm_phase<pg8::EpiPlain, pg8::DenseOrder, true, false>(F.lds, 512, S, E); }
            { pg8::DenseOrder S{(const char*)CKVN, (const char*)W_UKV, 256, 64, 8, pG, pbx, 1 << 30, 0}; pg8::EpiPlain E{KVb, 2048};
              pg8::gemm_phase<pg8::EpiPlain, pg8::DenseOrder, true, false>(F.lds, 256, S, E); }
        }
            GBAR();
        PHASE_BEGIN(4)
            for (int rep2_ = 0; rep2_ <= (int)((REPMASK >> 20) & 1u); ++rep2_) for (int it = pvcu; it < 512; it += pG) {
                const int bh = it >> 4, qb = it & 15, b = bh >> 3, h = bh & 7; const size_t t0 = (size_t)b * 4096 + qb * 256;
                att::AttnArgs A; A.Qp = Qb + t0 * 1536 + h * 192; A.Kp = KVb + (size_t)b * 4096 * 2048 + h * 256; A.Vp = A.Kp + 128;
                A.Pp = KPE + (size_t)b * 4096 * 64; A.Op = AO + t0 * 2048 + 1024 + h * 128; A.cosM = T_COSM; A.sinM = T_SINM; A.s0 = qb * 256; A.NT = 64; A.kr0 = 0; A.rg = 0;
                att::attn_item<0>(A, ldsg);
            }
            for (int rep2_ = 0; rep2_ <= (int)((REPMASK >> 21) & 1u); ++rep2_) for (int it = pvcu; it < 512; it += pG) {
                const int bh = it >> 4, rg = it & 15, b = bh >> 3, h = bh & 7; const size_t t0 = (size_t)b * 4096 + rg * 256;
                int klo = min(max(4 * rg - 4, 0), 56), khi = min(max(4 * rg - 1, 0), 56) + 7;
                if ((khi - klo + 1) & 1) { if (khi < 63) ++khi; else --klo; }
                for (int i = ptid; i < 465; i += 512) ((float*)(ldsg + att::OFF_BIAS))[i] = ab_rpb[h * 465 + i] * 11.313708498984761f;
                att::AttnArgs A; A.Qp = H + t0 * 4096 + h * 128; A.Kp = H + ((size_t)b * 4096 + klo * 64) * 4096 + 1024 + h * 128; A.Vp = A.Kp + 1024;
                A.Pp = nullptr; A.Op = AO + t0 * 2048 + h * 128; A.cosM = nullptr; A.sinM = nullptr; A.s0 = 0; A.NT = khi - klo + 1; A.kr0 = klo; A.rg = rg;
                att::attn_item<1>(A, ldsg);
            }
        }
            GBAR();
        } else {
        PHASE_BEGIN(6)
            { pg8::DenseOrder S{(const char*)XB, (const char*)W_CIN, 2048, 64, 24, pG, pbx, 8, 24}; pg8::EpiCinN E{Qm, Gm, T_COSR, T_SINR};
              pg8::gemm_phase<pg8::EpiCinN, pg8::DenseOrder, true, false>(F.lds, 2048, S, E); }
            { pg8::DenseOrder S{(const char*)(W_CIN + (size_t)2048 * 2048), (const char*)XB, 2048, 24, 64, pG, pbx, 1 << 30, 0}; pg8::EpiCinT E{KVT, T_COSRT, T_SINRT};
              pg8::gemm_phase<pg8::EpiCinT, pg8::DenseOrder, true, false>(F.lds, 2048, S, E); }
        }
            GBAR();
        PHASE_BEGIN(7)
            for (int it = pvcu; it < 1024; it += pG) ret::pprime_item(it, Qm, KVT, PP, T_LG, T_LG + 8, ldsg);
            __syncthreads();
#ifdef STAMP_MID_B2
            STAMP();
#endif
            { int tid_q = threadIdx.x; asm volatile("" : "+v"(tid_q)); const int plane = tid_q & 63;
              LAS float* scr = (LAS float*)(F.lds + F.wave * TR_WAVE_BYTES);
              for (int it = gwp; it < 3 * 8192; it += ngwp) moe_item(it, plane, moe_w_gate + (size_t)32 * 2048 * 512, moe_w_up + (size_t)32 * 2048 * 512, moe_w_down + (size_t)32 * 512 * 2048, W_GU, W_DN, scr); }
        }
            GBAR();
        PHASE_BEGIN(8)
            for (int it = pvcu; it < 256; it += pG) ret::chain_item(it, Qm, KVT, PP, Rf, Rb, T_LG, T_LG + 8, ldsg);
        }
            GBAR();
        PHASE_BEGIN(9)
            for (int u = gwp; u < NTOK * 8; u += 4 * ngwp) {
                u32x4 a[4], bq[4], gq[4]; size_t off[4];
#pragma unroll
                for (int r = 0; r < 4; ++r) { const int uu = u + r * ngwp; off[r] = (size_t)(uu >> 3) * 4096 + (uu & 7) * 512 + 8 * plane;
                    a[r] = *(const u32x4*)(Rf + off[r]); bq[r] = *(const u32x4*)(Rb + off[r]); gq[r] = *(const u32x4*)(Gm + off[r]); }
#pragma unroll
                for (int r = 0; r < 4; ++r) {
                    float rr[8] = {bf_lo(a[r].x) + bf_lo(bq[r].x), bf_hi(a[r].x) + bf_hi(bq[r].x), bf_lo(a[r].y) + bf_lo(bq[r].y), bf_hi(a[r].y) + bf_hi(bq[r].y), bf_lo(a[r].z) + bf_lo(bq[r].z), bf_hi(a[r].z) + bf_hi(bq[r].z), bf_lo(a[r].w) + bf_lo(bq[r].w), bf_hi(a[r].w) + bf_hi(bq[r].w)};
                    const float g[8] = {bf_lo(gq[r].x), bf_hi(gq[r].x), bf_lo(gq[r].y), bf_hi(gq[r].y), bf_lo(gq[r].z), bf_hi(gq[r].z), bf_lo(gq[r].w), bf_hi(gq[r].w)};
                    float s = 0.f;
#pragma unroll
                    for (int j = 0; j < 8; ++j) s += rr[j];
                    const float mean = wave_sum(s, plane) * (1.f / 512.f); float s2 = 0.f;
#pragma unroll
                    for (int j = 0; j < 8; ++j) { rr[j] -= mean; s2 += rr[j] * rr[j]; }
                    const float rstd = 1.0f / sqrtf(wave_sum(s2, plane) * (1.f / 512.f) + LN_EPS);
                    f32x4 o0, o1;
#pragma unroll
                    for (int j = 0; j < 4; ++j) { o0[j] = g[j] * sigmoidf_(g[j]) * rr[j] * rstd; o1[j] = g[4 + j] * sigmoidf_(g[4 + j]) * rr[4 + j] * rstd; }
                    *(u32x4*)(Am + off[r]) = pg8::pack8(o0, o1);
                }
            }
        }
            GBAR();
        }
        PHASE_BEGIN(5)
        { pg8::DenseOrder S{(const char*)(L ? Am : AO), (const char*)(L ? W_COUT : W_ABOUT), L ? 4096 : 2048, 64, 8, pG, pbx, 1 << 30, 0}; pg8::EpiPre E{PRE, XB, DN_ALPHA};
          pg8::gemm_phase<pg8::EpiPre, pg8::DenseOrder, true, false>(F.lds, L ? 4096 : 2048, S, E); }
        { pg8::DenseOrder S{(const char*)(PB + (size_t)L * NTOK * 256), (const char*)(W_PLEP + (size_t)L * 2048 * 256), 256, 64, 8, pG, pbx, 1 << 30, 0}; pg8::EpiPlain E{PROJ, 2048};
          pg8::gemm_phase<pg8::EpiPlain, pg8::DenseOrder, true, false>(F.lds, 256, S, E); }
        }
        GBAR();
        PHASE_BEGIN(11)
        { int tid_q = threadIdx.x; asm volatile("" : "+v"(tid_q)); const int plane = tid_q & 63; int gwp = gw, ngwp = NGW; asm volatile("" : "+s"(gwp), "+s"(ngwp));
        for (int m = gwp; m < NTOK; m += 2 * ngwp) {
            f32x4 v[2][8]; float s[2] = {0.f, 0.f};
#pragma unroll
            for (int r = 0; r < 2; ++r) { const f32x4* xr = (const f32x4*)(PRE + (size_t)(m + r * ngwp) * DM) + plane;
#pragma unroll
                for (int j = 0; j < 8; ++j) v[r][j] = xr[64 * j]; }
#pragma unroll
            for (int r = 0; r < 2; ++r)
#pragma unroll
                for (int j = 0; j < 8; ++j) s[r] += (v[r][j][0] + v[r][j][1]) + (v[r][j][2] + v[r][j][3]);
            const float mean[2] = {wave_sum(s[0], plane) * (1.f / DM), wave_sum(s[1], plane) * (1.f / DM)}; float s2[2] = {0.f, 0.f};
#pragma unroll
            for (int r = 0; r < 2; ++r)
#pragma unroll
                for (int j = 0; j < 8; ++j) { v[r][j] = v[r][j] - mean[r]; s2[r] += (v[r][j][0] * v[r][j][0] + v[r][j][1] * v[r][j][1]) + (v[r][j][2] * v[r][j][2] + v[r][j][3] * v[r][j][3]); }
            const float rstd[2] = {1.0f / sqrtf(wave_sum(s2[0], plane) * (1.f / DM) + LN_EPS), 1.0f / sqrtf(wave_sum(s2[1], plane) * (1.f / DM) + LN_EPS)};
            const f32x4* gr = (const f32x4*)(ln1_g + L * DM) + plane; const f32x4* br = (const f32x4*)(ln1_b + L * DM) + plane;
#pragma unroll
            for (int j = 0; j < 8; ++j) { const f32x4 g = gr[64 * j], bb = br[64 * j];
#pragma unroll
                for (int r = 0; r < 2; ++r) { const f32x4 y = v[r][j] * rstd[r] * g + bb; u32x2 w; w.x = cvt_pk_bf16(y[0], y[1]); w.y = cvt_pk_bf16(y[2], y[3]); ((u32x2*)(XB + (size_t)(m + r * ngwp) * DM) + plane)[64 * j] = w; } }
        } }
        }
        GBAR();
        PHASE_BEGIN(12)
        { pg8::DenseOrder S{(const char*)XB, (const char*)(W_PLEG + (size_t)L * 2304 * 2048), 2048, 64, 9, pG, pbx, 1 << 30, 0}; pg8::EpiPle E{PLE, PROJ, ple_b_gate + L * DM, LOG};
          pg8::gemm_phase<pg8::EpiPle, pg8::DenseOrder, true, false>(F.lds, 2048, S, E); }
        }
        GBAR();
        PHASE_BEGIN(13)
        if (ptid < 64) {
            const int n = pvcu * 64 + ptid;
            const float* lg = LOG + (size_t)n * 64;
            float gl[4]; int gi = 0;
#pragma unroll
            for (int g = 0; g < 4; ++g) gl[g] = lg[g] + moe_b_group[L * 4 + g];
            float gm = gl[0];
#pragma unroll
            for (int g = 1; g < 4; ++g) if (gl[g] > gm) { gm = gl[g]; gi = g; }
            float gs = 0.f;
#pragma unroll
            for (int g = 0; g < 4; ++g) gs += expf(gl[g] - gm);
            const float pg = 1.0f / gs;
            float el[8];
#pragma unroll
            for (int e = 0; e < 8; ++e) el[e] = lg[4 + gi * 8 + e] + moe_b_router[(L * 4 + gi) * 8 + e];
            int i0 = 0; float m0 = el[0];
#pragma unroll
            for (int e = 1; e < 8; ++e) if (el[e] > m0) { m0 = el[e]; i0 = e; }
            int i1 = -1; float m1 = -3.0e38f;
#pragma unroll
            for (int e = 0; e < 8; ++e) if (e != i0 && el[e] > m1) { m1 = el[e]; i1 = e; }
            const float t1 = expf(m1 - m0), den = 1.0f / (1.0f + t1);
            const int e0 = gi * 8 + i0, e1 = gi * 8 + i1;
            int r0 = 0, r1 = 0, mycnt = 0; const unsigned long long ltm = (1ull << ptid) - 1ull;
#pragma unroll 1
            for (int e = 0; e < 32; ++e) {
                const unsigned long long b0 = __ballot(e0 == e), b1 = __ballot(e1 == e);
                const int below = __popcll(b0 & ltm) + __popcll(b1 & ltm);
                if (e0 == e) r0 = below; if (e1 == e) r1 = below;
                if (ptid == e) mycnt = __popcll(b0) + __popcll(b1);
            }
            TOK_E[2 * n] = e0; TOK_E[2 * n + 1] = e1; TOK_W[2 * n] = pg * den; TOK_W[2 * n + 1] = pg * t1 * den; TOK_R[2 * n] = r0; TOK_R[2 * n + 1] = r1;
            if (ptid < 32) BLKCNT[pvcu * 32 + ptid] = mycnt;
        }
        }
        GBAR();
        volatile LAS int* EOFF = (volatile LAS int*)(F.MISC + 16);
        PHASE_BEGIN(14)
        { volatile LAS int* red = (volatile LAS int*)F.lds;
          const int e = ptid & 31, grp = ptid >> 5; int tot = 0, bel = 0;
          for (int b2 = grp; b2 < pG; b2 += 16) { const int c = BLKCNT[b2 * 32 + e]; tot += c; bel += (b2 < pvcu) ? c : 0; }
          red[ptid] = tot; red[512 + ptid] = bel;
          __syncthreads();
          if (ptid < 32) { int t = 0, q = 0; for (int g = 0; g < 16; ++g) { t += red[g * 32 + ptid]; q += red[512 + g * 32 + ptid]; } red[1024 + ptid] = t; red[1056 + ptid] = q; }
          __syncthreads();
          if (ptid == 0) { int acc = 0; for (int q = 0; q < 32; ++q) { EOFF[q] = acc; acc += (red[1024 + q] + 255) & ~255; } EOFF[32] = acc; }
          __syncthreads();
          if (ptid < 64) { const int n = pvcu * 64 + ptid;
#pragma unroll
            for (int k = 0; k < 2; ++k) { const int ee = TOK_E[2 * n + k]; const int slot = EOFF[ee] + red[1056 + ee] + TOK_R[2 * n + k]; SLOT_TOK[slot] = n; TOK_S[2 * n + k] = slot; } }
          for (int ee = pvcu; ee < 32; ee += pG) { const int c = red[1024 + ee]; const int pe = (c + 255) & ~255;
            for (int i = c + ptid; i < pe; i += 512) SLOT_TOK[EOFF[ee] + i] = 0; }
          __syncthreads();
        }
        }
        GBAR();
        const int ntiles = EOFF[32] >> 8;
        PHASE_BEGIN(15)
        {
            struct MoeGU { const char* A; const char* Bt; const int* slot_tok; volatile LAS int* eoff; int nun, G, c;
                __device__ __forceinline__ bool next(int i, pg8::Unit& u) const { const long Lq = (long)i * G + c; if (Lq >= nun) return false; const int t = (int)(Lq >> 2), pn = (int)(Lq & 3);
                    int e = 0;
#pragma unroll 1
                    for (int q = 1; q < 32; ++q) if (eoff[q] <= t * 256) e = q;
                    u.pm = t; u.pn = pn; u.a = A; u.b = Bt + ((size_t)e * 1024 + pn * 256) * 2048 * 2; return true; }
                __device__ __forceinline__ void rows(const pg8::Unit& u, int R, int C, unsigned (&o0)[2], unsigned (&o1)[2]) const {
                    int Ro = R; asm volatile("" : "+v"(Ro));
                    const int* st = slot_tok + u.pm * 256 + Ro;
                    o0[0] = (unsigned)st[0] * 4096u + (unsigned)C * 2u; o0[1] = (unsigned)st[64] * 4096u + (unsigned)C * 2u; o1[0] = (unsigned)st[128] * 4096u + (unsigned)C * 2u; o1[1] = (unsigned)st[192] * 4096u + (unsigned)C * 2u; }
            } S{(const char*)XB, (const char*)W_GU, SLOT_TOK, EOFF, ntiles * 4, pG, pvcu};
            pg8::EpiGU E{HB};
            pg8::gemm_phase<pg8::EpiGU, MoeGU, true, true>(F.lds, 2048, S, E);
        }
        }
        GBAR();
        PHASE_BEGIN(16)
        {
            struct MoeDN { const char* A; const char* Bt; volatile LAS int* eoff; int nun, G, c;
                __device__ __forceinline__ bool next(int i, pg8::Unit& u) const { const long Lq = (long)i * G + c; if (Lq >= nun) return false; const int t = (int)(Lq >> 3), pn = (int)(Lq & 7);
                    int e = 0;
#pragma unroll 1
                    for (int q = 1; q < 32; ++q) if (eoff[q] <= t * 256) e = q;
                    u.pm = t; u.pn = pn; u.a = A + (size_t)t * 256 * 512 * 2; u.b = Bt + ((size_t)e * 2048 + pn * 256) * 512 * 2; return true; }
                __device__ __forceinline__ void rows(const pg8::Unit&, int, int, unsigned (&)[2], unsigned (&)[2]) const {}
            } S{(const char*)HB, (const char*)W_DN, EOFF, ntiles * 8, pG, pvcu};
            pg8::EpiPlain E{YB, 2048};
            pg8::gemm_phase<pg8::EpiPlain, MoeDN, true, false>(F.lds, 512, S, E);
        }
        }
        GBAR();
        PHASE_BEGIN(17)
        for (int m = gwp; m < NTOK; m += ngwp) {
            const int s0 = TOK_S[2 * m], s1 = TOK_S[2 * m + 1]; const float w0 = TOK_W[2 * m], w1 = TOK_W[2 * m + 1];
            const u32x4* xr = (const u32x4*)(XB + (size_t)m * DM) + plane; const u32x4* y0 = (const u32x4*)(YB + (size_t)s0 * DM) + plane; const u32x4* y1 = (const u32x4*)(YB + (size_t)s1 * DM) + plane;
            const u32x4* pr = (const u32x4*)(PLE + (size_t)m * DM) + plane;
            float v[4][8]; float s = 0.f;
#pragma unroll
            for (int j = 0; j < 4; ++j) { const u32x4 a = xr[64 * j], b0 = y0[64 * j], b1 = y1[64 * j], c = pr[64 * j];
                const unsigned aw[4] = {a.x, a.y, a.z, a.w}, b0w[4] = {b0.x, b0.y, b0.z, b0.w}, b1w[4] = {b1.x, b1.y, b1.z, b1.w}, cw[4] = {c.x, c.y, c.z, c.w};
#pragma unroll
                for (int q = 0; q < 4; ++q) { v[j][2 * q] = DN_ALPHA * bf_lo(aw[q]) + w0 * bf_lo(b0w[q]) + w1 * bf_lo(b1w[q]) + bf_lo(cw[q]); v[j][2 * q + 1] = DN_ALPHA * bf_hi(aw[q]) + w0 * bf_hi(b0w[q]) + w1 * bf_hi(b1w[q]) + bf_hi(cw[q]);
                    s += v[j][2 * q] + v[j][2 * q + 1]; } }
            const float mean = wave_sum(s, plane) * (1.f / DM); float s2 = 0.f;
#pragma unroll
            for (int j = 0; j < 4; ++j)
#pragma unroll
                for (int q = 0; q < 8; ++q) { v[j][q] -= mean; s2 += v[j][q] * v[j][q]; }
            const float rstd = 1.0f / sqrtf(wave_sum(s2, plane) * (1.f / DM) + LN_EPS);
            u32x4* ox = (u32x4*)(XB + (size_t)m * DM) + plane;
#pragma unroll
            for (int j = 0; j < 4; ++j) { const int c0 = 512 * j + 8 * plane;
                const f32x4 g0 = *(const f32x4*)(ln2_g + L * DM + c0), g1 = *(const f32x4*)(ln2_g + L * DM + c0 + 4), b0 = *(const f32x4*)(ln2_b + L * DM + c0), b1 = *(const f32x4*)(ln2_b + L * DM + c0 + 4);
                f32x4 y0v, y1v;
#pragma unroll
                for (int q = 0; q < 4; ++q) { y0v[q] = v[j][q] * rstd * g0[q] + b0[q]; y1v[q] = v[j][4 + q] * rstd * g1[q] + b1[q]; }
                if (L == 1) { *(f32x4*)(OUTP() + (size_t)m * DM + c0) = y0v; *(f32x4*)(OUTP() + (size_t)m * DM + c0 + 4) = y1v; }
                else ox[64 * j] = pg8::pack8(y0v, y1v); }
        }
        }
        if (L == 0) GBAR();
    }
#if defined(STAMP_A) && defined(STAMP_B)
    STAMP();
    if (threadIdx.x == 0 && blockIdx.x == 0) { const unsigned dt = F.MISC[401 + STAMP_B] - F.MISC[401 + STAMP_A]; const unsigned long long t0 = __builtin_amdgcn_s_memrealtime();
        while (__builtin_amdgcn_s_memrealtime() - t0 < (unsigned long long)dt * STAMP_AMP) __builtin_amdgcn_s_sleep(32); }
#endif
}

extern "C" void kernel_launch(void* const* d_in, const int* in_sizes, int n_in, void* d_out, int out_size, void* d_ws, size_t ws_size, hipStream_t stream) {
    static int grid = 0;
    if (grid == 0) {
        if (n_in != 27 || out_size != NTOK * DM || ws_size < WS_END) { fprintf(stderr, "kernel_launch: unexpected shapes (n_in %d out %d ws %zu need %zu)\n", n_in, out_size, ws_size, (size_t)WS_END); grid = -1; return; }
        int dev = 0, cus = 0;
        if (hipGetDevice(&dev) != hipSuccess || hipDeviceGetAttribute(&cus, hipDeviceAttributeMultiprocessorCount, dev) != hipSuccess) { grid = -1; return; }
        if (hipFuncSetAttribute((const void*)fwd_kernel, hipFuncAttributeMaxDynamicSharedMemorySize, LDS_BYTES) != hipSuccess) { grid = -1; return; }
        if (cus < 256) { fprintf(stderr, "kernel_launch: needs 256 CUs\n"); grid = -1; return; }
        grid = 256;
    }
    if (grid < 0) return;
    (void)hipMemsetAsync((char*)d_ws + WS_CTL, 0, CTL_ZERO_BYTES, stream);
    Args a{};
    for (int i = 0; i < 27; ++i) a.in[i] = (const float*)d_in[i];
    a.out = (float*)d_out; a.ws = (unsigned char*)d_ws;
    hipLaunchKernelGGL(fwd_kernel, dim3(grid), dim3(512), LDS_BYTES, stream, a);
}
```

```cpp
#include <hip/hip_runtime.h>
#include <cstdio>
#include <cstdint>

#define GAS __attribute__((address_space(1)))
#define LAS __attribute__((address_space(3)))
typedef unsigned short bf16;
typedef unsigned short bf16_t;
typedef short bf16x8 __attribute__((ext_vector_type(8)));
typedef short s16x4 __attribute__((ext_vector_type(4)));
typedef float f32x4 __attribute__((ext_vector_type(4)));
typedef float f32x2 __attribute__((ext_vector_type(2)));
typedef float f32x8 __attribute__((ext_vector_type(8)));
typedef float f32x16 __attribute__((ext_vector_type(16)));
typedef unsigned u32x4 __attribute__((ext_vector_type(4)));
typedef unsigned u32x2 __attribute__((ext_vector_type(2)));
typedef unsigned v4u __attribute__((ext_vector_type(4)));

#define LDS_WAIT() asm volatile("s_waitcnt lgkmcnt(0)" ::: "memory")
#define VM_WAIT() asm volatile("s_waitcnt vmcnt(0)" ::: "memory")
#define SBAR() __builtin_amdgcn_sched_barrier(0)

__device__ __forceinline__ unsigned cvt_pk_bf16(float lo, float hi) { unsigned r; asm volatile("v_cvt_pk_bf16_f32 %0, %1, %2" : "=v"(r) : "v"(lo), "v"(hi)); return r; }
__device__ __forceinline__ float bf_lo(unsigned w) { return __uint_as_float(w << 16); }
__device__ __forceinline__ float bf_hi(unsigned w) { return __uint_as_float(w & 0xffff0000u); }
__device__ __forceinline__ float bf2f(bf16 h) { return __uint_as_float(((unsigned)h) << 16); }
__device__ __forceinline__ bf16 f2bf(float f) { return (bf16)(cvt_pk_bf16(f, 0.f) & 0xffffu); }
__device__ __forceinline__ float dpp_add(float v, const int ctrl, const int row_mask) { return v; }
#define DPP_ADD(v, ctrl, rmask) ((v) + __int_as_float(__builtin_amdgcn_update_dpp(0, __float_as_int(v), (ctrl), (rmask), 0xF, false)))
__device__ __forceinline__ float wave_sum(float v, int) {
    v = DPP_ADD(v, 0xB1, 0xF);
    v = DPP_ADD(v, 0x4E, 0xF);
    v = DPP_ADD(v, 0x141, 0xF);
    v = DPP_ADD(v, 0x140, 0xF);
    v = DPP_ADD(v, 0x142, 0xA);
    v = DPP_ADD(v, 0x143, 0xC);
    return __int_as_float(__builtin_amdgcn_readlane(__float_as_int(v), 63));
}
__device__ __forceinline__ float fast_exp(float x) { return __builtin_amdgcn_exp2f(x * 1.4426950408889634f); }
__device__ __forceinline__ float sigmoidf_(float x) { return __builtin_amdgcn_rcpf(1.0f + fast_exp(-x)); }

#define XB_TMO      128
#define XB_XCNT(j)  (256  + 64 * (j))
#define XB_XSUB(j)  (1280 + 64 * (j))
#define XB_XGEN(j)  (2304 + 64 * (j))
#define XB_TOP      3328
#define XB_TOPGEN   3392
#define XCD_BAR_WORDS 3456
#define XB_SPIN_CAP (1u << 18)

__device__ __forceinline__ unsigned xb_ld(unsigned* p)              { return __hip_atomic_load(p, __ATOMIC_RELAXED, __HIP_MEMORY_SCOPE_AGENT); }
__device__ __forceinline__ unsigned xb_add(unsigned* p, unsigned v) { return __hip_atomic_fetch_add(p, v, __ATOMIC_RELAXED, __HIP_MEMORY_SCOPE_AGENT); }
__device__ __forceinline__ unsigned xb_xcc_id() { return (unsigned)__builtin_amdgcn_s_getreg((3 << 11) | 20) & 0xFu; }
#define XB_SPIN(cond, bar) do { unsigned _sp = 0; while (cond) { __builtin_amdgcn_s_sleep(1); \
    if ((++_sp & 255u) == 0u) { if (xb_ld(&(bar)[XB_TMO])) break; if (_sp > XB_SPIN_CAP) { atomicAdd(&(bar)[XB_TMO], 1u); break; } } } } while (0)

struct XcdBarrier { unsigned* bar; unsigned x; volatile LAS unsigned* st; };

__device__ __forceinline__ XcdBarrier xcd_barrier_post(unsigned* bar, volatile LAS unsigned* st) {
    XcdBarrier b; b.bar = bar; b.x = xb_xcc_id(); b.st = st;
    if (threadIdx.x == 0) (void)xb_add(&bar[XB_XCNT(b.x)], 1u);
    return b;
}
__device__ __forceinline__ void xcd_barrier_complete(unsigned* bar, unsigned x, unsigned& nloc, unsigned& nx) {
    const unsigned G = gridDim.x * gridDim.y * gridDim.z;
    unsigned sum, cnt, mine, sp = 0u;
    for (;;) {
        sum = 0u; cnt = 0u; mine = 0u;
#pragma unroll
        for (unsigned j = 0; j < 16; ++j) { const unsigned c = xb_ld(&bar[XB_XCNT(j)]); sum += c; cnt += (c > 0u) ? 1u : 0u; mine = (j == x) ? c : mine; }
        if (sum == G) break;
        __builtin_amdgcn_s_sleep(1);
        if ((++sp & 255u) == 0u) { if (xb_ld(&bar[XB_TMO])) break; if (sp > XB_SPIN_CAP) { atomicAdd(&bar[XB_TMO], 1u); break; } }
    }
    nloc = mine > 0u ? mine : 1u; nx = cnt > 0u ? cnt : 1u;
}
__device__ __forceinline__ void xcd_barrier(const XcdBarrier& b) {
    asm volatile("s_waitcnt vmcnt(0)" ::: "memory");
    __syncthreads();
    if (threadIdx.x == 0) {
        unsigned* bar = b.bar; asm volatile("" : "+s"(bar));
        __builtin_amdgcn_s_waitcnt(0);
        unsigned nloc = b.st[0], nx = b.st[1]; unsigned bx = b.x; asm volatile("" : "+s"(bx));
        if (nloc == 0u) { xcd_barrier_complete(bar, bx, nloc, nx); b.st[0] = nloc; b.st[1] = nx; }
        const unsigned old = xb_add(&bar[XB_XSUB(bx)], 1u);
        const unsigned gen = old / nloc;
        if (old + 1u == (gen + 1u) * nloc) {
            __builtin_amdgcn_fence(__ATOMIC_RELEASE, "agent");
            asm volatile("s_waitcnt vmcnt(0)" ::: "memory");
            const unsigned og = xb_add(&bar[XB_TOP], 1u);
            const unsigned tg = og / nx;
            if (og + 1u == (tg + 1u) * nx) xb_add(&bar[XB_TOPGEN], 1u);
            else XB_SPIN(xb_ld(&bar[XB_TOPGEN]) == tg, bar);
            __builtin_amdgcn_fence(__ATOMIC_ACQUIRE, "agent");
            xb_add(&bar[XB_XGEN(bx)], 1u);
            asm volatile("s_waitcnt vmcnt(0)" ::: "memory");
        } else {
            XB_SPIN(xb_ld(&bar[XB_XGEN(bx)]) == gen, bar);
            __builtin_amdgcn_fence(__ATOMIC_ACQUIRE, "agent");
            asm volatile("s_waitcnt vmcnt(0)" ::: "memory");
        }
    }
    __syncthreads();
}

namespace pg8 {
constexpr int BM = 256, BK = 64, HALF = 128, HTB = HALF * BK * 2, STAGE_BYTES = 8 * HTB, NXCD = 8, WGM = 8;
__host__ __device__ __forceinline__ int lds_byte(int r, int c) { const int st = (r >> 4) * 2 + (c >> 5), rr = r & 15, cc = c & 31, ob = rr * 64 + cc * 2; return st * 1024 + (ob ^ (((ob >> 9) & 1) << 5)); }
__host__ __device__ __forceinline__ void stage_rc(int b, int& R, int& C) { const int st = b / 1024, sb = b % 1024, swz = sb ^ (((sb >> 9) & 1) << 5); R = (st >> 1) * 16 + swz / 64; C = (st & 1) * 32 + (swz % 64) / 2; }
__host__ __device__ __forceinline__ int perm32(int rho) { const int n = rho >> 4, i = rho & 15; return 8 * (i >> 2) + 4 * n + (i & 3); }

struct Unit { const char* a; const char* b; int pm, pn; };

__device__ __forceinline__ bool static_tile(int i, int G, int c, int nM, int nN, int& pm, int& pn) {
    const int nwg = nM * nN; const long L = (long)i * G + c; if (L >= nwg) return false;
    int wgid = (int)L; { const int q = nwg / NXCD, r = nwg % NXCD, xcd = wgid % NXCD, off = wgid / NXCD; wgid = (xcd < r ? xcd * (q + 1) : r * (q + 1) + (xcd - r) * q) + off; }
    const int nig = WGM * nN, gid = wgid / nig, fm = gid * WGM, gsz = (nM - fm) < WGM ? (nM - fm) : WGM;
    pm = fm + ((wgid % nig) % gsz); pn = (wgid % nig) / gsz; return true;
}
struct DenseOrder {
    const char* A; const char* Bt; int K, nM, nN, G, c, split, skip;
    __device__ __forceinline__ bool next(int i, Unit& u) const {
        int pm, pn; if (!static_tile(i, G, c, nM, nN, pm, pn)) return false;
        const int pp = pn < split ? pn : pn + skip;
        u.pm = pm; u.pn = pn; u.a = A + (size_t)pm * 256 * K * 2; u.b = Bt + (size_t)pp * 256 * K * 2; return true;
    }
    __device__ __forceinline__ void rows(const Unit&, int, int, unsigned (&)[2], unsigned (&)[2]) const {}
};

template <class Epi, class Sched, bool ALIGN_EPI, bool GATHER>
__device__ __forceinline__ void gemm_phase(LAS unsigned char* lds, const int K, const Sched& S, const Epi& E) {
    int tid_ = threadIdx.x; asm volatile("" : "+v"(tid_));
    const int tid = tid_, wid = __builtin_amdgcn_readfirstlane(tid >> 6), lane = tid & 63, wr = wid >> 2, wc = wid & 3, fr = lane & 15, fq = lane >> 4;
    const int nt = K / BK;
    unsigned voffA[2], voffB[2]; int stR = 0, stC = 0;
#pragma unroll
    for (int i = 0; i < 2; ++i) { int R, C; stage_rc(tid * 16 + i * 8192, R, C); const int Rb = Epi::PERM ? ((R & ~31) + perm32(R & 31)) : R;
        voffA[i] = (unsigned)(R * K + C) * 2u; voffB[i] = (unsigned)(Rb * K + C) * 2u; if (i == 0) { stR = R; stC = C; } }
    const size_t kstep = (size_t)(BK * 2);
    const size_t hstep = (size_t)HALF * K * 2;
    const unsigned ldsw = (unsigned)wid * 1024u;
    const int aoff = lds_byte(wr * 64 + fr, fq * 8), boff = lds_byte(wc * 32 + fr, fq * 8);
    unsigned ga0[2] = {0u, 0u}, ga1[2] = {0u, 0u};
#define PG8_SA(b, h) (((b) * 2 + (h)) * HTB)
#define PG8_SB(b, h) ((4 + (b) * 2 + (h)) * HTB)
#define PG8_STAGE(bufoff, gbase, voff) do { _Pragma("unroll") for (int _i = 0; _i < 2; ++_i) \
        __builtin_amdgcn_global_load_lds((const unsigned*)((const char*)(gbase) + (voff)[_i]), (LAS unsigned*)(lds + (bufoff) + ldsw + _i * 8192), 16, 0, 0); } while (0)
#define PG8_STAGE_A(bufoff, gbase, h, nx) do { if constexpr (GATHER) { if (h) PG8_STAGE(bufoff, gbase, ga1); else PG8_STAGE(bufoff, gbase, ga0); } \
        else { PG8_STAGE(bufoff, (gbase) + (h) * hstep, voffA); } } while (0)
#define PG8_LDA(dst, b, h) do { _Pragma("unroll") for (int m = 0; m < 4; ++m) _Pragma("unroll") for (int k = 0; k < 2; ++k) dst[m][k] = *(const LAS bf16x8*)(lds + PG8_SA(b, h) + aoff + m * 2048 + k * 1024); } while (0)
#define PG8_LDB(dst, b, h) do { _Pragma("unroll") for (int n = 0; n < 2; ++n) _Pragma("unroll") for (int k = 0; k < 2; ++k) dst[n][k] = *(const LAS bf16x8*)(lds + PG8_SB(b, h) + boff + n * 2048 + k * 1024); } while (0)
#define PG8_MMA(ai, bj, At, Bt) do { __builtin_amdgcn_s_setprio(1); _Pragma("unroll") for (int m = 0; m < 4; ++m) _Pragma("unroll") for (int n = 0; n < 2; ++n) _Pragma("unroll") for (int k = 0; k < 2; ++k) \
        acc[ai][bj][m][n] = __builtin_amdgcn_mfma_f32_16x16x32_bf16(Bt[n][k], At[m][k], acc[ai][bj][m][n], 0, 0, 0); __builtin_amdgcn_s_setprio(0); } while (0)
#define PG8_WAIT_V(n) asm volatile("s_waitcnt vmcnt(" #n ")" ::: "memory")
#define PG8_WAIT_L(n) asm volatile("s_waitcnt lgkmcnt(" #n ")" ::: "memory")
#define PG8_BAR __builtin_amdgcn_s_barrier()
#define PG8_SCHED __builtin_amdgcn_sched_barrier(0)
    Unit cur, nxt; int ui = 0;
    if (!S.next(0, cur)) return;
    f32x4 acc[2][2][4][2];
#pragma unroll
    for (int a = 0; a < 2; ++a)
#pragma unroll
        for (int b = 0; b < 2; ++b)
#pragma unroll
            for (int m = 0; m < 4; ++m)
#pragma unroll
                for (int n = 0; n < 2; ++n) acc[a][b][m][n] = (f32x4){0.f, 0.f, 0.f, 0.f};
    bf16x8 At[4][2], B0[2][2], B1[2][2];
    const char* cA = cur.a; const char* cB = cur.b;
    if constexpr (GATHER) { S.rows(cur, stR, stC, ga0, ga1); }
    PG8_STAGE(PG8_SB(0, 0), cB, voffB); PG8_STAGE(PG8_SB(0, 1), cB + hstep, voffB); PG8_STAGE_A(PG8_SA(0, 0), cA, 0, false); PG8_STAGE_A(PG8_SA(0, 1), cA, 1, false);
    if (wr == 1) PG8_BAR;
    PG8_WAIT_V(2); PG8_BAR;
    PG8_STAGE(PG8_SB(1, 0), cB + kstep, voffB); PG8_STAGE_A(PG8_SA(1, 0), cA + kstep, 0, false); PG8_STAGE(PG8_SB(1, 1), cB + hstep + kstep, voffB);
    PG8_WAIT_V(6); PG8_BAR;
    for (;;) {
        const bool has_next = S.next(ui + 1, nxt);
        const char* nA = has_next ? nxt.a : cA; const char* nB = has_next ? nxt.b : cB;
#pragma unroll 1
        for (int t = 0; t < nt; t += 2) {
            const bool last = (t == nt - 2);
            const char* a1 = cA + (size_t)(t + 1) * kstep;
            const char* a2 = last ? nA : cA + (size_t)(t + 2) * kstep; const char* b2 = last ? nB : cB + (size_t)(t + 2) * kstep;
            const char* a3 = a2 + kstep; const char* b3 = b2 + kstep;
            PG8_LDB(B0, 0, 0); PG8_LDB(B1, 0, 1); PG8_SCHED; PG8_LDA(At, 0, 0); PG8_STAGE_A(PG8_SA(1, 1), a1, 1, false);
            if constexpr (GATHER) { if (last && has_next) S.rows(nxt, stR, stC, ga0, ga1); }
            PG8_WAIT_V(8); PG8_WAIT_L(0); PG8_BAR; PG8_MMA(0, 0, At, B0); PG8_MMA(0, 1, At, B1); PG8_BAR; PG8_SCHED;
            PG8_LDA(At, 0, 1); PG8_STAGE(PG8_SB(0, 0), b2, voffB); PG8_STAGE(PG8_SB(0, 1), b2 + hstep, voffB); PG8_STAGE_A(PG8_SA(0, 0), a2, 0, last);
            PG8_WAIT_V(8); PG8_WAIT_L(0); PG8_BAR; PG8_MMA(1, 0, At, B0); PG8_MMA(1, 1, At, B1); PG8_BAR; PG8_SCHED;
            PG8_LDB(B0, 1, 0); PG8_LDB(B1, 1, 1); PG8_SCHED; PG8_LDA(At, 1, 0); PG8_STAGE_A(PG8_SA(0, 1), a2, 1, last);
            PG8_WAIT_V(8); PG8_WAIT_L(0); PG8_BAR; PG8_MMA(0, 0, At, B0); PG8_MMA(0, 1, At, B1); PG8_BAR; PG8_SCHED;
            PG8_LDA(At, 1, 1); PG8_STAGE(PG8_SB(1, 0), b3, voffB); PG8_STAGE(PG8_SB(1, 1), b3 + hstep, voffB); PG8_STAGE_A(PG8_SA(1, 0), a3, 0, last);
            PG8_WAIT_V(8); PG8_WAIT_L(0); PG8_BAR; PG8_MMA(1, 0, At, B0); PG8_MMA(1, 1, At, B1); PG8_BAR; PG8_SCHED;
        }
        if constexpr (ALIGN_EPI) { if (wr == 0) PG8_BAR; }
        E(acc, cur, wr, wc, fr, fq);
        if (!has_next) break;
#pragma unroll
        for (int a = 0; a < 2; ++a)
#pragma unroll
            for (int b = 0; b < 2; ++b)
#pragma unroll
                for (int m = 0; m < 4; ++m)
#pragma unroll
                    for (int n = 0; n < 2; ++n) acc[a][b][m][n] = (f32x4){0.f, 0.f, 0.f, 0.f};
        cur = nxt; cA = nA; cB = nB; ++ui;
        if constexpr (ALIGN_EPI) { if (wr == 1) PG8_BAR; }
    }
    PG8_WAIT_V(0);
    if constexpr (!ALIGN_EPI) { if (wr == 0) PG8_BAR; }
    PG8_BAR;
#undef PG8_SA
#undef PG8_SB
#undef PG8_STAGE
#undef PG8_STAGE_A
#undef PG8_LDA
#undef PG8_LDB
#undef PG8_MMA
#undef PG8_WAIT_V
#undef PG8_WAIT_L
#undef PG8_BAR
#undef PG8_SCHED
}

__device__ __forceinline__ u32x4 pack8(const f32x4 v0, const f32x4 v1) { u32x4 w; w.x = cvt_pk_bf16(v0[0], v0[1]); w.y = cvt_pk_bf16(v0[2], v0[3]); w.z = cvt_pk_bf16(v1[0], v1[1]); w.w = cvt_pk_bf16(v1[2], v1[3]); return w; }

struct EpiPlain {
    static constexpr bool PERM = true;
    bf16_t* O; int ldc;
    __device__ __forceinline__ void operator()(const f32x4 (&acc)[2][2][4][2], const Unit& u, int wr, int wc, int fr, int fq) const {
        bf16_t* base = O + (size_t)u.pm * BM * ldc + u.pn * BM;
        const unsigned lo = (unsigned)((wr * 64 + fr) * ldc + wc * 32 + 8 * fq);
#pragma unroll
        for (int ai = 0; ai < 2; ++ai)
#pragma unroll
            for (int m = 0; m < 4; ++m)
#pragma unroll
                for (int bj = 0; bj < 2; ++bj) *(u32x4*)(base + (size_t)((ai * HALF + m * 16) * ldc + bj * HALF) + lo) = pack8(acc[ai][bj][m][0], acc[ai][bj][m][1]);
    }
};
struct EpiPre {
    static constexpr bool PERM = false;
    float* out; const bf16_t* xb; float alpha;
    __device__ __forceinline__ void operator()(const f32x4 (&acc)[2][2][4][2], const Unit& u, int wr, int wc, int fr, int fq) const {
        const size_t ub = (size_t)u.pm * BM * 2048 + u.pn * BM; float* ob = out + ub; const bf16_t* xbb = xb + ub;
        const unsigned lo = (unsigned)((wr * 64 + fr) * 2048 + wc * 32 + 4 * fq);
#pragma unroll
        for (int ai = 0; ai < 2; ++ai)
#pragma unroll
            for (int m = 0; m < 4; ++m)
#pragma unroll
                for (int bj = 0; bj < 2; ++bj)
#pragma unroll
                    for (int n = 0; n < 2; ++n) { const unsigned uo = (unsigned)((ai * HALF + m * 16) * 2048 + bj * HALF + n * 16);
                        const u32x2 xw = *(const u32x2*)(xbb + uo + lo);
                        f32x4 o; o[0] = alpha * bf_lo(xw.x) + acc[ai][bj][m][n][0]; o[1] = alpha * bf_hi(xw.x) + acc[ai][bj][m][n][1]; o[2] = alpha * bf_lo(xw.y) + acc[ai][bj][m][n][2]; o[3] = alpha * bf_hi(xw.y) + acc[ai][bj][m][n][3];
                        *(f32x4*)(ob + uo + lo) = o; }
    }
};
struct EpiCinN {
    static constexpr bool PERM = true;
    bf16_t* Q; bf16_t* G; const float* cs; const float* sn;
    __device__ __forceinline__ void operator()(const f32x4 (&acc)[2][2][4][2], const Unit& u, int wr, int wc, int fr, int fq) const {
        if (u.pn < 8) {
            bf16_t* base = Q + (size_t)u.pm * BM * 2048 + u.pn * 256;
            const int i0 = wc * 32 + 8 * fq; const unsigned lo = (unsigned)((wr * 64 + fr) * 2048 + i0);
            const int s0 = ((u.pm * BM) & 4095) + wr * 64 + fr;
            const unsigned to = (unsigned)(s0 * 128 + i0);
#pragma unroll
            for (int ai = 0; ai < 2; ++ai)
#pragma unroll
                for (int m = 0; m < 4; ++m) { const unsigned tt = to + (unsigned)((ai * HALF + m * 16) * 128);
                    const f32x4 c0 = *(const f32x4*)(cs + tt), c1 = *(const f32x4*)(cs + tt + 4), s0v = *(const f32x4*)(sn + tt), s1v = *(const f32x4*)(sn + tt + 4);
                    const f32x4 x10 = acc[ai][0][m][0], x11 = acc[ai][0][m][1], x20 = acc[ai][1][m][0], x21 = acc[ai][1][m][1];
                    const f32x4 o10 = x10 * c0 - x20 * s0v, o11 = x11 * c1 - x21 * s1v, o20 = x20 * c0 + x10 * s0v, o21 = x21 * c1 + x11 * s1v;
                    bf16_t* rowp = base + (size_t)((ai * HALF + m * 16) * 2048) + lo;
                    *(u32x4*)(rowp) = pack8(o10, o11); *(u32x4*)(rowp + 128) = pack8(o20, o21); }
        } else {
            bf16_t* base = G + (size_t)u.pm * BM * 4096 + (u.pn - 8) * BM; const unsigned lo = (unsigned)((wr * 64 + fr) * 4096 + wc * 32 + 8 * fq);
#pragma unroll
            for (int ai = 0; ai < 2; ++ai)
#pragma unroll
                for (int m = 0; m < 4; ++m)
#pragma unroll
                    for (int bj = 0; bj < 2; ++bj) *(u32x4*)(base + (size_t)((ai * HALF + m * 16) * 4096 + bj * HALF) + lo) = pack8(acc[ai][bj][m][0], acc[ai][bj][m][1]);
        }
    }
};
struct EpiCinT {
    static constexpr bool PERM = true;
    bf16_t* O; const float* csT; const float* snT;
    __device__ __forceinline__ void operator()(const f32x4 (&acc)[2][2][4][2], const Unit& u, int wr, int wc, int fr, int fq) const {
        bf16_t* base = O + (size_t)u.pm * BM * 16384 + u.pn * BM; const unsigned lo = (unsigned)((wr * 64 + fr) * 16384 + wc * 32 + 8 * fq);
        if (u.pm < 8) {
            const unsigned to = (unsigned)((wr * 64 + fr) * 4096 + ((u.pn * BM) & 4095) + wc * 32 + 8 * fq);
#pragma unroll
            for (int m = 0; m < 4; ++m)
#pragma unroll
                for (int bj = 0; bj < 2; ++bj) { const unsigned tt = to + (unsigned)(m * 16 * 4096 + bj * HALF);
                    const f32x4 c0 = *(const f32x4*)(csT + tt), c1 = *(const f32x4*)(csT + tt + 4), s0 = *(const f32x4*)(snT + tt), s1 = *(const f32x4*)(snT + tt + 4);
                    const f32x4 x10 = acc[0][bj][m][0], x11 = acc[0][bj][m][1], x20 = acc[1][bj][m][0], x21 = acc[1][bj][m][1];
                    const f32x4 o10 = (x10 * c0 - x20 * s0) * 0.0625f, o11 = (x11 * c1 - x21 * s1) * 0.0625f, o20 = (x20 * c0 + x10 * s0) * 0.0625f, o21 = (x21 * c1 + x11 * s1) * 0.0625f;
                    *(u32x4*)(base + (size_t)(m * 16 * 16384 + bj * HALF) + lo) = pack8(o10, o11);
                    *(u32x4*)(base + (size_t)((HALF + m * 16) * 16384 + bj * HALF) + lo) = pack8(o20, o21); }
        } else {
#pragma unroll
            for (int ai = 0; ai < 2; ++ai)
#pragma unroll
                for (int m = 0; m < 4; ++m)
#pragma unroll
                    for (int bj = 0; bj < 2; ++bj) *(u32x4*)(base + (size_t)((ai * HALF + m * 16) * 16384 + bj * HALF) + lo) = pack8(acc[ai][bj][m][0], acc[ai][bj][m][1]);
        }
    }
};
struct EpiPle {
    static constexpr bool PERM = true;
    bf16_t* PLE; const bf16_t* PROJ; const float* bias; float* LOG;
    __device__ __forceinline__ void operator()(const f32x4 (&acc)[2][2][4][2], const Unit& u, int wr, int wc, int fr, int fq) const {
        if (u.pn < 8) {
            const size_t ub = (size_t)u.pm * BM * 2048 + u.pn * BM; bf16_t* pb = PLE + ub; const bf16_t* jb = PROJ + ub; const float* bb = bias + u.pn * BM;
            const unsigned lo = (unsigned)((wr * 64 + fr) * 2048 + wc * 32 + 8 * fq), lc = (unsigned)(wc * 32 + 8 * fq);
#pragma unroll
            for (int bj = 0; bj < 2; ++bj) { const f32x4 bv0 = *(const f32x4*)(bb + lc + bj * HALF), bv1 = *(const f32x4*)(bb + lc + bj * HALF + 4);
#pragma unroll
                for (int ai = 0; ai < 2; ++ai)
#pragma unroll
                    for (int m = 0; m < 4; ++m) { const unsigned uo = (unsigned)((ai * HALF + m * 16) * 2048 + bj * HALF); const u32x4 pw = *(const u32x4*)(jb + uo + lo);
                        f32x4 v0 = acc[ai][bj][m][0] + bv0, v1 = acc[ai][bj][m][1] + bv1;
                        v0[0] = sigmoidf_(v0[0]) * bf_lo(pw.x); v0[1] = sigmoidf_(v0[1]) * bf_hi(pw.x); v0[2] = sigmoidf_(v0[2]) * bf_lo(pw.y); v0[3] = sigmoidf_(v0[3]) * bf_hi(pw.y);
                        v1[0] = sigmoidf_(v1[0]) * bf_lo(pw.z); v1[1] = sigmoidf_(v1[1]) * bf_hi(pw.z); v1[2] = sigmoidf_(v1[2]) * bf_lo(pw.w); v1[3] = sigmoidf_(v1[3]) * bf_hi(pw.w);
                        *(u32x4*)(pb + uo + lo) = pack8(v0, v1); } }
        } else if (wc < 2) {
            float* lb = LOG + (size_t)u.pm * BM * 64; const unsigned lo = (unsigned)((wr * 64 + fr) * 64 + wc * 32 + 8 * fq);
#pragma unroll
            for (int ai = 0; ai < 2; ++ai)
#pragma unroll
                for (int m = 0; m < 4; ++m) { float* rowp = lb + (ai * HALF + m * 16) * 64 + lo;
                    *(f32x4*)(rowp) = acc[ai][0][m][0]; *(f32x4*)(rowp + 4) = acc[ai][0][m][1]; }
        }
    }
};
struct EpiGU {
    static constexpr bool PERM = true;
    bf16_t* HB;
    __device__ __forceinline__ void operator()(const f32x4 (&acc)[2][2][4][2], const Unit& u, int wr, int wc, int fr, int fq) const {
        bf16_t* base = HB + (size_t)u.pm * BM * 512 + u.pn * 128; const unsigned lo = (unsigned)((wr * 64 + fr) * 512 + wc * 32 + 8 * fq);
#pragma unroll
        for (int ai = 0; ai < 2; ++ai)
#pragma unroll
            for (int m = 0; m < 4; ++m) { f32x4 h0, h1;
#pragma unroll
                for (int j = 0; j < 4; ++j) { const float g0 = acc[ai][0][m][0][j], g1 = acc[ai][0][m][1][j]; h0[j] = g0 * sigmoidf_(g0) * acc[ai][1][m][0][j]; h1[j] = g1 * sigmoidf_(g1) * acc[ai][1][m][1][j]; }
                *(u32x4*)(base + (size_t)((ai * HALF + m * 16) * 512) + lo) = pack8(h0, h1); }
    }
};
}

namespace att {
constexpr int KVBLK = 64;
constexpr int SHM_V = 16384, SHM_K = 16384, SHM_P = 8192;
constexpr int OFF_V = 0, OFF_K = 2 * SHM_V, OFF_P = OFF_K + 2 * SHM_K, OFF_WS = OFF_P + 2 * SHM_P, OFF_BIAS = OFF_WS + 8 * 64 * 4, OFF_QPE = OFF_BIAS + 512 * 4, ATT_LDS = OFF_QPE + 256 * 128;
#define KSWZ(row, colB) ((row) * 256 + ((colB) ^ (((row) & 7) << 4)))
#define PSWZ(row, colB) ((row) * 128 + ((colB) ^ (((row) & 7) << 4)))
__device__ __forceinline__ int crow(int r, int hi) { return (r & 3) + 8 * (r >> 2) + 4 * hi; }

template <int MODE> struct Cfg;
template <> struct Cfg<0> { static constexpr int NQ = 8; static constexpr float SCALE = 0.07216878364870323f; static constexpr int LDQ = 1536, LDK = 2048, LDO = 2048; };
template <> struct Cfg<1> { static constexpr int NQ = 8;  static constexpr float SCALE = 0.08838834764831845f; static constexpr int LDQ = 4096, LDK = 4096, LDO = 2048; };
constexpr float THRN = 8.f;

template <int MODE>
__device__ __forceinline__ void partialSM(f32x16& p0, f32x16& p1, float& m_reg, float& mn, float& alpha) {
  constexpr float SCALE = Cfg<MODE>::SCALE; constexpr float C = SCALE * 1.4426950408889634f;
  float pmax = p0[0];
#pragma unroll
  for (int r = 1; r < 16; ++r) pmax = fmaxf(pmax, p0[r]);
#pragma unroll
  for (int r = 0; r < 16; ++r) pmax = fmaxf(pmax, p1[r]);
  { auto rr = __builtin_amdgcn_permlane32_swap(__float_as_uint(pmax), __float_as_uint(pmax), false, false);
    pmax = fmaxf(__uint_as_float(rr[0]), __uint_as_float(rr[1])); }
  if (__builtin_expect(__all(pmax - m_reg <= THRN / SCALE), 1)) { mn = m_reg; alpha = 1.f; }
  else { mn = fmaxf(m_reg, pmax); alpha = __builtin_amdgcn_exp2f((m_reg - mn) * C); m_reg = mn; }
  float mnC = -mn * C;
#pragma unroll
  for (int r = 0; r < 16; ++r) p0[r] = fmaf(p0[r], C, mnC);
#pragma unroll
  for (int r = 0; r < 16; ++r) p1[r] = fmaf(p1[r], C, mnC);
#pragma unroll
  for (int r = 0; r < 16; ++r) p0[r] = __builtin_amdgcn_exp2f(p0[r]);
}
__device__ __forceinline__ void finishSM(f32x16& p0, f32x16& p1, float alpha, float& l_reg, bf16x8& pa0, bf16x8& pa1, bf16x8& pa2, bf16x8& pa3) {
#pragma unroll
  for (int r = 0; r < 16; ++r) p1[r] = __builtin_amdgcn_exp2f(p1[r]);
  float ps = 0;
#pragma unroll
  for (int r = 0; r < 16; ++r) ps += p0[r];
#pragma unroll
  for (int r = 0; r < 16; ++r) ps += p1[r];
  { auto rr = __builtin_amdgcn_permlane32_swap(__float_as_uint(ps), __float_as_uint(ps), false, false);
    ps = __uint_as_float(rr[0]) + __uint_as_float(rr[1]); }
  l_reg = l_reg * alpha + ps;
#define PK4(P, BASE, OUT) do { unsigned a0 = cvt_pk_bf16(P[BASE + 0], P[BASE + 1]), a1 = cvt_pk_bf16(P[BASE + 2], P[BASE + 3]);   \
    unsigned b0 = cvt_pk_bf16(P[BASE + 4], P[BASE + 5]), b1 = cvt_pk_bf16(P[BASE + 6], P[BASE + 7]);                              \
    auto r0 = __builtin_amdgcn_permlane32_swap(a0, b0, false, false); auto r1 = __builtin_amdgcn_permlane32_swap(a1, b1, false, false); \
    u32x4 w = {r0[0], r1[0], r0[1], r1[1]}; OUT = *reinterpret_cast<bf16x8*>(&w); } while (0)
  PK4(p0, 0, pa0); PK4(p0, 8, pa1); PK4(p1, 0, pa2); PK4(p1, 8, pa3);
#undef PK4
}
template <int MODE>
__device__ __forceinline__ void qkt(f32x16& p0, f32x16& p1, const char* Ks, const char* Ps, const bf16x8* qr, const char* qpe, int r32, int hi) {
  p0 = f32x16{}; p1 = f32x16{};
#pragma unroll
  for (int d0 = 0; d0 < 8; ++d0) { int cb = (d0 * 16 + hi * 8) * 2;
    bf16x8 b0 = *reinterpret_cast<const bf16x8*>(Ks + KSWZ(r32, cb));
    bf16x8 b1 = *reinterpret_cast<const bf16x8*>(Ks + KSWZ(32 + r32, cb));
    p0 = __builtin_amdgcn_mfma_f32_32x32x16_bf16(b0, qr[d0], p0, 0, 0, 0);
    p1 = __builtin_amdgcn_mfma_f32_32x32x16_bf16(b1, qr[d0], p1, 0, 0, 0); }
  if constexpr (MODE == 0) {
#pragma unroll
    for (int d0 = 0; d0 < 4; ++d0) { int cb = (d0 * 16 + hi * 8) * 2;
      bf16x8 b0 = *reinterpret_cast<const bf16x8*>(Ps + PSWZ(r32, cb));
      bf16x8 b1 = *reinterpret_cast<const bf16x8*>(Ps + PSWZ(32 + r32, cb));
      const bf16x8 qp = *reinterpret_cast<const bf16x8*>(qpe + (cb ^ ((r32 & 7) << 4)));
      p0 = __builtin_amdgcn_mfma_f32_32x32x16_bf16(b0, qp, p0, 0, 0, 0);
      p1 = __builtin_amdgcn_mfma_f32_32x32x16_bf16(b1, qp, p1, 0, 0, 0); }
  }
}
__device__ __forceinline__ int v_st(int k, int c) { const int kk = (k & ~0xC) | ((k & 4) << 1) | ((k & 8) >> 1); return ((kk >> 3) * 4 + (c >> 5)) * 512 + ((kk & 7) * 32 + (c & 31)) * 2; }
__device__ __forceinline__ int v_rd_base(int lane) { return ((lane & 3) << 3) | (((lane >> 2) & 3) << 6) | (((lane >> 4) & 1) << 5) | (((lane >> 5) & 1) << 8); }
constexpr int v_rd_off(int d0, int ks, int half) { return d0 * 512 + ks * 4096 + half * 2048; }
template <int OFF> __device__ __forceinline__ s16x4 tr_read(int vb) {
  s16x4 r; asm volatile("ds_read_b64_tr_b16 %0, %1 offset:%2" : "=&v"(r) : "v"(vb), "i"(OFF) : "memory"); return r;
}
template <int D0> __device__ __forceinline__ void pv_one(f32x16& od, int vb, bf16x8 pa0, bf16x8 pa1, bf16x8 pa2, bf16x8 pa3) {
  const s16x4 l0 = tr_read<v_rd_off(D0, 0, 0)>(vb), h0 = tr_read<v_rd_off(D0, 0, 1)>(vb), l1 = tr_read<v_rd_off(D0, 1, 0)>(vb), h1 = tr_read<v_rd_off(D0, 1, 1)>(vb);
  const s16x4 l2 = tr_read<v_rd_off(D0, 2, 0)>(vb), h2 = tr_read<v_rd_off(D0, 2, 1)>(vb), l3 = tr_read<v_rd_off(D0, 3, 0)>(vb), h3 = tr_read<v_rd_off(D0, 3, 1)>(vb);
  asm volatile("s_waitcnt lgkmcnt(0)" ::: "memory"); SBAR();
#define PKV(L, H) (bf16x8){L[0], L[1], L[2], L[3], H[0], H[1], H[2], H[3]}
  od = __builtin_amdgcn_mfma_f32_32x32x16_bf16(pa0, PKV(l0, h0), od, 0, 0, 0);
  od = __builtin_amdgcn_mfma_f32_32x32x16_bf16(pa1, PKV(l1, h1), od, 0, 0, 0);
  od = __builtin_amdgcn_mfma_f32_32x32x16_bf16(pa2, PKV(l2, h2), od, 0, 0, 0);
  od = __builtin_amdgcn_mfma_f32_32x32x16_bf16(pa3, PKV(l3, h3), od, 0, 0, 0);
#undef PKV
}
__device__ __forceinline__ void pv_d0(f32x16* o, int vb, bf16x8 pa0, bf16x8 pa1, bf16x8 pa2, bf16x8 pa3) {
  pv_one<0>(o[0], vb, pa0, pa1, pa2, pa3); pv_one<1>(o[1], vb, pa0, pa1, pa2, pa3); pv_one<2>(o[2], vb, pa0, pa1, pa2, pa3); pv_one<3>(o[3], vb, pa0, pa1, pa2, pa3);
}
__device__ __forceinline__ void na_mask(f32x16& p0, f32x16& p1, const float* biasS, int kr, int rq, int cq, int hi) {
  const int rs = min(max(rq - 4, 0), 56), cs = min(max(cq - 8, 0), 48);
  const bool rowok = (kr >= rs) && (kr <= rs + 7);
  int lo = (rowok ? cs : 1000) - 4 * hi;
  int bidx = (kr - rq + 7) * 31 - cq + 15 + 4 * hi;
  asm volatile("" : "+v"(bidx), "+v"(lo));
  const float* bp = biasS + bidx;
#pragma unroll
  for (int r = 0; r < 16; ++r) {
    const int c0 = (r & 3) + 8 * (r >> 2), c1 = 32 + c0;
    const bool ok0 = (unsigned)(c0 - lo) < 16u, ok1 = (unsigned)(c1 - lo) < 16u;
    const float b0 = bp[c0], b1 = bp[c1];
    p0[r] = ok0 ? p0[r] + b0 : -3.0e38f; p1[r] = ok1 ? p1[r] + b1 : -3.0e38f;
  }
}

struct AttnArgs {
  const bf16* Qp;
  const bf16* Kp; const bf16* Vp;
  const bf16* Pp;
  bf16* Op;
  const float* cosM; const float* sinM;
  int s0;
  int NT;
  int kr0;
  int rg;
};

template <int MODE>
__device__ __forceinline__ void attn_item(const AttnArgs& A, char* lds) {
  constexpr int NQ = Cfg<MODE>::NQ, LDQ = Cfg<MODE>::LDQ, LDK = Cfg<MODE>::LDK, LDO = Cfg<MODE>::LDO;
  int tid_ = threadIdx.x; asm volatile("" : "+v"(tid_));
  const int tid = tid_, wid = tid >> 6, lane = tid & 63, r32 = lane & 31, hi = lane >> 5;
  char* V_lds = lds + OFF_V; char* K_lds = lds + OFF_K; char* P_lds = lds + OFF_P;
  float* ws = (float*)(lds + OFF_WS) + wid * 64; float* li_l = ws; float* al_l = ws + 32;
  const float* biasS = (const float*)(lds + OFF_BIAS);
  float m_reg = -1e30f, l_reg = 0; f32x16 o[4] = {}; bf16x8 qr[NQ];
  char* qpe_row = lds + OFF_QPE + (wid * 32 + r32) * 128;
  const bf16* Qw = A.Qp + (wid * 32 + r32) * LDQ + hi * 8;
#pragma unroll
  for (int d0 = 0; d0 < 8; ++d0) qr[d0] = *reinterpret_cast<const bf16x8*>(Qw + d0 * 16);
  if constexpr (MODE == 0) {
    const int s = A.s0 + wid * 32 + r32;
#pragma unroll
    for (int c = 0; c < 2; ++c) {
      const u32x4 x1 = *reinterpret_cast<const u32x4*>(Qw + (8 + c) * 16), x2 = *reinterpret_cast<const u32x4*>(Qw + (10 + c) * 16);
      const int i0 = c * 16 + hi * 8;
      const f32x4 ca = *(const f32x4*)(A.cosM + s * 32 + i0), cb = *(const f32x4*)(A.cosM + s * 32 + i0 + 4), sa = *(const f32x4*)(A.sinM + s * 32 + i0), sb = *(const f32x4*)(A.sinM + s * 32 + i0 + 4);
      float a[8], b[8], cc[8], ss[8];
      a[0] = bf_lo(x1.x); a[1] = bf_hi(x1.x); a[2] = bf_lo(x1.y); a[3] = bf_hi(x1.y); a[4] = bf_lo(x1.z); a[5] = bf_hi(x1.z); a[6] = bf_lo(x1.w); a[7] = bf_hi(x1.w);
      b[0] = bf_lo(x2.x); b[1] = bf_hi(x2.x); b[2] = bf_lo(x2.y); b[3] = bf_hi(x2.y); b[4] = bf_lo(x2.z); b[5] = bf_hi(x2.z); b[6] = bf_lo(x2.w); b[7] = bf_hi(x2.w);
#pragma unroll
      for (int j = 0; j < 4; ++j) { cc[j] = ca[j]; cc[4 + j] = cb[j]; ss[j] = sa[j]; ss[4 + j] = sb[j]; }
      float o1[8], o2[8];
#pragma unroll
      for (int j = 0; j < 8; ++j) { o1[j] = a[j] * cc[j] - b[j] * ss[j]; o2[j] = b[j] * cc[j] + a[j] * ss[j]; }
      u32x4 w1 = {cvt_pk_bf16(o1[0], o1[1]), cvt_pk_bf16(o1[2], o1[3]), cvt_pk_bf16(o1[4], o1[5]), cvt_pk_bf16(o1[6], o1[7])};
      u32x4 w2 = {cvt_pk_bf16(o2[0], o2[1]), cvt_pk_bf16(o2[2], o2[3]), cvt_pk_bf16(o2[4], o2[5]), cvt_pk_bf16(o2[6], o2[7])};
      *reinterpret_cast<u32x4*>(qpe_row + (((c * 16 + hi * 8) * 2) ^ ((r32 & 7) << 4))) = w1; *reinterpret_cast<u32x4*>(qpe_row + (((32 + c * 16 + hi * 8) * 2) ^ ((r32 & 7) << 4))) = w2;
    }
  }
  const int rq = A.rg * 4 + (wid >> 1), cq = 32 * (wid & 1) + r32;
  const int sr = tid >> 4, sc = (tid & 15) * 8, vst0 = v_st(sr, sc), vst1 = v_st(32 + sr, sc);
  const int pr = tid >> 3, pc = (tid & 7) * 8;
  const int vb0 = (int)(uintptr_t)V_lds + v_rd_base(lane);
  bf16x8 vs0, vs1, ks0, ks1, ps0;
  const int kvo0 = sr * LDK + sc, kvo1 = (32 + sr) * LDK + sc, po0 = pr * 64 + pc;
#define SLOAD(k0) do { const bf16* Vt = A.Vp + (size_t)(k0) * LDK; const bf16* Kt = A.Kp + (size_t)(k0) * LDK; \
    vs0 = *reinterpret_cast<const bf16x8*>(Vt + kvo0); vs1 = *reinterpret_cast<const bf16x8*>(Vt + kvo1); \
    ks0 = *reinterpret_cast<const bf16x8*>(Kt + kvo0); ks1 = *reinterpret_cast<const bf16x8*>(Kt + kvo1); \
    if constexpr (MODE == 0) ps0 = *reinterpret_cast<const bf16x8*>(A.Pp + (size_t)(k0) * 64 + po0); } while (0)
#define SWRITE(b) do { *(bf16x8*)(V_lds + (b) * SHM_V + vst0) = vs0; *(bf16x8*)(V_lds + (b) * SHM_V + vst1) = vs1; int kc = sc * 2; \
    *(bf16x8*)(K_lds + (b) * SHM_K + KSWZ(sr, kc)) = ks0; *(bf16x8*)(K_lds + (b) * SHM_K + KSWZ(32 + sr, kc)) = ks1; \
    if constexpr (MODE == 0) *(bf16x8*)(P_lds + (b) * SHM_P + PSWZ(pr, pc * 2)) = ps0; } while (0)
#define SWAIT() asm volatile("s_waitcnt vmcnt(0)" ::: "memory")
#define RESC(a) do { if (__any((a) < 1.f)) { if (hi == 0) al_l[r32] = (a); asm volatile("s_waitcnt lgkmcnt(0)" ::: "memory"); \
    _Pragma("unroll") for (int d = 0; d < 4; ++d) _Pragma("unroll") for (int r = 0; r < 16; ++r) o[d][r] *= al_l[crow(r, hi)]; } } while (0)
#define NAM(P0, P1, j) do { if constexpr (MODE == 1) na_mask(P0, P1, biasS, A.kr0 + (j), rq, cq, hi); } while (0)
  f32x16 pA0, pA1, pB0, pB1; float mnA, mnB, alA, alB; bf16x8 pa0, pa1, pa2, pa3; const int NT = A.NT;
  SLOAD(0); asm volatile("s_waitcnt vmcnt(0)" ::: "memory"); SWRITE(0); __syncthreads();
  qkt<MODE>(pA0, pA1, K_lds, P_lds, qr, qpe_row, r32, hi); NAM(pA0, pA1, 0); partialSM<MODE>(pA0, pA1, m_reg, mnA, alA);
  SLOAD(KVBLK);
  SWAIT(); SWRITE(1); __syncthreads();
  for (int j = 1; j + 1 < NT; j += 2) {
    SBAR(); qkt<MODE>(pB0, pB1, K_lds + SHM_K, P_lds + SHM_P, qr, qpe_row, r32, hi); NAM(pB0, pB1, j);
    finishSM(pA0, pA1, alA, l_reg, pa0, pa1, pa2, pa3); SBAR();
    SLOAD((j + 1) * KVBLK); SBAR();
    pv_d0(o, vb0, pa0, pa1, pa2, pa3); partialSM<MODE>(pB0, pB1, m_reg, mnB, alB);
    __syncthreads(); SWAIT(); SWRITE(0);
    RESC(alB); __syncthreads();
    SBAR(); qkt<MODE>(pA0, pA1, K_lds, P_lds, qr, qpe_row, r32, hi); NAM(pA0, pA1, j + 1);
    finishSM(pB0, pB1, alB, l_reg, pa0, pa1, pa2, pa3); SBAR();
    SLOAD((j + 2) * KVBLK); SBAR();
    pv_d0(o, vb0 + SHM_V, pa0, pa1, pa2, pa3); partialSM<MODE>(pA0, pA1, m_reg, mnA, alA);
    __syncthreads(); SWAIT(); SWRITE(1);
    RESC(alA); __syncthreads();
  }
  SBAR(); qkt<MODE>(pB0, pB1, K_lds + SHM_K, P_lds + SHM_P, qr, qpe_row, r32, hi); NAM(pB0, pB1, NT - 1);
  finishSM(pA0, pA1, alA, l_reg, pa0, pa1, pa2, pa3); SBAR();
  pv_d0(o, vb0, pa0, pa1, pa2, pa3); partialSM<MODE>(pB0, pB1, m_reg, mnB, alB);
  __syncthreads(); RESC(alB);
  finishSM(pB0, pB1, alB, l_reg, pa0, pa1, pa2, pa3); SBAR();
  pv_d0(o, vb0 + SHM_V, pa0, pa1, pa2, pa3);
  if (hi == 0) li_l[r32] = l_reg; asm volatile("s_waitcnt lgkmcnt(0)" ::: "memory");
  float rli[16];
#pragma unroll
  for (int r = 0; r < 16; ++r) rli[r] = __builtin_amdgcn_rcpf(li_l[crow(r, hi)]);
  bf16* Ow = A.Op + (wid * 32) * LDO + r32;
#pragma unroll
  for (int r = 0; r < 16; ++r) { const int orow = crow(r, hi);
#pragma unroll
    for (int d0 = 0; d0 < 4; ++d0) Ow[orow * LDO + d0 * 32] = f2bf(o[d0][r] * rli[r]); }
  __syncthreads();
#undef SLOAD
#undef SWRITE
#undef SWAIT
#undef RESC
#undef NAM
}
}

namespace ret {
constexpr int ST_PITCH = 528;
constexpr int OFF_VT = 0, VT_BYTES = 128 * 256, OFF_ST = 2 * VT_BYTES, ST_BYTES = 128 * ST_PITCH, RET_LDS = OFF_ST + ST_BYTES;
__device__ __forceinline__ int crow(int r, int hi) { return (r & 3) + 8 * (r >> 2) + 4 * hi; }

__device__ __forceinline__ unsigned ktoff(unsigned row, unsigned ch) { return 256u * row + 16u * (ch ^ (((row & 3u) << 2) | ((row >> 2) & 3u))); }
__device__ __forceinline__ void pprime_item(int item, const bf16* Qm, const bf16* KVT, bf16* PP, const float* lg2f, const float* lg2b, char* lds) {
  int tid_ = threadIdx.x; asm volatile("" : "+v"(tid_));
  const int tid = tid_, wid = __builtin_amdgcn_readfirstlane(tid >> 6), lane = tid & 63, r32 = lane & 31, hi = lane >> 5;
  const int bh = item >> 5, n = item & 31, b = bh >> 3, h = bh & 7;
  const int T0 = b * 4096 + n * 128;
  const int kb = wid >> 1, qb0 = 2 * (wid & 1);
  LAS unsigned char* ldsl = (LAS unsigned char*)lds;
  const char* kg = (const char*)(KVT + (size_t)(h * 256) * 16384 + T0);
#pragma unroll
  for (int i = 0; i < 8; ++i) { const unsigned d = 32u * wid + 4u * i + (lane >> 4); const unsigned ch = (lane & 15u) ^ (((d & 3u) << 2) | ((d >> 2) & 3u));
    __builtin_amdgcn_global_load_lds((const unsigned*)(kg + (size_t)d * 32768 + ch * 16), (LAS unsigned*)(ldsl + (8 * wid + i) * 1024), 16, 0, 0); }
  const bf16* Q0 = Qm + (size_t)(T0 + 32 * qb0 + r32) * 2048 + h * 256 + 8 * hi;
  bf16x8 q0[16], q1[16];
#pragma unroll
  for (int s = 0; s < 16; ++s) { q0[s] = *reinterpret_cast<const bf16x8*>(Q0 + 16 * s); q1[s] = *reinterpret_cast<const bf16x8*>(Q0 + (size_t)32 * 2048 + 16 * s); }
  asm volatile("s_waitcnt vmcnt(0)" ::: "memory");
  __builtin_amdgcn_s_barrier(); asm volatile("" ::: "memory");
  const unsigned blk = (lane >> 4) & 1u, qq = (lane & 15u) >> 2, pp = lane & 3u;
  const unsigned ldsb = (unsigned)(size_t)ldsl;
  f32x16 acc0 = {}, acc1 = {};
#pragma unroll
  for (int ks = 0; ks < 16; ++ks) {
    const unsigned a0 = ldsb + ktoff(16u * ks + 8u * hi + qq, 4u * kb + 2u * blk + (pp >> 1)) + 8u * (pp & 1u);
    const unsigned a1 = ldsb + ktoff(16u * ks + 8u * hi + 4u + qq, 4u * kb + 2u * blk + (pp >> 1)) + 8u * (pp & 1u);
    s16x4 lo, hi4;
    asm volatile("ds_read_b64_tr_b16 %0, %2\n\tds_read_b64_tr_b16 %1, %3\n\ts_waitcnt lgkmcnt(0)" : "=&v"(lo), "=&v"(hi4) : "v"(a0), "v"(a1) : "memory");
    const bf16x8 a = (bf16x8){lo[0], lo[1], lo[2], lo[3], hi4[0], hi4[1], hi4[2], hi4[3]};
    acc0 = __builtin_amdgcn_mfma_f32_32x32x16_bf16(a, q0[ks], acc0, 0, 0, 0);
    acc1 = __builtin_amdgcn_mfma_f32_32x32x16_bf16(a, q1[ks], acc1, 0, 0, 0);
  }
  bf16* Pf = PP + ((size_t)(bh * 32 + n) * 128) * 128;
  bf16* Pb = Pf + (size_t)1024 * 128 * 128;
#pragma unroll
  for (int t = 0; t < 2; ++t) {
    const int q = 32 * (qb0 + t) + r32;
#pragma unroll
    for (int g = 0; g < 4; ++g) {
      const int k0 = 32 * kb + 8 * g + 4 * hi;
      float vf[4], vb[4];
#pragma unroll
      for (int j = 0; j < 4; ++j) { const int k = k0 + j; const float sc = t ? acc1[4 * g + j] : acc0[4 * g + j];
        vf[j] = (k <= q) ? sc : 0.f;
        vb[j] = (k > q) ? sc : 0.f; }
      u32x2 wf = {cvt_pk_bf16(vf[0], vf[1]), cvt_pk_bf16(vf[2], vf[3])}, wb = {cvt_pk_bf16(vb[0], vb[1]), cvt_pk_bf16(vb[2], vb[3])};
      *reinterpret_cast<u32x2*>(Pf + (size_t)q * 128 + k0) = wf;
      *reinterpret_cast<u32x2*>(Pb + (size_t)q * 128 + k0) = wb;
    }
  }
  asm volatile("s_waitcnt lgkmcnt(0)" ::: "memory"); __builtin_amdgcn_s_barrier(); asm volatile("" ::: "memory");
}

#if defined(CH_WAVE)
#define CSTAMP(seg) do { if (blockIdx.x == 0 && wid == CH_WAVE && lane == 0) { const unsigned now_ = (unsigned)__builtin_amdgcn_s_memrealtime(); volatile unsigned* m_ = (volatile unsigned*)(lds + 143360 + 4 * 450); m_[seg] += now_ - m_[15]; m_[15] = now_; } } while (0)
#else
#define CSTAMP(seg) do { } while (0)
#endif
__device__ __forceinline__ void chain_item(int item, const bf16* Qm, const bf16* KVT, const bf16* PP, bf16* Rf, bf16* Rb, const float* lg2f, const float* lg2b, char* lds) {
  int tid_ = threadIdx.x; asm volatile("" : "+v"(tid_));
  const int tid = tid_, wid = __builtin_amdgcn_readfirstlane(tid >> 6), lane = tid & 63, r32 = lane & 31, hi = lane >> 5;
  const int j = item & 3, dir = (item >> 2) & 1, bh = item >> 3, b = bh >> 3, h = bh & 7;
  const float lg2 = dir ? lg2b[h] : lg2f[h];
  const float cdec = __builtin_amdgcn_exp2f(lg2 * 128.f);
  bf16* Rout = dir ? Rb : Rf;
  const bf16* VTg = KVT + (size_t)(2048 + h * 512 + 128 * j) * 16384;
  const bf16* KTg = KVT + (size_t)(h * 256) * 16384;
  const bf16* PPd = PP + (size_t)dir * 1024 * 128 * 128 + (size_t)(bh * 32) * 128 * 128;
  char* STl = lds + OFF_ST;
  { unsigned z = 0u; asm volatile("" : "+v"(z));
    for (int i = tid; i < ST_BYTES / 16; i += 512) *reinterpret_cast<u32x4*>(STl + i * 16) = (u32x4){z, z, z, z}; }
#define VDMA(T0, buf) do { const char* vg = (const char*)(VTg + (T0)); int l_ = lane; asm volatile("" : "+v"(l_)); _Pragma("unroll") for (int i = 0; i < 4; ++i) { \
      const int v_ = 16 * wid + 4 * i + (l_ >> 4); const unsigned so_ = (unsigned)v_ * 32768u + (unsigned)(((l_ & 15) ^ (v_ & 15)) * 16); \
      __builtin_amdgcn_global_load_lds((const unsigned*)(vg + so_), (LAS unsigned*)(ldsl + OFF_VT + (buf) * VT_BYTES + (4 * wid + i) * 1024), 16, 0, 0); } } while (0)
  LAS unsigned char* ldsl = (LAS unsigned char*)lds;
  { const int n0 = dir ? 31 : 0; VDMA(b * 4096 + n0 * 128, 0); asm volatile("s_waitcnt vmcnt(0)" ::: "memory"); }
#define WGBAR() do { asm volatile("s_waitcnt lgkmcnt(0)" ::: "memory"); __builtin_amdgcn_s_barrier(); asm volatile("" ::: "memory"); } while (0)
#define VSCALE(buf) do { float lq_ = lg2; asm volatile("" : "+v"(lq_)); const int kc_ = 8 * ((tid & 15) ^ ((tid >> 4) & 15)); float kq_[8]; \
      _Pragma("unroll") for (int e = 0; e < 8; ++e) kq_[e] = __builtin_amdgcn_exp2f(dir ? lq_ * (float)(kc_ + e - 128) : -lq_ * (float)(kc_ + e + 1)); \
      _Pragma("unroll") for (int i = 0; i < 4; ++i) { u32x4* p_ = reinterpret_cast<u32x4*>(lds + OFF_VT + (buf) * VT_BYTES + (tid + 512 * i) * 16); const u32x4 x_ = *p_; u32x4 w_; \
        w_.x = cvt_pk_bf16(bf_lo(x_.x) * kq_[0], bf_hi(x_.x) * kq_[1]); w_.y = cvt_pk_bf16(bf_lo(x_.y) * kq_[2], bf_hi(x_.y) * kq_[3]); w_.z = cvt_pk_bf16(bf_lo(x_.z) * kq_[4], bf_hi(x_.z) * kq_[5]); w_.w = cvt_pk_bf16(bf_lo(x_.w) * kq_[6], bf_hi(x_.w) * kq_[7]); \
        *p_ = w_; } } while (0)
  WGBAR();
  VSCALE(0);
  WGBAR();
  if (wid < 4) {
#ifndef RET_NO_Q
    const int qb = wid; int buf = 0;
    bf16x8 pf[8], qf[16];
    { const int n = dir ? 31 : 0; const int T0 = b * 4096 + n * 128;
      const bf16* Qr = Qm + (size_t)(T0 + 32 * qb + r32) * 2048 + h * 256 + 8 * hi; const bf16* Pr = PPd + ((size_t)n * 128 + 32 * qb + r32) * 128 + 8 * hi;
#pragma unroll
      for (int s = 0; s < 8; ++s) pf[s] = *reinterpret_cast<const bf16x8*>(Pr + 16 * s);
#pragma unroll
      for (int s = 0; s < 16; ++s) qf[s] = *reinterpret_cast<const bf16x8*>(Qr + 16 * s); }
    const int vrow = r32 * 256 + ((hi ^ (r32 & 1)) << 4), vx = (r32 & 14) << 4, srow = r32 * ST_PITCH + 16 * hi;
    for (int ci = 0; ci < 32; ++ci) {
      const int n = dir ? 31 - ci : ci; const int T0 = b * 4096 + n * 128;
      const int nn = dir ? n - 1 : n + 1; const int T1 = b * 4096 + nn * 128;
      if (ci < 31) VDMA(T1, buf ^ 1);
      const char* VTl = lds + OFF_VT + buf * VT_BYTES + vrow; const char* STr = STl + srow;
      f32x16 o[4];
#pragma unroll
      for (int v = 0; v < 4; ++v) o[v] = f32x16{};
      bf16x8 b0[4];
#define RB(dst, t) do { _Pragma("unroll") for (int v = 0; v < 4; ++v) dst[v] = ((t) < 8) ? *reinterpret_cast<const bf16x8*>(VTl + (32 * v) * 256 + ((32 * (t)) ^ vx)) : *reinterpret_cast<const bf16x8*>(STr + (32 * v) * ST_PITCH + 32 * ((t) - 8)); } while (0)
#define RA(t) (((t) < 8) ? pf[(t) & 7] : qf[((t) - 8) & 15])
#pragma unroll
      for (int t = 0; t < 24; ++t) {
        RB(b0, t);
#pragma unroll
        for (int v = 0; v < 4; ++v) o[v] = __builtin_amdgcn_mfma_f32_32x32x16_bf16(RA(t), b0[v], o[v], 0, 0, 0);
        SBAR();
        if (t == 7 && ci < 31) {
          const bf16* Pr = PPd + ((size_t)nn * 128 + 32 * qb + r32) * 128 + 8 * hi;
#pragma unroll
          for (int s = 0; s < 8; ++s) pf[s] = *reinterpret_cast<const bf16x8*>(Pr + 16 * s);
          asm volatile("s_waitcnt vmcnt(8)" ::: "memory");
          SBAR(); }
      }
#undef RB
#undef RA
      if (ci < 31) {
        const bf16* Qr = Qm + (size_t)(T1 + 32 * qb + r32) * 2048 + h * 256 + 8 * hi;
#pragma unroll
        for (int s = 0; s < 16; ++s) qf[s] = *reinterpret_cast<const bf16x8*>(Qr + 16 * s); }
      WGBAR();
      float lgc = lg2; asm volatile("" : "+v"(lgc));
#pragma unroll
      for (int r = 0; r < 16; ++r) { const int q = 32 * qb + crow(r, hi);
        const float qd = __builtin_amdgcn_exp2f(dir ? lgc * (float)(128 - q) : lgc * (float)(q + 1));
        bf16* orow = Rout + (size_t)(T0 + q) * 4096 + h * 512 + 128 * j + r32;
#pragma unroll
        for (int v = 0; v < 4; ++v) orow[32 * v] = f2bf(o[v][r] * qd); }
      if (ci < 31) VSCALE(buf ^ 1);
      WGBAR();
      buf ^= 1;
    }
#endif
  } else {
#ifndef RET_NO_S
    const int sw = wid - 4; int buf = 0;
    f32x16 st[2][4];
#pragma unroll
    for (int a = 0; a < 2; ++a)
#pragma unroll
      for (int v = 0; v < 4; ++v) st[a][v] = f32x16{};
    u32x4 kr0[8], kr1[8];
    const bf16* Kl = KTg + (size_t)(64 * sw + r32) * 16384 + 8 * hi;
    { const int n = dir ? 31 : 0; const bf16* K0 = Kl + b * 4096 + n * 128;
#pragma unroll
      for (int s = 0; s < 4; ++s) { kr0[s] = *reinterpret_cast<const u32x4*>(K0 + 16 * s); kr1[s] = *reinterpret_cast<const u32x4*>(K0 + (size_t)32 * 16384 + 16 * s); } }
    const int vrow = r32 * 256 + ((hi ^ (r32 & 1)) << 4), vx = (r32 & 14) << 4;
    for (int ci = 0; ci < 32; ++ci) {
      const int n = dir ? 31 - ci : ci;
      const int nn = dir ? n - 1 : n + 1; const int T1 = b * 4096 + nn * 128;
      CSTAMP(0);
      if (ci < 31) VDMA(T1, buf ^ 1);
      const char* VTl = lds + OFF_VT + buf * VT_BYTES + vrow;
      { const bf16* K0 = Kl + b * 4096 + n * 128;
#pragma unroll
        for (int s = 4; s < 8; ++s) { kr0[s] = *reinterpret_cast<const u32x4*>(K0 + 16 * s); kr1[s] = *reinterpret_cast<const u32x4*>(K0 + (size_t)32 * 16384 + 16 * s); } }
      CSTAMP(1);
      bf16x8 bva[4], bvb[4];
#define RBV(dst, s_) do { _Pragma("unroll") for (int v = 0; v < 4; ++v) dst[v] = *reinterpret_cast<const bf16x8*>(VTl + (32 * v) * 256 + ((32 * (s_)) ^ vx)); } while (0)
      RBV(bva, 0);
#pragma unroll
      for (int s2 = 0; s2 < 4; ++s2) {
        if (s2 == 2) CSTAMP(2);
        RBV(bvb, 2 * s2 + 1);
        { const bf16x8 f0 = __builtin_bit_cast(bf16x8, kr0[2 * s2]), f1 = __builtin_bit_cast(bf16x8, kr1[2 * s2]);
#pragma unroll
          for (int v = 0; v < 4; ++v) { st[0][v] = __builtin_amdgcn_mfma_f32_32x32x16_bf16(f0, bva[v], st[0][v], 0, 0, 0); st[1][v] = __builtin_amdgcn_mfma_f32_32x32x16_bf16(f1, bva[v], st[1][v], 0, 0, 0); } }
        SBAR();
        if (s2 < 3) RBV(bva, 2 * s2 + 2);
        { const bf16x8 f0 = __builtin_bit_cast(bf16x8, kr0[2 * s2 + 1]), f1 = __builtin_bit_cast(bf16x8, kr1[2 * s2 + 1]);
#pragma unroll
          for (int v = 0; v < 4; ++v) { st[0][v] = __builtin_amdgcn_mfma_f32_32x32x16_bf16(f0, bvb[v], st[0][v], 0, 0, 0); st[1][v] = __builtin_amdgcn_mfma_f32_32x32x16_bf16(f1, bvb[v], st[1][v], 0, 0, 0); } }
        SBAR();
      }
#undef RBV
      CSTAMP(3);
      asm volatile("s_waitcnt vmcnt(0)" ::: "memory");
      CSTAMP(4);
      if (ci < 31) { const bf16* K0 = Kl + T1;
#pragma unroll
        for (int s = 0; s < 4; ++s) { kr0[s] = *reinterpret_cast<const u32x4*>(K0 + 16 * s); kr1[s] = *reinterpret_cast<const u32x4*>(K0 + (size_t)32 * 16384 + 16 * s); } }
#pragma unroll
      for (int a = 0; a < 2; ++a)
#pragma unroll
        for (int v = 0; v < 4; ++v) st[a][v] = st[a][v] * cdec;
      CSTAMP(5);
      WGBAR();
      CSTAMP(6);
#pragma unroll
      for (int a = 0; a < 2; ++a)
#pragma unroll
        for (int v = 0; v < 4; ++v)
#pragma unroll
          for (int g = 0; g < 4; ++g) { const int d = 64 * sw + 32 * a + 8 * g + 4 * hi;
            u32x2 w = {cvt_pk_bf16(st[a][v][4 * g + 0], st[a][v][4 * g + 1]), cvt_pk_bf16(st[a][v][4 * g + 2], st[a][v][4 * g + 3])};
            *reinterpret_cast<u32x2*>(STl + (32 * v + r32) * ST_PITCH + d * 2) = w; }
      if (ci < 31) VSCALE(buf ^ 1);
      CSTAMP(7);
      WGBAR();
      CSTAMP(9);
      buf ^= 1;
    }
#endif
  }
  WGBAR();
#undef WGBAR
#undef VDMA
#undef VSCALE
}
}

#ifndef PHMASK
#define PHMASK 0xFFFFFFFFu
#endif
#define PH(k) ((PHMASK >> (k)) & 1u)
#ifndef REPMASK
#define REPMASK 0u
#endif
#define PHASE_OPQ int tid_o = threadIdx.x; asm volatile("" : "+v"(tid_o)); const int ptid = tid_o, plane = tid_o & 63; (void)ptid; (void)plane; int gwp = gw, ngwp = NGW, pbx = blockIdx.x, pvcu = F.vcu, pG = F.G; asm volatile("" : "+s"(gwp), "+s"(ngwp), "+s"(pbx), "+s"(pvcu), "+s"(pG)); (void)gwp; (void)ngwp; (void)pbx; (void)pvcu; (void)pG;
#if REPMASK == 0u
#define PHASE_BEGIN(k) if (PH(k)) { PHASE_OPQ
#else
#define PHASE_BEGIN(k) if (PH(k)) for (int rep_ = 0; rep_ <= (int)((REPMASK >> (k)) & 1u); ++rep_) { if (rep_) xcd_barrier(bar); PHASE_OPQ
#endif
#if defined(STAMP_A) && defined(STAMP_B)
#ifndef STAMP_AMP
#define STAMP_AMP 8
#endif
#define STAMP() do { if (threadIdx.x == 0 && blockIdx.x == 0) { const unsigned n_ = F.MISC[400]; F.MISC[401 + n_] = (unsigned)__builtin_amdgcn_s_memrealtime(); F.MISC[400] = n_ + 1u; } } while (0)
#else
#define STAMP() do { } while (0)
#endif
#define GBAR() do { xcd_barrier(bar); STAMP(); } while (0)
constexpr int NTOK = 16384, SEQ = 4096, DM = 2048, NWAVES = 8;
constexpr float DN_ALPHA = 1.4142135623730951f;
constexpr float LN_EPS = 1e-5f, RMS_EPS = 1e-6f;
constexpr size_t MiB = 1u << 20;
constexpr size_t WS_CTL = 0, CTL_ZERO_BYTES = 1 * MiB;
constexpr int CW_BAR = 4096;
constexpr int CW_CNT = 8192;
constexpr size_t WS_ABIN = 1 * MiB;
constexpr size_t WS_UQ   = 17 * MiB;
constexpr size_t WS_UKV  = WS_UQ + 1536 * 512 * 2;
constexpr size_t WS_ABOUT = WS_UKV + 2048 * 256 * 2;
constexpr size_t WS_CIN  = WS_ABOUT + 8 * MiB;
constexpr size_t WS_COUT = WS_CIN + 48 * MiB;
constexpr size_t WS_PLEG = WS_COUT + 16 * MiB;
constexpr size_t WS_PLEP = WS_PLEG + 18 * MiB;
constexpr size_t WS_TAB  = WS_PLEP + 2 * MiB;
constexpr size_t WS_PB   = WS_TAB + 10 * MiB;
constexpr size_t WS_GU   = WS_PB + 16 * MiB;
constexpr size_t WS_DN   = WS_GU + 128 * MiB;
constexpr size_t WS_XB   = WS_DN + 64 * MiB;
constexpr size_t WS_AR   = WS_XB + 64 * MiB;
static_assert(WS_AR == 393 * MiB + 512 * 1024, "map");
constexpr size_t A_H = WS_AR, A_Q = A_H + 128 * MiB, A_KV = A_Q + 48 * MiB, A_AO = A_KV + 64 * MiB, A_KPE = A_AO + 64 * MiB, A_CQN = A_KPE + 2 * MiB, A_CKVN = A_CQN + 16 * MiB;
constexpr size_t C_HB = WS_AR, C_PROJ = WS_AR + 128 * MiB, C_YB = C_PROJ + 64 * MiB, C_PLE = C_YB + 160 * MiB, C_LOG = C_PLE + 64 * MiB, C_RT = C_LOG + 4 * MiB;
static_assert(C_RT + 2 * MiB <= WS_AR + 704 * MiB, "arena");
constexpr size_t B_Q = WS_AR, B_KVT = B_Q + 64 * MiB, B_G = B_KVT + 192 * MiB, B_PP = B_G + 128 * MiB, B_K = B_PP + 64 * MiB, B_RF = B_K, B_RB = B_RF + 128 * MiB, B_A = WS_AR, WS_END = B_RB + 128 * MiB;
constexpr int MAXSLOT = 40960;
constexpr size_t RT_E = 0, RT_W = RT_E + 16384 * 8, RT_R = RT_W + 16384 * 8, RT_S = RT_R + 16384 * 8, RT_ST = RT_S + 16384 * 8, RT_BC = RT_ST + 40960 * 4;
constexpr int RING_BYTES = 143360, MISC_OFF = RING_BYTES, LDS_BYTES = 147456;
static_assert(ret::RET_LDS <= RING_BYTES && att::ATT_LDS <= RING_BYTES && pg8::STAGE_BYTES <= RING_BYTES, "LDS map");

struct Frame {
    LAS unsigned char* lds; volatile LAS unsigned* MISC; unsigned* ctl;
    int tid, lane, wave, vcu, G;
};
__device__ __forceinline__ unsigned long long ld_ptr(const Frame& F, int k) {
    volatile LAS unsigned* p = F.MISC + 256 + 2 * k; const unsigned lo = __builtin_amdgcn_readfirstlane(p[0]), hi = __builtin_amdgcn_readfirstlane(p[1]);
    return ((unsigned long long)hi << 32) | lo;
}
#define INP(k) ((const float*)(GAS const float*)ld_ptr(F, (k)))
#define WSB() ((unsigned char*)(GAS unsigned char*)ld_ptr(F, 28))
#define OUTP() ((float*)(GAS float*)ld_ptr(F, 27))
struct Args { const float* in[27]; float* out; unsigned char* ws; };

constexpr int TR_WAVE_BYTES = 64 * 68 * 4;
__device__ __forceinline__ void transpose_item(const float* W, int ldw, bf16* WT, int ldt, int k0, int n0, int dst_row0, LAS float* scr, int lane) {
    const float* src = W + (size_t)(k0 + (lane >> 4)) * ldw + n0 + 4 * (lane & 15);
#pragma unroll
    for (int i = 0; i < 16; ++i) { const int kk = 4 * i + (lane >> 4); const f32x4 v = *(const f32x4*)(src + (size_t)(4 * i) * ldw);
        *(LAS f32x4*)(scr + kk * 68 + ((4 * (lane & 15)) ^ (((kk >> 3) & 7) << 2))) = v; }
    LDS_WAIT(); asm volatile("" ::: "memory");
    const int c = lane & 7;
#pragma unroll
    for (int j = 0; j < 8; ++j) { const int n = (lane >> 3) + 8 * j; const LAS float* p = scr + (8 * c) * 68 + (n ^ (c << 2));
        v4u o; o.x = cvt_pk_bf16(p[0 * 68], p[1 * 68]); o.y = cvt_pk_bf16(p[2 * 68], p[3 * 68]); o.z = cvt_pk_bf16(p[4 * 68], p[5 * 68]); o.w = cvt_pk_bf16(p[6 * 68], p[7 * 68]);
        *(v4u*)(WT + (size_t)(dst_row0 + n) * ldt + k0 + 8 * c) = o; }
    LDS_WAIT(); asm volatile("" ::: "memory");
}
__device__ __forceinline__ void transpose_plain(const float* W, int K, int N, bf16* WT, int item, LAS float* scr, int lane) {
    const int nblk = N / 64, kb = item / nblk, nb = item % nblk;
    transpose_item(W, N, WT, K, 64 * kb, 64 * nb, 64 * nb, scr, lane);
}
__device__ __forceinline__ void moe_item(int it, int lane, const float* wg, const float* wu, const float* wd, bf16* GU, bf16* DN, LAS float* scr) {
    const int which = it >> 13, r = it & 8191, e = r >> 8, q = r & 255;
    if (which < 2) { const int kb = q >> 3, n0 = 64 * (q & 7);
        transpose_item((which ? wu : wg) + (size_t)e * 2048 * 512, 512, GU, 2048, 64 * kb, n0, e * 1024 + (n0 >> 7) * 256 + (which ? 128 : 0) + (n0 & 127), scr, lane); }
    else { const int kb = q >> 5, n0 = 64 * (q & 31);
        transpose_item(wd + (size_t)e * 512 * 2048, 2048, DN, 512, 64 * kb, n0, e * 2048 + n0, scr, lane); }
}
__device__ __forceinline__ void cvt_rows(const Frame& F, int tid, const float* src, bf16* dst, size_t n8) {
    for (size_t i = (size_t)(F.vcu * 512 + tid); i < n8; i += (size_t)F.G * 512) {
        const f32x4 a = *(const f32x4*)(src + i * 8), b = *(const f32x4*)(src + i * 8 + 4);
        *(u32x4*)(dst + i * 8) = pg8::pack8(a, b); }
}
__device__ __forceinline__ void sincos_acc(int pos, float inv, float& c, float& s) {
    const double a = (double)pos * (double)inv; const double k = __builtin_rint(a * 0.15915494309189535); const float r = (float)(a - k * 6.283185307179586);
    s = sinf(r); c = cosf(r);
}

#define x_in INP(0)
#define p_in INP(1)
#define ab_w_in INP(2)
#define ab_rpb INP(3)
#define ab_q_norm INP(4)
#define ab_w_uq INP(5)
#define ab_kv_norm INP(6)
#define ab_w_ukv INP(7)
#define ab_w_out INP(8)
#define c_w_in INP(9)
#define c_lrf INP(10)
#define c_lrb INP(11)
#define c_w_out INP(12)
#define ln1_g INP(13)
#define ln1_b INP(14)
#define moe_w_group INP(15)
#define moe_b_group INP(16)
#define moe_w_router INP(17)
#define moe_b_router INP(18)
#define moe_w_gate INP(19)
#define moe_w_up INP(20)
#define moe_w_down INP(21)
#define ple_w_proj INP(22)
#define ple_w_gate INP(23)
#define ple_b_gate INP(24)
#define ln2_g INP(25)
#define ln2_b INP(26)
#define W_ABIN ((bf16*)(WSB() + WS_ABIN))
#define W_UQ ((bf16*)(WSB() + WS_UQ))
#define W_UKV ((bf16*)(WSB() + WS_UKV))
#define W_ABOUT ((bf16*)(WSB() + WS_ABOUT))
#define W_CIN ((bf16*)(WSB() + WS_CIN))
#define W_COUT ((bf16*)(WSB() + WS_COUT))
#define W_PLEG ((bf16*)(WSB() + WS_PLEG))
#define W_PLEP ((bf16*)(WSB() + WS_PLEP))
#define T_COSM ((float*)(WSB() + WS_TAB))
#define T_SINM (T_COSM + 4096 * 32)
#define T_COSR (T_COSM + 2 * 4096 * 32)
#define T_SINR (T_COSR + 4096 * 128)
#define T_COSRT (T_COSR + 2 * 4096 * 128)
#define T_SINRT (T_COSR + 3 * 4096 * 128)
#define T_LG (T_COSR + 4 * 4096 * 128)
#define PB ((bf16*)(WSB() + WS_PB))
#define W_GU ((bf16*)(WSB() + WS_GU))
#define W_DN ((bf16*)(WSB() + WS_DN))
#define XB ((bf16*)(WSB() + WS_XB))
#define PRE OUTP()
#define H ((bf16*)(WSB() + A_H))
#define Qb ((bf16*)(WSB() + A_Q))
#define KVb ((bf16*)(WSB() + A_KV))
#define AO ((bf16*)(WSB() + A_AO))
#define KPE ((bf16*)(WSB() + A_KPE))
#define CQN ((bf16*)(WSB() + A_CQN))
#define CKVN ((bf16*)(WSB() + A_CKVN))
#define Qm ((bf16*)(WSB() + B_Q))
#define KVT ((bf16*)(WSB() + B_KVT))
#define Gm ((bf16*)(WSB() + B_G))
#define PP ((bf16*)(WSB() + B_PP))
#define Km ((bf16*)(WSB() + B_K))
#define Rf ((bf16*)(WSB() + B_RF))
#define Rb ((bf16*)(WSB() + B_RB))
#define Am ((bf16*)(WSB() + B_A))
#define PROJ ((bf16*)(WSB() + C_PROJ))
#define HB ((bf16*)(WSB() + C_HB))
#define YB ((bf16*)(WSB() + C_YB))
#define PLE ((bf16*)(WSB() + C_PLE))
#define LOG ((float*)(WSB() + C_LOG))
#define TOK_E ((int*)(WSB() + C_RT + RT_E))
#define TOK_W ((float*)(WSB() + C_RT + RT_W))
#define TOK_R ((int*)(WSB() + C_RT + RT_R))
#define TOK_S ((int*)(WSB() + C_RT + RT_S))
#define SLOT_TOK ((int*)(WSB() + C_RT + RT_ST))
#define BLKCNT ((int*)(WSB() + C_RT + RT_BC))
__global__ void __launch_bounds__(512, 2) fwd_kernel(Args args) {
    extern __shared__ __attribute__((aligned(16))) unsigned char lds[];
    Frame F;
    F.lds = (LAS unsigned char*)lds; F.MISC = (volatile LAS unsigned*)(F.lds + MISC_OFF);
    F.tid = threadIdx.x; F.lane = F.tid & 63; F.wave = __builtin_amdgcn_readfirstlane(F.tid >> 6);
    F.G = gridDim.x; { const int bx = blockIdx.x; F.vcu = (F.G % 8 == 0) ? (bx % 8) * (F.G / 8) + bx / 8 : bx; }
    F.ctl = (unsigned*)(args.ws + WS_CTL);
    for (int u = F.tid; u < (LDS_BYTES - MISC_OFF) / 4; u += 512) ((LAS unsigned*)(F.lds + MISC_OFF))[u] = 0u;
    __syncthreads();
    if (F.tid == 0) {
#pragma unroll
        for (int i = 0; i < 27; ++i) { const unsigned long long v = (unsigned long long)args.in[i]; F.MISC[256 + 2 * i] = (unsigned)v; F.MISC[257 + 2 * i] = (unsigned)(v >> 32); }
        { const unsigned long long v = (unsigned long long)args.out; F.MISC[256 + 54] = (unsigned)v; F.MISC[257 + 54] = (unsigned)(v >> 32); }
        { const unsigned long long v = (unsigned long long)args.ws; F.MISC[256 + 56] = (unsigned)v; F.MISC[257 + 56] = (unsigned)(v >> 32); }
    }
    __syncthreads();
    XcdBarrier bar = xcd_barrier_post(F.ctl + CW_BAR, F.MISC + 8);
    STAMP();
    const int gw = F.vcu * NWAVES + F.wave, NGW = F.G * NWAVES;
    char* ldsg = (char*)lds;


        PHASE_BEGIN(0)
    {
        LAS float* scr = (LAS float*)(F.lds + F.wave * TR_WAVE_BYTES);
        constexpr int I_ABIN = 32 * 61, I_UQ = 8 * 24, I_UKV = 4 * 32, I_ABOUT = 32 * 32, I_CIN = 32 * 192, I_COUT = 64 * 32, I_PLEG = 32 * 32, I_PLEP = 4 * 32;
        constexpr int NIT = I_ABIN + I_UQ + I_UKV + I_ABOUT + I_CIN + I_COUT + 2 * I_PLEG + 2 * I_PLEP;
        for (int it = gwp; it < NIT + 3 * 8192; it += ngwp) {
            int r = it;
            if (r >= NIT) { moe_item(r - NIT, plane, moe_w_gate, moe_w_up, moe_w_down, W_GU, W_DN, scr); continue; }
            if (r < I_ABIN) { transpose_plain(ab_w_in, 2048, 3904, W_ABIN, r, scr, plane); continue; } r -= I_ABIN;
            if (r < I_UQ) { transpose_plain(ab_w_uq, 512, 1536, W_UQ, r, scr, plane); continue; } r -= I_UQ;
            if (r < I_UKV) { transpose_plain(ab_w_ukv, 256, 2048, W_UKV, r, scr, plane); continue; } r -= I_UKV;
            if (r < I_ABOUT) { transpose_plain(ab_w_out, 2048, 2048, W_ABOUT, r, scr, plane); continue; } r -= I_ABOUT;
            if (r < I_CIN) { transpose_plain(c_w_in, 2048, 12288, W_CIN, r, scr, plane); continue; } r -= I_CIN;
            if (r < I_COUT) { transpose_plain(c_w_out, 4096, 2048, W_COUT, r, scr, plane); continue; } r -= I_COUT;
            if (r < 2 * I_PLEG) { const int L = r / I_PLEG; transpose_plain(ple_w_gate + (size_t)L * 2048 * 2048, 2048, 2048, W_PLEG + (size_t)L * 2304 * 2048, r % I_PLEG, scr, plane); continue; } r -= 2 * I_PLEG;
            { const int L = r / I_PLEP; transpose_plain(ple_w_proj + (size_t)L * 256 * 2048, 256, 2048, W_PLEP + (size_t)L * 2048 * 256, r % I_PLEP, scr, plane); }
        }
        const size_t gt = (size_t)pvcu * 512 + ptid, GT = (size_t)pG * 512;
        for (size_t i = gt; i < (size_t)192 * 2048 / 8; i += GT) *(u32x4*)(W_ABIN + (size_t)3904 * 2048 + i * 8) = (u32x4){0u, 0u, 0u, 0u};
        for (size_t i = gt; i < (size_t)2 * 220 * 2048 / 8; i += GT) { const size_t L = i / (220 * 2048 / 8), r = i % (220 * 2048 / 8); *(u32x4*)(W_PLEG + (L * 2304 + 2084) * 2048 + r * 8) = (u32x4){0u, 0u, 0u, 0u}; }
        for (size_t i = gt; i < (size_t)2 * 36 * 2048; i += GT) { const int L = (int)(i / (36 * 2048)), r = (int)(i % (36 * 2048)), row = r / 2048, k = r % 2048;
            const float v = row < 4 ? moe_w_group[((size_t)L * 2048 + k) * 4 + row] : moe_w_router[(((size_t)L * 4 + ((row - 4) >> 3)) * 2048 + k) * 8 + ((row - 4) & 7)];
            W_PLEG[((size_t)L * 2304 + 2048 + row) * 2048 + k] = f2bf(v); }
        cvt_rows(F, ptid, x_in, XB, (size_t)NTOK * DM / 8);
        cvt_rows(F, ptid, p_in, PB, (size_t)2 * NTOK * 256 / 8);
        for (size_t i = gt; i < (size_t)4096 * 32; i += GT) { const int s = (int)(i >> 5), f = (int)(i & 31); float c, sn; sincos_acc(s, expf((float)(2 * f) * (-9.210340371976184f / 64.f)), c, sn); T_COSM[i] = c; T_SINM[i] = sn; }
        for (size_t i = gt; i < (size_t)4096 * 128; i += GT) { const int s = (int)(i >> 7), f = (int)(i & 127); float c, sn; sincos_acc(s, expf((float)(2 * f) * (-9.210340371976184f / 256.f)), c, sn);
            T_COSR[i] = c; T_SINR[i] = sn; T_COSRT[(size_t)f * 4096 + s] = c; T_SINRT[(size_t)f * 4096 + s] = sn; }
        if (gt < 16) { const float lr = gt < 8 ? c_lrf[gt] : c_lrb[gt - 8]; T_LG[gt] = log1pf(-expf(lr)) * 1.4426950408889634f; }
    }
        }
    GBAR();

#pragma unroll 1
    for (int L = 0; L < 2; ++L) {
        if (L == 0) {
        PHASE_BEGIN(1)
            { pg8::DenseOrder S{(const char*)XB, (const char*)W_ABIN, 2048, 64, 16, pG, pbx, 1 << 30, 0}; pg8::EpiPlain E{H, 4096};
              pg8::gemm_phase<pg8::EpiPlain, pg8::DenseOrder, true, false>(F.lds, 2048, S, E); }
        }
            GBAR();
        PHASE_BEGIN(2)
            for (int m = gwp; m < NTOK; m += ngwp) {
                const bf16* hr = H + (size_t)m * 4096;
                { const u32x4 w = *(const u32x4*)(hr + 3072 + 8 * plane); float v[8] = {bf_lo(w.x), bf_hi(w.x), bf_lo(w.y), bf_hi(w.y), bf_lo(w.z), bf_hi(w.z), bf_lo(w.w), bf_hi(w.w)};
                  float ss = 0.f;
#pragma unroll
                  for (int j = 0; j < 8; ++j) ss += v[j] * v[j];
                  const float rs = 1.0f / sqrtf(wave_sum(ss, plane) * (1.f / 512.f) + RMS_EPS);
                  const f32x4 g0 = *(const f32x4*)(ab_q_norm + 8 * plane), g1 = *(const f32x4*)(ab_q_norm + 8 * plane + 4);
                  const f32x4 o0 = {v[0] * rs * g0[0], v[1] * rs * g0[1], v[2] * rs * g0[2], v[3] * rs * g0[3]}, o1 = {v[4] * rs * g1[0], v[5] * rs * g1[1], v[6] * rs * g1[2], v[7] * rs * g1[3]};
                  *(u32x4*)(CQN + (size_t)m * 512 + 8 * plane) = pg8::pack8(o0, o1); }
                { const u32x2 w = *(const u32x2*)(hr + 3584 + 4 * plane); float v[4] = {bf_lo(w.x), bf_hi(w.x), bf_lo(w.y), bf_hi(w.y)};
                  const float ss = v[0] * v[0] + v[1] * v[1] + v[2] * v[2] + v[3] * v[3];
                  const float rs = 1.0f / sqrtf(wave_sum(ss, plane) * (1.f / 256.f) + RMS_EPS);
                  const f32x4 g0 = *(const f32x4*)(ab_kv_norm + 4 * plane);
                  u32x2 o; o.x = cvt_pk_bf16(v[0] * rs * g0[0], v[1] * rs * g0[1]); o.y = cvt_pk_bf16(v[2] * rs * g0[2], v[3] * rs * g0[3]);
                  *(u32x2*)(CKVN + (size_t)m * 256 + 4 * plane) = o; }
                { const int i = plane & 31, s = m & 4095; const float x1 = bf2f(hr[3840 + i]), x2 = bf2f(hr[3872 + i]); const float c = T_COSM[s * 32 + i], sn = T_SINM[s * 32 + i];
                  KPE[(size_t)m * 64 + plane] = f2bf(plane < 32 ? x1 * c - x2 * sn : x2 * c + x1 * sn); }
            }
        }
            GBAR();
        PHASE_BEGIN(3)
            { pg8::DenseOrder S{(const char*)CQN, (const char*)W_UQ, 512, 64, 6, pG, pbx, 1 << 30, 0}; pg8::EpiPlain E{Qb, 1536};
              pg8::gemm_phase<pg8::EpiPlain, pg8::DenseOrder, true, false>(F.lds, 512, S, E); }
            { pg8::DenseOrder S{(const char*)CKVN, (const char*)W_UKV, 256, 64, 8, pG, pbx, 1 << 30, 0}; pg8::EpiPlain E{KVb, 2048};
              pg8::gemm_phase<pg8::EpiPlain, pg8::DenseOrder, true, false>(F.lds, 256, S, E); }
        }
            GBAR();
        PHASE_BEGIN(4)
            for (int rep2_ = 0; rep2_ <= (int)((REPMASK >> 20) & 1u); ++rep2_) for (int it = pvcu; it < 512; it += pG) {
                const int bh = it >> 4, qb = it & 15, b = bh >> 3, h = bh & 7; const size_t t0 = (size_t)b * 4096 + qb * 256;
                att::AttnArgs A; A.Qp = Qb + t0 * 1536 + h * 192; A.Kp = KVb + (size_t)b * 4096 * 2048 + h * 256; A.Vp = A.Kp + 128;
                A.Pp = KPE + (size_t)b * 4096 * 64; A.Op = AO + t0 * 2048 + 1024 + h * 128; A.cosM = T_COSM; A.sinM = T_SINM; A.s0 = qb * 256; A.NT = 64; A.kr0 = 0; A.rg = 0;
                att::attn_item<0>(A, ldsg);
            }
            for (int rep2_ = 0; rep2_ <= (int)((REPMASK >> 21) & 1u); ++rep2_) for (int it = pvcu; it < 512; it += pG) {
                const int bh = it >> 4, rg = it & 15, b = bh >> 3, h = bh & 7; const size_t t0 = (size_t)b * 4096 + rg * 256;
                int klo = min(max(4 * rg - 4, 0), 56), khi = min(max(4 * rg - 1, 0), 56) + 7;
                if ((khi - klo + 1) & 1) { if (khi < 63) ++khi; else --klo; }
                for (int i = ptid; i < 465; i += 512) ((float*)(ldsg + att::OFF_BIAS))[i] = ab_rpb[h * 465 + i] * 11.313708498984761f;
                att::AttnArgs A; A.Qp = H + t0 * 4096 + h * 128; A.Kp = H + ((size_t)b * 4096 + klo * 64) * 4096 + 1024 + h * 128; A.Vp = A.Kp + 1024;
                A.Pp = nullptr; A.Op = AO + t0 * 2048 + h * 128; A.cosM = nullptr; A.sinM = nullptr; A.s0 = 0; A.NT = khi - klo + 1; A.kr0 = klo; A.rg = rg;
                att::attn_item<1>(A, ldsg);
            }
        }
            GBAR();
        } else {
        PHASE_BEGIN(6)
            { pg8::DenseOrder S{(const char*)XB, (const char*)W_CIN, 2048, 64, 24, pG, pbx, 8, 24}; pg8::EpiCinN E{Qm, Gm, T_COSR, T_SINR};
              pg8::gemm_phase<pg8::EpiCinN, pg8::DenseOrder, true, false>(F.lds, 2048, S, E); }
            { pg8::DenseOrder S{(const char*)(W_CIN + (size_t)2048 * 2048), (const char*)XB, 2048, 24, 64, pG, pbx, 1 << 30, 0}; pg8::EpiCinT E{KVT, T_COSRT, T_SINRT};
              pg8::gemm_phase<pg8::EpiCinT, pg8::DenseOrder, true, false>(F.lds, 2048, S, E); }
        }
            GBAR();
        PHASE_BEGIN(7)
            for (int it = pvcu; it < 1024; it += pG) ret::pprime_item(it, Qm, KVT, PP, T_LG, T_LG + 8, ldsg);
            __syncthreads();
#ifdef STAMP_MID_B2
            STAMP();
#endif
            { int tid_q = threadIdx.x; asm volatile("" : "+v"(tid_q)); const int plane = tid_q & 63;
              LAS float* scr = (LAS float*)(F.lds + F.wave * TR_WAVE_BYTES);
              for (int it = gwp; it < 3 * 8192; it += ngwp) moe_item(it, plane, moe_w_gate + (size_t)32 * 2048 * 512, moe_w_up + (size_t)32 * 2048 * 512, moe_w_down + (size_t)32 * 512 * 2048, W_GU, W_DN, scr); }
        }
            GBAR();
        PHASE_BEGIN(8)
            for (int it = pvcu; it < 256; it += pG) ret::chain_item(it, Qm, KVT, PP, Rf, Rb, T_LG, T_LG + 8, ldsg);
        }
            GBAR();
        PHASE_BEGIN(9)
            for (int u = gwp; u < NTOK * 8; u += 4 * ngwp) {
                u32x4 a[4], bq[4], gq[4]; size_t off[4];
#pragma unroll
                for (int r = 0; r < 4; ++r) { const int uu = u + r * ngwp; off[r] = (size_t)(uu >> 3) * 4096 + (uu & 7) * 512 + 8 * plane;
                    a[r] = *(const u32x4*)(Rf + off[r]); bq[r] = *(const u32x4*)(Rb + off[r]); gq[r] = *(const u32x4*)(Gm + off[r]); }
#pragma unroll
                for (int r = 0; r < 4; ++r) {
                    float rr[8] = {bf_lo(a[r].x) + bf_lo(bq[r].x), bf_hi(a[r].x) + bf_hi(bq[r].x), bf_lo(a[r].y) + bf_lo(bq[r].y), bf_hi(a[r].y) + bf_hi(bq[r].y), bf_lo(a[r].z) + bf_lo(bq[r].z), bf_hi(a[r].z) + bf_hi(bq[r].z), bf_lo(a[r].w) + bf_lo(bq[r].w), bf_hi(a[r].w) + bf_hi(bq[r].w)};
                    const float g[8] = {bf_lo(gq[r].x), bf_hi(gq[r].x), bf_lo(gq[r].y), bf_hi(gq[r].y), bf_lo(gq[r].z), bf_hi(gq[r].z), bf_lo(gq[r].w), bf_hi(gq[r].w)};
                    float s = 0.f;
#pragma unroll
                    for (int j = 0; j < 8; ++j) s += rr[j];
                    const float mean = wave_sum(s, plane) * (1.f / 512.f); float s2 = 0.f;
#pragma unroll
                    for (int j = 0; j < 8; ++j) { rr[j] -= mean; s2 += rr[j] * rr[j]; }
                    const float rstd = 1.0f / sqrtf(wave_sum(s2, plane) * (1.f / 512.f) + LN_EPS);
                    f32x4 o0, o1;
#pragma unroll
                    for (int j = 0; j < 4; ++j) { o0[j] = g[j] * sigmoidf_(g[j]) * rr[j] * rstd; o1[j] = g[4 + j] * sigmoidf_(g[4 + j]) * rr[4 + j] * rstd; }
                    *(u32x4*)(Am + off[r]) = pg8::pack8(o0, o1);
                }
            }
        }
            GBAR();
        }
        PHASE_BEGIN(5)
        { pg8::DenseOrder S{(const char*)(L ? Am : AO), (const char*)(L ? W_COUT : W_ABOUT), L ? 4096 : 2048, 64, 8, pG, pbx, 1 << 30, 0}; pg8::EpiPre E{PRE, XB, DN_ALPHA};
          pg8::gemm_phase<pg8::EpiPre, pg8::DenseOrder, true, false>(F.lds, L ? 4096 : 2048, S, E); }
        { pg8::DenseOrder S{(const char*)(PB + (size_t)L * NTOK * 256), (const char*)(W_PLEP + (size_t)L * 2048 * 256), 256, 64, 8, pG, pbx, 1 << 30, 0}; pg8::EpiPlain E{PROJ, 2048};
          pg8::gemm_phase<pg8::EpiPlain, pg8::DenseOrder, true, false>(F.lds, 256, S, E); }
        }
        GBAR();
        PHASE_BEGIN(11)
        { int tid_q = threadIdx.x; asm volatile("" : "+v"(tid_q)); const int plane = tid_q & 63; int gwp = gw, ngwp = NGW; asm volatile("" : "+s"(gwp), "+s"(ngwp));
        for (int m = gwp; m < NTOK; m += 2 * ngwp) {
            f32x4 v[2][8]; float s[2] = {0.f, 0.f};
#pragma unroll
            for (int r = 0; r < 2; ++r) { const f32x4* xr = (const f32x4*)(PRE + (size_t)(m + r * ngwp) * DM) + plane;
#pragma unroll
                for (int j = 0; j < 8; ++j) v[r][j] = xr[64 * j]; }
#pragma unroll
            for (int r = 0; r < 2; ++r)
#pragma unroll
                for (int j = 0; j < 8; ++j) s[r] += (v[r][j][0] + v[r][j][1]) + (v[r][j][2] + v[r][j][3]);
            const float mean[2] = {wave_sum(s[0], plane) * (1.f / DM), wave_sum(s[1], plane) * (1.f / DM)}; float s2[2] = {0.f, 0.f};
#pragma unroll
            for (int r = 0; r < 2; ++r)
#pragma unroll
                for (int j = 0; j < 8; ++j) { v[r][j] = v[r][j] - mean[r]; s2[r] += (v[r][j][0] * v[r][j][0] + v[r][j][1] * v[r][j][1]) + (v[r][j][2] * v[r][j][2] + v[r][j][3] * v[r][j][3]); }
            const float rstd[2] = {1.0f / sqrtf(wave_sum(s2[0], plane) * (1.f / DM) + LN_EPS), 1.0f / sqrtf(wave_sum(s2[1], plane) * (1.f / DM) + LN_EPS)};
            const f32x4* gr = (const f32x4*)(ln1_g + L * DM) + plane; const f32x4* br = (const f32x4*)(ln1_b + L * DM) + plane;
#pragma unroll
            for (int j = 0; j < 8; ++j) { const f32x4 g = gr[64 * j], bb = br[64 * j];
#pragma unroll
                for (int r = 0; r < 2; ++r) { const f32x4 y = v[r][j] * rstd[r] * g + bb; u32x2 w; w.x = cvt_pk_bf16(y[0], y[1]); w.y = cvt_pk_bf16(y[2], y[3]); ((u32x2*)(XB + (size_t)(m + r * ngwp) * DM) + plane)[64 * j] = w; } }
        } }
        }
        GBAR();
        PHASE_BEGIN(12)
        { pg8::DenseOrder S{(const char*)XB, (const char*)(W_PLEG + (size_t)L * 2304 * 2048), 2048, 64, 9, pG, pbx, 1 << 30, 0}; pg8::EpiPle E{PLE, PROJ, ple_b_gate + L * DM, LOG};
          pg8::gemm_phase<pg8::EpiPle, pg8::DenseOrder, true, false>(F.lds, 2048, S, E); }
        }
        GBAR();
        PHASE_BEGIN(13)
        if (ptid < 64) {
            const int n = pvcu * 64 + ptid;
            const float* lg = LOG + (size_t)n * 64;
            float gl[4]; int gi = 0;
#pragma unroll
            for (int g = 0; g < 4; ++g) gl[g] = lg[g] + moe_b_group[L * 4 + g];
            float gm = gl[0];
#pragma unroll
            for (int g = 1; g < 4; ++g) if (gl[g] > gm) { gm = gl[g]; gi = g; }
            float gs = 0.f;
#pragma unroll
            for (int g = 0; g < 4; ++g) gs += expf(gl[g] - gm);
            const float pg = 1.0f / gs;
            float el[8];
#pragma unroll
            for (int e = 0; e < 8; ++e) el[e] = lg[4 + gi * 8 + e] + moe_b_router[(L * 4 + gi) * 8 + e];
            int i0 = 0; float m0 = el[0];
#pragma unroll
            for (int e = 1; e < 8; ++e) if (el[e] > m0) { m0 = el[e]; i0 = e; }
            int i1 = -1; float m1 = -3.0e38f;
#pragma unroll
            for (int e = 0; e < 8; ++e) if (e != i0 && el[e] > m1) { m1 = el[e]; i1 = e; }
            const float t1 = expf(m1 - m0), den = 1.0f / (1.0f + t1);
            const int e0 = gi * 8 + i0, e1 = gi * 8 + i1;
            int r0 = 0, r1 = 0, mycnt = 0; const unsigned long long ltm = (1ull << ptid) - 1ull;
#pragma unroll 1
            for (int e = 0; e < 32; ++e) {
                const unsigned long long b0 = __ballot(e0 == e), b1 = __ballot(e1 == e);
                const int below = __popcll(b0 & ltm) + __popcll(b1 & ltm);
                if (e0 == e) r0 = below; if (e1 == e) r1 = below;
                if (ptid == e) mycnt = __popcll(b0) + __popcll(b1);
            }
            TOK_E[2 * n] = e0; TOK_E[2 * n + 1] = e1; TOK_W[2 * n] = pg * den; TOK_W[2 * n + 1] = pg * t1 * den; TOK_R[2 * n] = r0; TOK_R[2 * n + 1] = r1;
            if (ptid < 32) BLKCNT[pvcu * 32 + ptid] = mycnt;
        }
        }
        GBAR();
        volatile LAS int* EOFF = (volatile LAS int*)(F.MISC + 16);
        PHASE_BEGIN(14)
        { volatile LAS int* red = (volatile LAS int*)F.lds;
          const int e = ptid & 31, grp = ptid >> 5; int tot = 0, bel = 0;
          for (int b2 = grp; b2 < pG; b2 += 16) { const int c = BLKCNT[b2 * 32 + e]; tot += c; bel += (b2 < pvcu) ? c : 0; }
          red[ptid] = tot; red[512 + ptid] = bel;
          __syncthreads();
          if (ptid < 32) { int t = 0, q = 0; for (int g = 0; g < 16; ++g) { t += red[g * 32 + ptid]; q += red[512 + g * 32 + ptid]; } red[1024 + ptid] = t; red[1056 + ptid] = q; }
          __syncthreads();
          if (ptid == 0) { int acc = 0; for (int q = 0; q < 32; ++q) { EOFF[q] = acc; acc += (red[1024 + q] + 255) & ~255; } EOFF[32] = acc; }
          __syncthreads();
          if (ptid < 64) { const int n = pvcu * 64 + ptid;
#pragma unroll
            for (int k = 0; k < 2; ++k) { const int ee = TOK_E[2 * n + k]; const int slot = EOFF[ee] + red[1056 + ee] + TOK_R[2 * n + k]; SLOT_TOK[slot] = n; TOK_S[2 * n + k] = slot; } }
          for (int ee = pvcu; ee < 32; ee += pG) { const int c = red[1024 + ee]; const int pe = (c + 255) & ~255;
            for (int i = c + ptid; i < pe; i += 512) SLOT_TOK[EOFF[ee] + i] = 0; }
          __syncthreads();
        }
        }
        GBAR();
        const int ntiles = EOFF[32] >> 8;
        PHASE_BEGIN(15)
        {
            struct MoeGU { const char* A; const char* Bt; const int* slot_tok; volatile LAS int* eoff; int nun, G, c;
                __device__ __forceinline__ bool next(int i, pg8::Unit& u) const { const long Lq = (long)i * G + c; if (Lq >= nun) return false; const int t = (int)(Lq >> 2), pn = (int)(Lq & 3);
                    int e = 0;
#pragma unroll 1
                    for (int q = 1; q < 32; ++q) if (eoff[q] <= t * 256) e = q;
                    u.pm = t; u.pn = pn; u.a = A; u.b = Bt + ((size_t)e * 1024 + pn * 256) * 2048 * 2; return true; }
                __device__ __forceinline__ void rows(const pg8::Unit& u, int R, int C, unsigned (&o0)[2], unsigned (&o1)[2]) const {
                    int Ro = R; asm volatile("" : "+v"(Ro));
                    const int* st = slot_tok + u.pm * 256 + Ro;
                    o0[0] = (unsigned)st[0] * 4096u + (unsigned)C * 2u; o0[1] = (unsigned)st[64] * 4096u + (unsigned)C * 2u; o1[0] = (unsigned)st[128] * 4096u + (unsigned)C * 2u; o1[1] = (unsigned)st[192] * 4096u + (unsigned)C * 2u; }
            } S{(const char*)XB, (const char*)W_GU, SLOT_TOK, EOFF, ntiles * 4, pG, pvcu};
            pg8::EpiGU E{HB};
            pg8::gemm_phase<pg8::EpiGU, MoeGU, true, true>(F.lds, 2048, S, E);
        }
        }
        GBAR();
        PHASE_BEGIN(16)
        {
            struct MoeDN { const char* A; const char* Bt; volatile LAS int* eoff; int nun, G, c;
                __device__ __forceinline__ bool next(int i, pg8::Unit& u) const { const long Lq = (long)i * G + c; if (Lq >= nun) return false; const int t = (int)(Lq >> 3), pn = (int)(Lq & 7);
                    int e = 0;
#pragma unroll 1
                    for (int q = 1; q < 32; ++q) if (eoff[q] <= t * 256) e = q;
                    u.pm = t; u.pn = pn; u.a = A + (size_t)t * 256 * 512 * 2; u.b = Bt + ((size_t)e * 2048 + pn * 256) * 512 * 2; return true; }
                __device__ __forceinline__ void rows(const pg8::Unit&, int, int, unsigned (&)[2], unsigned (&)[2]) const {}
            } S{(const char*)HB, (const char*)W_DN, EOFF, ntiles * 8, pG, pvcu};
            pg8::EpiPlain E{YB, 2048};
            pg8::gemm_phase<pg8::EpiPlain, MoeDN, true, false>(F.lds, 512, S, E);
        }
        }
        GBAR();
        PHASE_BEGIN(17)
        for (int m = gwp; m < NTOK; m += ngwp) {
            const int s0 = TOK_S[2 * m], s1 = TOK_S[2 * m + 1]; const float w0 = TOK_W[2 * m], w1 = TOK_W[2 * m + 1];
            const u32x4* xr = (const u32x4*)(XB + (size_t)m * DM) + plane; const u32x4* y0 = (const u32x4*)(YB + (size_t)s0 * DM) + plane; const u32x4* y1 = (const u32x4*)(YB + (size_t)s1 * DM) + plane;
            const u32x4* pr = (const u32x4*)(PLE + (size_t)m * DM) + plane;
            float v[4][8]; float s = 0.f;
#pragma unroll
            for (int j = 0; j < 4; ++j) { const u32x4 a = xr[64 * j], b0 = y0[64 * j], b1 = y1[64 * j], c = pr[64 * j];
                const unsigned aw[4] = {a.x, a.y, a.z, a.w}, b0w[4] = {b0.x, b0.y, b0.z, b0.w}, b1w[4] = {b1.x, b1.y, b1.z, b1.w}, cw[4] = {c.x, c.y, c.z, c.w};
#pragma unroll
                for (int q = 0; q < 4; ++q) { v[j][2 * q] = DN_ALPHA * bf_lo(aw[q]) + w0 * bf_lo(b0w[q]) + w1 * bf_lo(b1w[q]) + bf_lo(cw[q]); v[j][2 * q + 1] = DN_ALPHA * bf_hi(aw[q]) + w0 * bf_hi(b0w[q]) + w1 * bf_hi(b1w[q]) + bf_hi(cw[q]);
                    s += v[j][2 * q] + v[j][2 * q + 1]; } }
            const float mean = wave_sum(s, plane) * (1.f / DM); float s2 = 0.f;
#pragma unroll
            for (int j = 0; j < 4; ++j)
#pragma unroll
                for (int q = 0; q < 8; ++q) { v[j][q] -= mean; s2 += v[j][q] * v[j][q]; }
            const float rstd = 1.0f / sqrtf(wave_sum(s2, plane) * (1.f / DM) + LN_EPS);
            u32x4* ox = (u32x4*)(XB + (size_t)m * DM) + plane;
#pragma unroll
            for (int j = 0; j < 4; ++j) { const int c0 = 512 * j + 8 * plane;
                const f32x4 g0 = *(const f32x4*)(ln2_g + L * DM + c0), g1 = *(const f32x4*)(ln2_g + L * DM + c0 + 4), b0 = *(const f32x4*)(ln2_b + L * DM + c0), b1 = *(const f32x4*)(ln2_b + L * DM + c0 + 4);
                f32x4 y0v, y1v;
#pragma unroll
                for (int q = 0; q < 4; ++q) { y0v[q] = v[j][q] * rstd * g0[q] + b0[q]; y1v[q] = v[j][4 + q] * rstd * g1[q] + b1[q]; }
                if (L == 1) { *(f32x4*)(OUTP() + (size_t)m * DM + c0) = y0v; *(f32x4*)(OUTP() + (size_t)m * DM + c0 + 4) = y1v; }
                else ox[64 * j] = pg8::pack8(y0v, y1v); }
        }
        }
        if (L == 0) GBAR();
    }
#if defined(STAMP_A) && defined(STAMP_B)
    STAMP();
#if defined(CH_WAVE)
    if (threadIdx.x == 0 && blockIdx.x == 0) { const unsigned dt = F.MISC[450 + CH_SEG]; const unsigned long long t0 = __builtin_amdgcn_s_memrealtime();
#else
    if (threadIdx.x == 0 && blockIdx.x == 0) { const unsigned dt = F.MISC[401 + STAMP_B] - F.MISC[401 + STAMP_A]; const unsigned long long t0 = __builtin_amdgcn_s_memrealtime();
#endif
        while (__builtin_amdgcn_s_memrealtime() - t0 < (unsigned long long)dt * STAMP_AMP) __builtin_amdgcn_s_sleep(32); }
#endif
}

extern "C" void kernel_launch(void* const* d_in, const int* in_sizes, int n_in, void* d_out, int out_size, void* d_ws, size_t ws_size, hipStream_t stream) {
    static int grid = 0;
    if (grid == 0) {
        if (n_in != 27 || out_size != NTOK * DM || ws_size < WS_END) { fprintf(stderr, "kernel_launch: unexpected shapes (n_in %d out %d ws %zu need %zu)\n", n_in, out_size, ws_size, (size_t)WS_END); grid = -1; return; }
        int dev = 0, cus = 0;
        if (hipGetDevice(&dev) != hipSuccess || hipDeviceGetAttribute(&cus, hipDeviceAttributeMultiprocessorCount, dev) != hipSuccess) { grid = -1; return; }
        if (hipFuncSetAttribute((const void*)fwd_kernel, hipFuncAttributeMaxDynamicSharedMemorySize, LDS_BYTES) != hipSuccess) { grid = -1; return; }
        if (cus < 256) { fprintf(stderr, "kernel_launch: needs 256 CUs\n"); grid = -1; return; }
        grid = 256;
    }
    if (grid < 0) return;
    (void)hipMemsetAsync((char*)d_ws + WS_CTL, 0, CTL_ZERO_BYTES, stream);
    Args a{};
    for (int i = 0; i < 27; ++i) a.in[i] = (const float*)d_in[i];
    a.out = (float*)d_out; a.ws = (unsigned char*)d_ws;
    hipLaunchKernelGGL(fwd_kernel, dim3(grid), dim3(512), LDS_BYTES, stream, a);
}
```

```cpp
#include <hip/hip_runtime.h>
#include <cstdio>
#include <cstdint>

#define GAS __attribute__((address_space(1)))
#define LAS __attribute__((address_space(3)))
typedef unsigned short bf16;
typedef unsigned short bf16_t;
typedef short bf16x8 __attribute__((ext_vector_type(8)));
typedef short s16x4 __attribute__((ext_vector_type(4)));
typedef float f32x4 __attribute__((ext_vector_type(4)));
typedef float f32x2 __attribute__((ext_vector_type(2)));
typedef float f32x8 __attribute__((ext_vector_type(8)));
typedef float f32x16 __attribute__((ext_vector_type(16)));
typedef unsigned u32x4 __attribute__((ext_vector_type(4)));
typedef unsigned u32x2 __attribute__((ext_vector_type(2)));
typedef unsigned v4u __attribute__((ext_vector_type(4)));

#define LDS_WAIT() asm volatile("s_waitcnt lgkmcnt(0)" ::: "memory")
#define VM_WAIT() asm volatile("s_waitcnt vmcnt(0)" ::: "memory")
#define SBAR() __builtin_amdgcn_sched_barrier(0)

__device__ __forceinline__ unsigned cvt_pk_bf16(float lo, float hi) { unsigned r; asm volatile("v_cvt_pk_bf16_f32 %0, %1, %2" : "=v"(r) : "v"(lo), "v"(hi)); return r; }
__device__ __forceinline__ float bf_lo(unsigned w) { return __uint_as_float(w << 16); }
__device__ __forceinline__ float bf_hi(unsigned w) { return __uint_as_float(w & 0xffff0000u); }
__device__ __forceinline__ float bf2f(bf16 h) { return __uint_as_float(((unsigned)h) << 16); }
__device__ __forceinline__ bf16 f2bf(float f) { return (bf16)(cvt_pk_bf16(f, 0.f) & 0xffffu); }
__device__ __forceinline__ float dpp_add(float v, const int ctrl, const int row_mask) { return v; }
#define DPP_ADD(v, ctrl, rmask) ((v) + __int_as_float(__builtin_amdgcn_update_dpp(0, __float_as_int(v), (ctrl), (rmask), 0xF, false)))
__device__ __forceinline__ float wave_sum(float v, int) {
    v = DPP_ADD(v, 0xB1, 0xF);
    v = DPP_ADD(v, 0x4E, 0xF);
    v = DPP_ADD(v, 0x141, 0xF);
    v = DPP_ADD(v, 0x140, 0xF);
    v = DPP_ADD(v, 0x142, 0xA);
    v = DPP_ADD(v, 0x143, 0xC);
    return __int_as_float(__builtin_amdgcn_readlane(__float_as_int(v), 63));
}
__device__ __forceinline__ float fast_exp(float x) { return __builtin_amdgcn_exp2f(x * 1.4426950408889634f); }
__device__ __forceinline__ float sigmoidf_(float x) { return __builtin_amdgcn_rcpf(1.0f + fast_exp(-x)); }

#define XB_TMO      128
#define XB_XCNT(j)  (256  + 64 * (j))
#define XB_XSUB(j)  (1280 + 64 * (j))
#define XB_XGEN(j)  (2304 + 64 * (j))
#define XB_TOP      3328
#define XB_TOPGEN   3392
#define XCD_BAR_WORDS 3456
#define XB_SPIN_CAP (1u << 18)

__device__ __forceinline__ unsigned xb_ld(unsigned* p)              { return __hip_atomic_load(p, __ATOMIC_RELAXED, __HIP_MEMORY_SCOPE_AGENT); }
__device__ __forceinline__ unsigned xb_add(unsigned* p, unsigned v) { return __hip_atomic_fetch_add(p, v, __ATOMIC_RELAXED, __HIP_MEMORY_SCOPE_AGENT); }
__device__ __forceinline__ unsigned xb_xcc_id() { return (unsigned)__builtin_amdgcn_s_getreg((3 << 11) | 20) & 0xFu; }
#define XB_SPIN(cond, bar) do { unsigned _sp = 0; while (cond) { __builtin_amdgcn_s_sleep(1); \
    if ((++_sp & 255u) == 0u) { if (xb_ld(&(bar)[XB_TMO])) break; if (_sp > XB_SPIN_CAP) { atomicAdd(&(bar)[XB_TMO], 1u); break; } } } } while (0)

struct XcdBarrier { unsigned* bar; unsigned x; volatile LAS unsigned* st; };

__device__ __forceinline__ XcdBarrier xcd_barrier_post(unsigned* bar, volatile LAS unsigned* st) {
    XcdBarrier b; b.bar = bar; b.x = xb_xcc_id(); b.st = st;
    if (threadIdx.x == 0) (void)xb_add(&bar[XB_XCNT(b.x)], 1u);
    return b;
}
__device__ __forceinline__ void xcd_barrier_complete(unsigned* bar, unsigned x, unsigned& nloc, unsigned& nx) {
    const unsigned G = gridDim.x * gridDim.y * gridDim.z;
    unsigned sum, cnt, mine, sp = 0u;
    for (;;) {
        sum = 0u; cnt = 0u; mine = 0u;
#pragma unroll
        for (unsigned j = 0; j < 16; ++j) { const unsigned c = xb_ld(&bar[XB_XCNT(j)]); sum += c; cnt += (c > 0u) ? 1u : 0u; mine = (j == x) ? c : mine; }
        if (sum == G) break;
        __builtin_amdgcn_s_sleep(1);
        if ((++sp & 255u) == 0u) { if (xb_ld(&bar[XB_TMO])) break; if (sp > XB_SPIN_CAP) { atomicAdd(&bar[XB_TMO], 1u); break; } }
    }
    nloc = mine > 0u ? mine : 1u; nx = cnt > 0u ? cnt : 1u;
}
__device__ __forceinline__ void xcd_barrier(const XcdBarrier& b) {
    asm volatile("s_waitcnt vmcnt(0)" ::: "memory");
    __syncthreads();
    if (threadIdx.x == 0) {
        unsigned* bar = b.bar; asm volatile("" : "+s"(bar));
        __builtin_amdgcn_s_waitcnt(0);
        unsigned nloc = b.st[0], nx = b.st[1]; unsigned bx = b.x; asm volatile("" : "+s"(bx));
        if (nloc == 0u) { xcd_barrier_complete(bar, bx, nloc, nx); b.st[0] = nloc; b.st[1] = nx; }
        const unsigned old = xb_add(&bar[XB_XSUB(bx)], 1u);
        const unsigned gen = old / nloc;
        if (old + 1u == (gen + 1u) * nloc) {
            __builtin_amdgcn_fence(__ATOMIC_RELEASE, "agent");
            asm volatile("s_waitcnt vmcnt(0)" ::: "memory");
            const unsigned og = xb_add(&bar[XB_TOP], 1u);
            const unsigned tg = og / nx;
            if (og + 1u == (tg + 1u) * nx) xb_add(&bar[XB_TOPGEN], 1u);
            else XB_SPIN(xb_ld(&bar[XB_TOPGEN]) == tg, bar);
            __builtin_amdgcn_fence(__ATOMIC_ACQUIRE, "agent");
            xb_add(&bar[XB_XGEN(bx)], 1u);
            asm volatile("s_waitcnt vmcnt(0)" ::: "memory");
        } else {
            XB_SPIN(xb_ld(&bar[XB_XGEN(bx)]) == gen, bar);
            __builtin_amdgcn_fence(__ATOMIC_ACQUIRE, "agent");
            asm volatile("s_waitcnt vmcnt(0)" ::: "memory");
        }
    }
    __syncthreads();
}

namespace pg8 {
constexpr int BM = 256, BK = 64, HALF = 128, HTB = HALF * BK * 2, STAGE_BYTES = 8 * HTB, NXCD = 8, WGM = 8;
__host__ __device__ __forceinline__ int lds_byte(int r, int c) { const int st = (r >> 4) * 2 + (c >> 5), rr = r & 15, cc = c & 31, ob = rr * 64 + cc * 2; return st * 1024 + (ob ^ (((ob >> 9) & 1) << 5)); }
__host__ __device__ __forceinline__ void stage_rc(int b, int& R, int& C) { const int st = b / 1024, sb = b % 1024, swz = sb ^ (((sb >> 9) & 1) << 5); R = (st >> 1) * 16 + swz / 64; C = (st & 1) * 32 + (swz % 64) / 2; }
__host__ __device__ __forceinline__ int perm32(int rho) { const int n = rho >> 4, i = rho & 15; return 8 * (i >> 2) + 4 * n + (i & 3); }

struct Unit { const char* a; const char* b; int pm, pn; };

__device__ __forceinline__ bool static_tile(int i, int G, int c, int nM, int nN, int& pm, int& pn) {
    const int nwg = nM * nN; const long L = (long)i * G + c; if (L >= nwg) return false;
    int wgid = (int)L; { const int q = nwg / NXCD, r = nwg % NXCD, xcd = wgid % NXCD, off = wgid / NXCD; wgid = (xcd < r ? xcd * (q + 1) : r * (q + 1) + (xcd - r) * q) + off; }
    const int nig = WGM * nN, gid = wgid / nig, fm = gid * WGM, gsz = (nM - fm) < WGM ? (nM - fm) : WGM;
    pm = fm + ((wgid % nig) % gsz); pn = (wgid % nig) / gsz; return true;
}
struct DenseOrder {
    const char* A; const char* Bt; int K, nM, nN, G, c, split, skip;
    __device__ __forceinline__ bool next(int i, Unit& u) const {
        int pm, pn; if (!static_tile(i, G, c, nM, nN, pm, pn)) return false;
        const int pp = pn < split ? pn : pn + skip;
        u.pm = pm; u.pn = pn; u.a = A + (size_t)pm * 256 * K * 2; u.b = Bt + (size_t)pp * 256 * K * 2; return true;
    }
    __device__ __forceinline__ void rows(const Unit&, int, int, unsigned (&)[2], unsigned (&)[2]) const {}
};

template <class Epi, class Sched, bool ALIGN_EPI, bool GATHER>
__device__ __forceinline__ void gemm_phase(LAS unsigned char* lds, const int K, const Sched& S, const Epi& E) {
    int tid_ = threadIdx.x; asm volatile("" : "+v"(tid_));
    const int tid = tid_, wid = __builtin_amdgcn_readfirstlane(tid >> 6), lane = tid & 63, wr = wid >> 2, wc = wid & 3, fr = lane & 15, fq = lane >> 4;
    const int nt = K / BK;
    unsigned voffA[2], voffB[2]; int stR = 0, stC = 0;
#pragma unroll
    for (int i = 0; i < 2; ++i) { int R, C; stage_rc(tid * 16 + i * 8192, R, C); const int Rb = Epi::PERM ? ((R & ~31) + perm32(R & 31)) : R;
        voffA[i] = (unsigned)(R * K + C) * 2u; voffB[i] = (unsigned)(Rb * K + C) * 2u; if (i == 0) { stR = R; stC = C; } }
    const size_t kstep = (size_t)(BK * 2);
    const size_t hstep = (size_t)HALF * K * 2;
    const unsigned ldsw = (unsigned)wid * 1024u;
    const int aoff = lds_byte(wr * 64 + fr, fq * 8), boff = lds_byte(wc * 32 + fr, fq * 8);
    unsigned ga0[2] = {0u, 0u}, ga1[2] = {0u, 0u};
#define PG8_SA(b, h) (((b) * 2 + (h)) * HTB)
#define PG8_SB(b, h) ((4 + (b) * 2 + (h)) * HTB)
#define PG8_STAGE(bufoff, gbase, voff) do { _Pragma("unroll") for (int _i = 0; _i < 2; ++_i) \
        __builtin_amdgcn_global_load_lds((const unsigned*)((const char*)(gbase) + (voff)[_i]), (LAS unsigned*)(lds + (bufoff) + ldsw + _i * 8192), 16, 0, 0); } while (0)
#define PG8_STAGE_A(bufoff, gbase, h, nx) do { if constexpr (GATHER) { if (h) PG8_STAGE(bufoff, gbase, ga1); else PG8_STAGE(bufoff, gbase, ga0); } \
        else { PG8_STAGE(bufoff, (gbase) + (h) * hstep, voffA); } } while (0)
#define PG8_LDA(dst, b, h) do { _Pragma("unroll") for (int m = 0; m < 4; ++m) _Pragma("unroll") for (int k = 0; k < 2; ++k) dst[m][k] = *(const LAS bf16x8*)(lds + PG8_SA(b, h) + aoff + m * 2048 + k * 1024); } while (0)
#define PG8_LDB(dst, b, h) do { _Pragma("unroll") for (int n = 0; n < 2; ++n) _Pragma("unroll") for (int k = 0; k < 2; ++k) dst[n][k] = *(const LAS bf16x8*)(lds + PG8_SB(b, h) + boff + n * 2048 + k * 1024); } while (0)
#define PG8_MMA(ai, bj, At, Bt) do { __builtin_amdgcn_s_setprio(1); _Pragma("unroll") for (int m = 0; m < 4; ++m) _Pragma("unroll") for (int n = 0; n < 2; ++n) _Pragma("unroll") for (int k = 0; k < 2; ++k) \
        acc[ai][bj][m][n] = __builtin_amdgcn_mfma_f32_16x16x32_bf16(Bt[n][k], At[m][k], acc[ai][bj][m][n], 0, 0, 0); __builtin_amdgcn_s_setprio(0); } while (0)
#define PG8_WAIT_V(n) asm volatile("s_waitcnt vmcnt(" #n ")" ::: "memory")
#define PG8_WAIT_L(n) asm volatile("s_waitcnt lgkmcnt(" #n ")" ::: "memory")
#define PG8_BAR __builtin_amdgcn_s_barrier()
#define PG8_SCHED __builtin_amdgcn_sched_barrier(0)
    Unit cur, nxt; int ui = 0;
    if (!S.next(0, cur)) return;
    f32x4 acc[2][2][4][2];
#pragma unroll
    for (int a = 0; a < 2; ++a)
#pragma unroll
        for (int b = 0; b < 2; ++b)
#pragma unroll
            for (int m = 0; m < 4; ++m)
#pragma unroll
                for (int n = 0; n < 2; ++n) acc[a][b][m][n] = (f32x4){0.f, 0.f, 0.f, 0.f};
    bf16x8 At[4][2], B0[2][2], B1[2][2];
    const char* cA = cur.a; const char* cB = cur.b;
    if constexpr (GATHER) { S.rows(cur, stR, stC, ga0, ga1); }
    PG8_STAGE(PG8_SB(0, 0), cB, voffB); PG8_STAGE(PG8_SB(0, 1), cB + hstep, voffB); PG8_STAGE_A(PG8_SA(0, 0), cA, 0, false); PG8_STAGE_A(PG8_SA(0, 1), cA, 1, false);
    if (wr == 1) PG8_BAR;
    PG8_WAIT_V(2); PG8_BAR;
    PG8_STAGE(PG8_SB(1, 0), cB + kstep, voffB); PG8_STAGE_A(PG8_SA(1, 0), cA + kstep, 0, false); PG8_STAGE(PG8_SB(1, 1), cB + hstep + kstep, voffB);
    PG8_WAIT_V(6); PG8_BAR;
    for (;;) {
        const bool has_next = S.next(ui + 1, nxt);
        const char* nA = has_next ? nxt.a : cA; const char* nB = has_next ? nxt.b : cB;
#pragma unroll 1
        for (int t = 0; t < nt; t += 2) {
            const bool last = (t == nt - 2);
            const char* a1 = cA + (size_t)(t + 1) * kstep;
            const char* a2 = last ? nA : cA + (size_t)(t + 2) * kstep; const char* b2 = last ? nB : cB + (size_t)(t + 2) * kstep;
            const char* a3 = a2 + kstep; const char* b3 = b2 + kstep;
            PG8_LDB(B0, 0, 0); PG8_LDB(B1, 0, 1); PG8_SCHED; PG8_LDA(At, 0, 0); PG8_STAGE_A(PG8_SA(1, 1), a1, 1, false);
            if constexpr (GATHER) { if (last && has_next) S.rows(nxt, stR, stC, ga0, ga1); }
            PG8_WAIT_V(8); PG8_WAIT_L(0); PG8_BAR; PG8_MMA(0, 0, At, B0); PG8_MMA(0, 1, At, B1); PG8_BAR; PG8_SCHED;
            PG8_LDA(At, 0, 1); PG8_STAGE(PG8_SB(0, 0), b2, voffB); PG8_STAGE(PG8_SB(0, 1), b2 + hstep, voffB); PG8_STAGE_A(PG8_SA(0, 0), a2, 0, last);
            PG8_WAIT_V(8); PG8_WAIT_L(0); PG8_BAR; PG8_MMA(1, 0, At, B0); PG8_MMA(1, 1, At, B1); PG8_BAR; PG8_SCHED;
            PG8_LDB(B0, 1, 0); PG8_LDB(B1, 1, 1); PG8_SCHED; PG8_LDA(At, 1, 0); PG8_STAGE_A(PG8_SA(0, 1), a2, 1, last);
            PG8_WAIT_V(8); PG8_WAIT_L(0); PG8_BAR; PG8_MMA(0, 0, At, B0); PG8_MMA(0, 1, At, B1); PG8_BAR; PG8_SCHED;
            PG8_LDA(At, 1, 1); PG8_STAGE(PG8_SB(1, 0), b3, voffB); PG8_STAGE(PG8_SB(1, 1), b3 + hstep, voffB); PG8_STAGE_A(PG8_SA(1, 0), a3, 0, last);
            PG8_WAIT_V(8); PG8_WAIT_L(0); PG8_BAR; PG8_MMA(1, 0, At, B0); PG8_MMA(1, 1, At, B1); PG8_BAR; PG8_SCHED;
        }
        if constexpr (ALIGN_EPI) { if (wr == 0) PG8_BAR; }
        E(acc, cur, wr, wc, fr, fq);
        if (!has_next) break;
#pragma unroll
        for (int a = 0; a < 2; ++a)
#pragma unroll
            for (int b = 0; b < 2; ++b)
#pragma unroll
                for (int m = 0; m < 4; ++m)
#pragma unroll
                    for (int n = 0; n < 2; ++n) acc[a][b][m][n] = (f32x4){0.f, 0.f, 0.f, 0.f};
        cur = nxt; cA = nA; cB = nB; ++ui;
        if constexpr (ALIGN_EPI) { if (wr == 1) PG8_BAR; }
    }
    PG8_WAIT_V(0);
    if constexpr (!ALIGN_EPI) { if (wr == 0) PG8_BAR; }
    PG8_BAR;
#undef PG8_SA
#undef PG8_SB
#undef PG8_STAGE
#undef PG8_STAGE_A
#undef PG8_LDA
#undef PG8_LDB
#undef PG8_MMA
#undef PG8_WAIT_V
#undef PG8_WAIT_L
#undef PG8_BAR
#undef PG8_SCHED
}

__device__ __forceinline__ u32x4 pack8(const f32x4 v0, const f32x4 v1) { u32x4 w; w.x = cvt_pk_bf16(v0[0], v0[1]); w.y = cvt_pk_bf16(v0[2], v0[3]); w.z = cvt_pk_bf16(v1[0], v1[1]); w.w = cvt_pk_bf16(v1[2], v1[3]); return w; }

struct EpiPlain {
    static constexpr bool PERM = true;
    bf16_t* O; int ldc;
    __device__ __forceinline__ void operator()(const f32x4 (&acc)[2][2][4][2], const Unit& u, int wr, int wc, int fr, int fq) const {
        bf16_t* base = O + (size_t)u.pm * BM * ldc + u.pn * BM;
        const unsigned lo = (unsigned)((wr * 64 + fr) * ldc + wc * 32 + 8 * fq);
#pragma unroll
        for (int ai = 0; ai < 2; ++ai)
#pragma unroll
            for (int m = 0; m < 4; ++m)
#pragma unroll
                for (int bj = 0; bj < 2; ++bj) *(u32x4*)(base + (size_t)((ai * HALF + m * 16) * ldc + bj * HALF) + lo) = pack8(acc[ai][bj][m][0], acc[ai][bj][m][1]);
    }
};
struct EpiPre {
    static constexpr bool PERM = false;
    float* out; const bf16_t* xb; float alpha;
    __device__ __forceinline__ void operator()(const f32x4 (&acc)[2][2][4][2], const Unit& u, int wr, int wc, int fr, int fq) const {
        const size_t ub = (size_t)u.pm * BM * 2048 + u.pn * BM; float* ob = out + ub; const bf16_t* xbb = xb + ub;
        const unsigned lo = (unsigned)((wr * 64 + fr) * 2048 + wc * 32 + 4 * fq);
#pragma unroll
        for (int ai = 0; ai < 2; ++ai)
#pragma unroll
            for (int m = 0; m < 4; ++m)
#pragma unroll
                for (int bj = 0; bj < 2; ++bj)
#pragma unroll
                    for (int n = 0; n < 2; ++n) { const unsigned uo = (unsigned)((ai * HALF + m * 16) * 2048 + bj * HALF + n * 16);
                        const u32x2 xw = *(const u32x2*)(xbb + uo + lo);
                        f32x4 o; o[0] = alpha * bf_lo(xw.x) + acc[ai][bj][m][n][0]; o[1] = alpha * bf_hi(xw.x) + acc[ai][bj][m][n][1]; o[2] = alpha * bf_lo(xw.y) + acc[ai][bj][m][n][2]; o[3] = alpha * bf_hi(xw.y) + acc[ai][bj][m][n][3];
                        *(f32x4*)(ob + uo + lo) = o; }
    }
};
struct EpiCinN {
    static constexpr bool PERM = true;
    bf16_t* Q; bf16_t* G; const float* cs; const float* sn;
    __device__ __forceinline__ void operator()(const f32x4 (&acc)[2][2][4][2], const Unit& u, int wr, int wc, int fr, int fq) const {
        if (u.pn < 8) {
            bf16_t* base = Q + (size_t)u.pm * BM * 2048 + u.pn * 256;
            const int i0 = wc * 32 + 8 * fq; const unsigned lo = (unsigned)((wr * 64 + fr) * 2048 + i0);
            const int s0 = ((u.pm * BM) & 4095) + wr * 64 + fr;
            const unsigned to = (unsigned)(s0 * 128 + i0);
#pragma unroll
            for (int ai = 0; ai < 2; ++ai)
#pragma unroll
                for (int m = 0; m < 4; ++m) { const unsigned tt = to + (unsigned)((ai * HALF + m * 16) * 128);
                    const f32x4 c0 = *(const f32x4*)(cs + tt), c1 = *(const f32x4*)(cs + tt + 4), s0v = *(const f32x4*)(sn + tt), s1v = *(const f32x4*)(sn + tt + 4);
                    const f32x4 x10 = acc[ai][0][m][0], x11 = acc[ai][0][m][1], x20 = acc[ai][1][m][0], x21 = acc[ai][1][m][1];
                    const f32x4 o10 = x10 * c0 - x20 * s0v, o11 = x11 * c1 - x21 * s1v, o20 = x20 * c0 + x10 * s0v, o21 = x21 * c1 + x11 * s1v;
                    bf16_t* rowp = base + (size_t)((ai * HALF + m * 16) * 2048) + lo;
                    *(u32x4*)(rowp) = pack8(o10, o11); *(u32x4*)(rowp + 128) = pack8(o20, o21); }
        } else {
            bf16_t* base = G + (size_t)u.pm * BM * 4096 + (u.pn - 8) * BM; const unsigned lo = (unsigned)((wr * 64 + fr) * 4096 + wc * 32 + 8 * fq);
#pragma unroll
            for (int ai = 0; ai < 2; ++ai)
#pragma unroll
                for (int m = 0; m < 4; ++m)
#pragma unroll
                    for (int bj = 0; bj < 2; ++bj) *(u32x4*)(base + (size_t)((ai * HALF + m * 16) * 4096 + bj * HALF) + lo) = pack8(acc[ai][bj][m][0], acc[ai][bj][m][1]);
        }
    }
};
struct EpiCinT {
    static constexpr bool PERM = true;
    bf16_t* O; const float* csT; const float* snT;
    __device__ __forceinline__ void operator()(const f32x4 (&acc)[2][2][4][2], const Unit& u, int wr, int wc, int fr, int fq) const {
        bf16_t* base = O + (size_t)u.pm * BM * 16384 + u.pn * BM; const unsigned lo = (unsigned)((wr * 64 + fr) * 16384 + wc * 32 + 8 * fq);
        if (u.pm < 8) {
            const unsigned to = (unsigned)((wr * 64 + fr) * 4096 + ((u.pn * BM) & 4095) + wc * 32 + 8 * fq);
#pragma unroll
            for (int m = 0; m < 4; ++m)
#pragma unroll
                for (int bj = 0; bj < 2; ++bj) { const unsigned tt = to + (unsigned)(m * 16 * 4096 + bj * HALF);
                    const f32x4 c0 = *(const f32x4*)(csT + tt), c1 = *(const f32x4*)(csT + tt + 4), s0 = *(const f32x4*)(snT + tt), s1 = *(const f32x4*)(snT + tt + 4);
                    const f32x4 x10 = acc[0][bj][m][0], x11 = acc[0][bj][m][1], x20 = acc[1][bj][m][0], x21 = acc[1][bj][m][1];
                    const f32x4 o10 = (x10 * c0 - x20 * s0) * 0.0625f, o11 = (x11 * c1 - x21 * s1) * 0.0625f, o20 = (x20 * c0 + x10 * s0) * 0.0625f, o21 = (x21 * c1 + x11 * s1) * 0.0625f;
                    *(u32x4*)(base + (size_t)(m * 16 * 16384 + bj * HALF) + lo) = pack8(o10, o11);
                    *(u32x4*)(base + (size_t)((HALF + m * 16) * 16384 + bj * HALF) + lo) = pack8(o20, o21); }
        } else {
#pragma unroll
            for (int ai = 0; ai < 2; ++ai)
#pragma unroll
                for (int m = 0; m < 4; ++m)
#pragma unroll
                    for (int bj = 0; bj < 2; ++bj) *(u32x4*)(base + (size_t)((ai * HALF + m * 16) * 16384 + bj * HALF) + lo) = pack8(acc[ai][bj][m][0], acc[ai][bj][m][1]);
        }
    }
};
struct EpiPle {
    static constexpr bool PERM = true;
    bf16_t* PLE; const bf16_t* PROJ; const float* bias; float* LOG;
    __device__ __forceinline__ void operator()(const f32x4 (&acc)[2][2][4][2], const Unit& u, int wr, int wc, int fr, int fq) const {
        if (u.pn < 8) {
            const size_t ub = (size_t)u.pm * BM * 2048 + u.pn * BM; bf16_t* pb = PLE + ub; const bf16_t* jb = PROJ + ub; const float* bb = bias + u.pn * BM;
            const unsigned lo = (unsigned)((wr * 64 + fr) * 2048 + wc * 32 + 8 * fq), lc = (unsigned)(wc * 32 + 8 * fq);
#pragma unroll
            for (int bj = 0; bj < 2; ++bj) { const f32x4 bv0 = *(const f32x4*)(bb + lc + bj * HALF), bv1 = *(const f32x4*)(bb + lc + bj * HALF + 4);
#pragma unroll
                for (int ai = 0; ai < 2; ++ai)
#pragma unroll
                    for (int m = 0; m < 4; ++m) { const unsigned uo = (unsigned)((ai * HALF + m * 16) * 2048 + bj * HALF); const u32x4 pw = *(const u32x4*)(jb + uo + lo);
                        f32x4 v0 = acc[ai][bj][m][0] + bv0, v1 = acc[ai][bj][m][1] + bv1;
                        v0[0] = sigmoidf_(v0[0]) * bf_lo(pw.x); v0[1] = sigmoidf_(v0[1]) * bf_hi(pw.x); v0[2] = sigmoidf_(v0[2]) * bf_lo(pw.y); v0[3] = sigmoidf_(v0[3]) * bf_hi(pw.y);
                        v1[0] = sigmoidf_(v1[0]) * bf_lo(pw.z); v1[1] = sigmoidf_(v1[1]) * bf_hi(pw.z); v1[2] = sigmoidf_(v1[2]) * bf_lo(pw.w); v1[3] = sigmoidf_(v1[3]) * bf_hi(pw.w);
                        *(u32x4*)(pb + uo + lo) = pack8(v0, v1); } }
        } else if (wc < 2) {
            float* lb = LOG + (size_t)u.pm * BM * 64; const unsigned lo = (unsigned)((wr * 64 + fr) * 64 + wc * 32 + 8 * fq);
#pragma unroll
            for (int ai = 0; ai < 2; ++ai)
#pragma unroll
                for (int m = 0; m < 4; ++m) { float* rowp = lb + (ai * HALF + m * 16) * 64 + lo;
                    *(f32x4*)(rowp) = acc[ai][0][m][0]; *(f32x4*)(rowp + 4) = acc[ai][0][m][1]; }
        }
    }
};
struct EpiGU {
    static constexpr bool PERM = true;
    bf16_t* HB;
    __device__ __forceinline__ void operator()(const f32x4 (&acc)[2][2][4][2], const Unit& u, int wr, int wc, int fr, int fq) const {
        bf16_t* base = HB + (size_t)u.pm * BM * 512 + u.pn * 128; const unsigned lo = (unsigned)((wr * 64 + fr) * 512 + wc * 32 + 8 * fq);
#pragma unroll
        for (int ai = 0; ai < 2; ++ai)
#pragma unroll
            for (int m = 0; m < 4; ++m) { f32x4 h0, h1;
#pragma unroll
                for (int j = 0; j < 4; ++j) { const float g0 = acc[ai][0][m][0][j], g1 = acc[ai][0][m][1][j]; h0[j] = g0 * sigmoidf_(g0) * acc[ai][1][m][0][j]; h1[j] = g1 * sigmoidf_(g1) * acc[ai][1][m][1][j]; }
                *(u32x4*)(base + (size_t)((ai * HALF + m * 16) * 512) + lo) = pack8(h0, h1); }
    }
};
}

namespace att {
constexpr int KVBLK = 64;
constexpr int SHM_V = 16384, SHM_K = 16384, SHM_P = 8192;
constexpr int OFF_V = 0, OFF_K = 2 * SHM_V, OFF_P = OFF_K + 2 * SHM_K, OFF_WS = OFF_P + 2 * SHM_P, OFF_BIAS = OFF_WS + 8 * 64 * 4, OFF_QPE = OFF_BIAS + 512 * 4, OFF_QNO = OFF_QPE + 256 * 128, ATT_LDS = OFF_QNO + 256 * 128;
#define KSWZ(row, colB) ((row) * 256 + ((colB) ^ (((row) & 7) << 4)))
#define PSWZ(row, colB) ((row) * 128 + ((colB) ^ (((row) & 7) << 4)))
__device__ __forceinline__ int crow(int r, int hi) { return (r & 3) + 8 * (r >> 2) + 4 * hi; }

template <int MODE> struct Cfg;
template <> struct Cfg<0> { static constexpr int NQ = 4; static constexpr float SCALE = 0.07216878364870323f; static constexpr int LDQ = 1536, LDK = 2048, LDO = 2048; };
template <> struct Cfg<1> { static constexpr int NQ = 4;  static constexpr float SCALE = 0.08838834764831845f; static constexpr int LDQ = 4096, LDK = 4096, LDO = 2048; };
constexpr float THRN = 8.f;

template <int MODE>
__device__ __forceinline__ void partialSM(f32x16& p0, f32x16& p1, float& m_reg, float& mn, float& alpha) {
  constexpr float SCALE = Cfg<MODE>::SCALE; constexpr float C = SCALE * 1.4426950408889634f;
  float pmax = p0[0];
#pragma unroll
  for (int r = 1; r < 16; ++r) pmax = fmaxf(pmax, p0[r]);
#pragma unroll
  for (int r = 0; r < 16; ++r) pmax = fmaxf(pmax, p1[r]);
  { auto rr = __builtin_amdgcn_permlane32_swap(__float_as_uint(pmax), __float_as_uint(pmax), false, false);
    pmax = fmaxf(__uint_as_float(rr[0]), __uint_as_float(rr[1])); }
  if (__builtin_expect(__all(pmax - m_reg <= THRN / SCALE), 1)) { mn = m_reg; alpha = 1.f; }
  else { mn = fmaxf(m_reg, pmax); alpha = __builtin_amdgcn_exp2f((m_reg - mn) * C); m_reg = mn; }
  float mnC = -mn * C;
#pragma unroll
  for (int r = 0; r < 16; ++r) p0[r] = fmaf(p0[r], C, mnC);
#pragma unroll
  for (int r = 0; r < 16; ++r) p1[r] = fmaf(p1[r], C, mnC);
#pragma unroll
  for (int r = 0; r < 16; ++r) p0[r] = __builtin_amdgcn_exp2f(p0[r]);
}
__device__ __forceinline__ void finishSM(f32x16& p0, f32x16& p1, float alpha, float& l_reg, bf16x8& pa0, bf16x8& pa1, bf16x8& pa2, bf16x8& pa3) {
#pragma unroll
  for (int r = 0; r < 16; ++r) p1[r] = __builtin_amdgcn_exp2f(p1[r]);
  float ps = 0;
#pragma unroll
  for (int r = 0; r < 16; ++r) ps += p0[r];
#pragma unroll
  for (int r = 0; r < 16; ++r) ps += p1[r];
  { auto rr = __builtin_amdgcn_permlane32_swap(__float_as_uint(ps), __float_as_uint(ps), false, false);
    ps = __uint_as_float(rr[0]) + __uint_as_float(rr[1]); }
  l_reg = l_reg * alpha + ps;
#define PK4(P, BASE, OUT) do { unsigned a0 = cvt_pk_bf16(P[BASE + 0], P[BASE + 1]), a1 = cvt_pk_bf16(P[BASE + 2], P[BASE + 3]);   \
    unsigned b0 = cvt_pk_bf16(P[BASE + 4], P[BASE + 5]), b1 = cvt_pk_bf16(P[BASE + 6], P[BASE + 7]);                              \
    auto r0 = __builtin_amdgcn_permlane32_swap(a0, b0, false, false); auto r1 = __builtin_amdgcn_permlane32_swap(a1, b1, false, false); \
    u32x4 w = {r0[0], r1[0], r0[1], r1[1]}; OUT = *reinterpret_cast<bf16x8*>(&w); } while (0)
  PK4(p0, 0, pa0); PK4(p0, 8, pa1); PK4(p1, 0, pa2); PK4(p1, 8, pa3);
#undef PK4
}
template <int MODE>
__device__ __forceinline__ void qkt(f32x16& p0, f32x16& p1, const char* Ks, const char* Ps, const bf16x8* qr, const char* qpe, int r32, int hi) {
  p0 = f32x16{}; p1 = f32x16{};
#pragma unroll
  for (int d0 = 0; d0 < 8; ++d0) { int cb = (d0 * 16 + hi * 8) * 2;
    bf16x8 b0 = *reinterpret_cast<const bf16x8*>(Ks + KSWZ(r32, cb));
    bf16x8 b1 = *reinterpret_cast<const bf16x8*>(Ks + KSWZ(32 + r32, cb));
    const bf16x8 qf = d0 < 4 ? qr[d0 & 3] : *reinterpret_cast<const bf16x8*>(qpe + 256 * 128 + ((((d0 - 4) * 16 + hi * 8) * 2) ^ ((r32 & 7) << 4)));
    p0 = __builtin_amdgcn_mfma_f32_32x32x16_bf16(b0, qf, p0, 0, 0, 0);
    p1 = __builtin_amdgcn_mfma_f32_32x32x16_bf16(b1, qf, p1, 0, 0, 0); }
  if constexpr (MODE == 0) {
#pragma unroll
    for (int d0 = 0; d0 < 4; ++d0) { int cb = (d0 * 16 + hi * 8) * 2;
      bf16x8 b0 = *reinterpret_cast<const bf16x8*>(Ps + PSWZ(r32, cb));
      bf16x8 b1 = *reinterpret_cast<const bf16x8*>(Ps + PSWZ(32 + r32, cb));
      const bf16x8 qp = *reinterpret_cast<const bf16x8*>(qpe + (cb ^ ((r32 & 7) << 4)));
      p0 = __builtin_amdgcn_mfma_f32_32x32x16_bf16(b0, qp, p0, 0, 0, 0);
      p1 = __builtin_amdgcn_mfma_f32_32x32x16_bf16(b1, qp, p1, 0, 0, 0); }
  }
}
__device__ __forceinline__ int v_st(int k, int c) { const int kk = (k & ~0xC) | ((k & 4) << 1) | ((k & 8) >> 1); return ((kk >> 3) * 4 + (c >> 5)) * 512 + ((kk & 7) * 32 + (c & 31)) * 2; }
__device__ __forceinline__ int v_rd_base(int lane) { return ((lane & 3) << 3) | (((lane >> 2) & 3) << 6) | (((lane >> 4) & 1) << 5) | (((lane >> 5) & 1) << 8); }
constexpr int v_rd_off(int d0, int ks, int half) { return d0 * 512 + ks * 4096 + half * 2048; }
template <int OFF> __device__ __forceinline__ s16x4 tr_read(int vb) {
  s16x4 r; asm volatile("ds_read_b64_tr_b16 %0, %1 offset:%2" : "=&v"(r) : "v"(vb), "i"(OFF) : "memory"); return r;
}
template <int D0> __device__ __forceinline__ void pv_one(f32x16& od, int vb, bf16x8 pa0, bf16x8 pa1, bf16x8 pa2, bf16x8 pa3) {
  const s16x4 l0 = tr_read<v_rd_off(D0, 0, 0)>(vb), h0 = tr_read<v_rd_off(D0, 0, 1)>(vb), l1 = tr_read<v_rd_off(D0, 1, 0)>(vb), h1 = tr_read<v_rd_off(D0, 1, 1)>(vb);
  const s16x4 l2 = tr_read<v_rd_off(D0, 2, 0)>(vb), h2 = tr_read<v_rd_off(D0, 2, 1)>(vb), l3 = tr_read<v_rd_off(D0, 3, 0)>(vb), h3 = tr_read<v_rd_off(D0, 3, 1)>(vb);
  asm volatile("s_waitcnt lgkmcnt(0)" ::: "memory"); SBAR();
#define PKV(L, H) (bf16x8){L[0], L[1], L[2], L[3], H[0], H[1], H[2], H[3]}
  od = __builtin_amdgcn_mfma_f32_32x32x16_bf16(pa0, PKV(l0, h0), od, 0, 0, 0);
  od = __builtin_amdgcn_mfma_f32_32x32x16_bf16(pa1, PKV(l1, h1), od, 0, 0, 0);
  od = __builtin_amdgcn_mfma_f32_32x32x16_bf16(pa2, PKV(l2, h2), od, 0, 0, 0);
  od = __builtin_amdgcn_mfma_f32_32x32x16_bf16(pa3, PKV(l3, h3), od, 0, 0, 0);
#undef PKV
}
__device__ __forceinline__ void pv_d0(f32x16* o, int vb, bf16x8 pa0, bf16x8 pa1, bf16x8 pa2, bf16x8 pa3) {
  pv_one<0>(o[0], vb, pa0, pa1, pa2, pa3); pv_one<1>(o[1], vb, pa0, pa1, pa2, pa3); pv_one<2>(o[2], vb, pa0, pa1, pa2, pa3); pv_one<3>(o[3], vb, pa0, pa1, pa2, pa3);
}
__device__ __forceinline__ void na_mask(f32x16& p0, f32x16& p1, const float* biasS, int kr, int rq, int cq, int hi) {
  const int rs = min(max(rq - 4, 0), 56), cs = min(max(cq - 8, 0), 48);
  const bool rowok = (kr >= rs) && (kr <= rs + 7);
  int lo = (rowok ? cs : 1000) - 4 * hi;
  int bidx = (kr - rq + 7) * 31 - cq + 15 + 4 * hi;
  asm volatile("" : "+v"(bidx), "+v"(lo));
  const float* bp = biasS + bidx;
#pragma unroll
  for (int r = 0; r < 16; ++r) {
    const int c0 = (r & 3) + 8 * (r >> 2), c1 = 32 + c0;
    const bool ok0 = (unsigned)(c0 - lo) < 16u, ok1 = (unsigned)(c1 - lo) < 16u;
    const float b0 = bp[c0], b1 = bp[c1];
    p0[r] = ok0 ? p0[r] + b0 : -3.0e38f; p1[r] = ok1 ? p1[r] + b1 : -3.0e38f;
  }
}

struct AttnArgs {
  const bf16* Qp;
  const bf16* Kp; const bf16* Vp;
  const bf16* Pp;
  bf16* Op;
  const float* cosM; const float* sinM;
  int s0;
  int NT;
  int kr0;
  int rg;
};

template <int MODE>
__device__ __forceinline__ void attn_item(const AttnArgs& A, char* lds) {
  constexpr int NQ = Cfg<MODE>::NQ, LDQ = Cfg<MODE>::LDQ, LDK = Cfg<MODE>::LDK, LDO = Cfg<MODE>::LDO;
  int tid_ = threadIdx.x; asm volatile("" : "+v"(tid_));
  const int tid = tid_, wid = tid >> 6, lane = tid & 63, r32 = lane & 31, hi = lane >> 5;
  char* V_lds = lds + OFF_V; char* K_lds = lds + OFF_K; char* P_lds = lds + OFF_P;
  float* ws = (float*)(lds + OFF_WS) + wid * 64; float* li_l = ws; float* al_l = ws + 32;
  const float* biasS = (const float*)(lds + OFF_BIAS);
  float m_reg = -1e30f, l_reg = 0; f32x16 o[4] = {}; bf16x8 qr[NQ];
  char* qpe_row = lds + OFF_QPE + (wid * 32 + r32) * 128;
  const bf16* Qw = A.Qp + (wid * 32 + r32) * LDQ + hi * 8;
#pragma unroll
  for (int d0 = 0; d0 < 4; ++d0) qr[d0] = *reinterpret_cast<const bf16x8*>(Qw + d0 * 16);
#pragma unroll
  for (int d0 = 4; d0 < 8; ++d0) *reinterpret_cast<bf16x8*>(qpe_row + 256 * 128 + ((((d0 - 4) * 16 + hi * 8) * 2) ^ ((r32 & 7) << 4))) = *reinterpret_cast<const bf16x8*>(Qw + d0 * 16);
  if constexpr (MODE == 0) {
    const int s = A.s0 + wid * 32 + r32;
#pragma unroll
    for (int c = 0; c < 2; ++c) {
      const u32x4 x1 = *reinterpret_cast<const u32x4*>(Qw + (8 + c) * 16), x2 = *reinterpret_cast<const u32x4*>(Qw + (10 + c) * 16);
      const int i0 = c * 16 + hi * 8;
      const f32x4 ca = *(const f32x4*)(A.cosM + s * 32 + i0), cb = *(const f32x4*)(A.cosM + s * 32 + i0 + 4), sa = *(const f32x4*)(A.sinM + s * 32 + i0), sb = *(const f32x4*)(A.sinM + s * 32 + i0 + 4);
      float a[8], b[8], cc[8], ss[8];
      a[0] = bf_lo(x1.x); a[1] = bf_hi(x1.x); a[2] = bf_lo(x1.y); a[3] = bf_hi(x1.y); a[4] = bf_lo(x1.z); a[5] = bf_hi(x1.z); a[6] = bf_lo(x1.w); a[7] = bf_hi(x1.w);
      b[0] = bf_lo(x2.x); b[1] = bf_hi(x2.x); b[2] = bf_lo(x2.y); b[3] = bf_hi(x2.y); b[4] = bf_lo(x2.z); b[5] = bf_hi(x2.z); b[6] = bf_lo(x2.w); b[7] = bf_hi(x2.w);
#pragma unroll
      for (int j = 0; j < 4; ++j) { cc[j] = ca[j]; cc[4 + j] = cb[j]; ss[j] = sa[j]; ss[4 + j] = sb[j]; }
      float o1[8], o2[8];
#pragma unroll
      for (int j = 0; j < 8; ++j) { o1[j] = a[j] * cc[j] - b[j] * ss[j]; o2[j] = b[j] * cc[j] + a[j] * ss[j]; }
      u32x4 w1 = {cvt_pk_bf16(o1[0], o1[1]), cvt_pk_bf16(o1[2], o1[3]), cvt_pk_bf16(o1[4], o1[5]), cvt_pk_bf16(o1[6], o1[7])};
      u32x4 w2 = {cvt_pk_bf16(o2[0], o2[1]), cvt_pk_bf16(o2[2], o2[3]), cvt_pk_bf16(o2[4], o2[5]), cvt_pk_bf16(o2[6], o2[7])};
      *reinterpret_cast<u32x4*>(qpe_row + (((c * 16 + hi * 8) * 2) ^ ((r32 & 7) << 4))) = w1; *reinterpret_cast<u32x4*>(qpe_row + (((32 + c * 16 + hi * 8) * 2) ^ ((r32 & 7) << 4))) = w2;
    }
  }
  const int rq = A.rg * 4 + (wid >> 1), cq = 32 * (wid & 1) + r32;
  const int sr = tid >> 4, sc = (tid & 15) * 8, vst0 = v_st(sr, sc), vst1 = v_st(32 + sr, sc);
  const int pr = tid >> 3, pc = (tid & 7) * 8;
  const int vb0 = (int)(uintptr_t)V_lds + v_rd_base(lane);
  bf16x8 vs0, vs1, ks0, ks1, ps0;
  const int kvo0 = sr * LDK + sc, kvo1 = (32 + sr) * LDK + sc, po0 = pr * 64 + pc;
#define SLOAD(k0) do { const bf16* Vt = A.Vp + (size_t)(k0) * LDK; const bf16* Kt = A.Kp + (size_t)(k0) * LDK; \
    vs0 = *reinterpret_cast<const bf16x8*>(Vt + kvo0); vs1 = *reinterpret_cast<const bf16x8*>(Vt + kvo1); \
    ks0 = *reinterpret_cast<const bf16x8*>(Kt + kvo0); ks1 = *reinterpret_cast<const bf16x8*>(Kt + kvo1); \
    if constexpr (MODE == 0) ps0 = *reinterpret_cast<const bf16x8*>(A.Pp + (size_t)(k0) * 64 + po0); } while (0)
#define SWRITE(b) do { *(bf16x8*)(V_lds + (b) * SHM_V + vst0) = vs0; *(bf16x8*)(V_lds + (b) * SHM_V + vst1) = vs1; int kc = sc * 2; \
    *(bf16x8*)(K_lds + (b) * SHM_K + KSWZ(sr, kc)) = ks0; *(bf16x8*)(K_lds + (b) * SHM_K + KSWZ(32 + sr, kc)) = ks1; \
    if constexpr (MODE == 0) *(bf16x8*)(P_lds + (b) * SHM_P + PSWZ(pr, pc * 2)) = ps0; } while (0)
#define SWAIT() asm volatile("s_waitcnt vmcnt(0)" ::: "memory")
#define RESC(a) do { if (__any((a) < 1.f)) { if (hi == 0) al_l[r32] = (a); asm volatile("s_waitcnt lgkmcnt(0)" ::: "memory"); \
    _Pragma("unroll") for (int d = 0; d < 4; ++d) _Pragma("unroll") for (int r = 0; r < 16; ++r) o[d][r] *= al_l[crow(r, hi)]; } } while (0)
#define NAM(P0, P1, j) do { if constexpr (MODE == 1) na_mask(P0, P1, biasS, A.kr0 + (j), rq, cq, hi); } while (0)
  f32x16 pA0, pA1, pB0, pB1; float mnA, mnB, alA, alB; bf16x8 pa0, pa1, pa2, pa3; const int NT = A.NT;
  SLOAD(0); asm volatile("s_waitcnt vmcnt(0)" ::: "memory"); SWRITE(0); __syncthreads();
  qkt<MODE>(pA0, pA1, K_lds, P_lds, qr, qpe_row, r32, hi); NAM(pA0, pA1, 0); partialSM<MODE>(pA0, pA1, m_reg, mnA, alA);
  SLOAD(KVBLK);
  SWAIT(); SWRITE(1); __syncthreads();
  for (int j = 1; j + 1 < NT; j += 2) {
    SBAR(); qkt<MODE>(pB0, pB1, K_lds + SHM_K, P_lds + SHM_P, qr, qpe_row, r32, hi); NAM(pB0, pB1, j);
    finishSM(pA0, pA1, alA, l_reg, pa0, pa1, pa2, pa3); SBAR();
    SLOAD((j + 1) * KVBLK); SBAR();
    pv_d0(o, vb0, pa0, pa1, pa2, pa3); partialSM<MODE>(pB0, pB1, m_reg, mnB, alB);
    __syncthreads(); SWAIT(); SWRITE(0);
    RESC(alB); __syncthreads();
    SBAR(); qkt<MODE>(pA0, pA1, K_lds, P_lds, qr, qpe_row, r32, hi); NAM(pA0, pA1, j + 1);
    finishSM(pB0, pB1, alB, l_reg, pa0, pa1, pa2, pa3); SBAR();
    SLOAD((j + 2) * KVBLK); SBAR();
    pv_d0(o, vb0 + SHM_V, pa0, pa1, pa2, pa3); partialSM<MODE>(pA0, pA1, m_reg, mnA, alA);
    __syncthreads(); SWAIT(); SWRITE(1);
    RESC(alA); __syncthreads();
  }
  SBAR(); qkt<MODE>(pB0, pB1, K_lds + SHM_K, P_lds + SHM_P, qr, qpe_row, r32, hi); NAM(pB0, pB1, NT - 1);
  finishSM(pA0, pA1, alA, l_reg, pa0, pa1, pa2, pa3); SBAR();
  pv_d0(o, vb0, pa0, pa1, pa2, pa3); partialSM<MODE>(pB0, pB1, m_reg, mnB, alB);
  __syncthreads(); RESC(alB);
  finishSM(pB0, pB1, alB, l_reg, pa0, pa1, pa2, pa3); SBAR();
  pv_d0(o, vb0 + SHM_V, pa0, pa1, pa2, pa3);
  if (hi == 0) li_l[r32] = l_reg; asm volatile("s_waitcnt lgkmcnt(0)" ::: "memory");
  float rli[16];
#pragma unroll
  for (int r = 0; r < 16; ++r) rli[r] = __builtin_amdgcn_rcpf(li_l[crow(r, hi)]);
  bf16* Ow = A.Op + (wid * 32) * LDO + r32;
#pragma unroll
  for (int r = 0; r < 16; ++r) { const int orow = crow(r, hi);
#pragma unroll
    for (int d0 = 0; d0 < 4; ++d0) Ow[orow * LDO + d0 * 32] = f2bf(o[d0][r] * rli[r]); }
  __syncthreads();
#undef SLOAD
#undef SWRITE
#undef SWAIT
#undef RESC
#undef NAM
}
}

namespace ret {
constexpr int ST_PITCH = 528;
constexpr int OFF_VT = 0, VT_BYTES = 128 * 256, OFF_ST = 2 * VT_BYTES, ST_BYTES = 128 * ST_PITCH, RET_LDS = OFF_ST + ST_BYTES;
__device__ __forceinline__ int crow(int r, int hi) { return (r & 3) + 8 * (r >> 2) + 4 * hi; }

__device__ __forceinline__ unsigned ktoff(unsigned row, unsigned ch) { return 256u * row + 16u * (ch ^ (((row & 3u) << 2) | ((row >> 2) & 3u))); }
__device__ __forceinline__ void pprime_item(int item, const bf16* Qm, const bf16* KVT, bf16* PP, const float* lg2f, const float* lg2b, char* lds) {
  int tid_ = threadIdx.x; asm volatile("" : "+v"(tid_));
  const int tid = tid_, wid = __builtin_amdgcn_readfirstlane(tid >> 6), lane = tid & 63, r32 = lane & 31, hi = lane >> 5;
  const int bh = item >> 5, n = item & 31, b = bh >> 3, h = bh & 7;
  const int T0 = b * 4096 + n * 128;
  const int kb = wid >> 1, qb0 = 2 * (wid & 1);
  LAS unsigned char* ldsl = (LAS unsigned char*)lds;
  const char* kg = (const char*)(KVT + (size_t)(h * 256) * 16384 + T0);
#pragma unroll
  for (int i = 0; i < 8; ++i) { const unsigned d = 32u * wid + 4u * i + (lane >> 4); const unsigned ch = (lane & 15u) ^ (((d & 3u) << 2) | ((d >> 2) & 3u));
    __builtin_amdgcn_global_load_lds((const unsigned*)(kg + (size_t)d * 32768 + ch * 16), (LAS unsigned*)(ldsl + (8 * wid + i) * 1024), 16, 0, 0); }
  const bf16* Q0 = Qm + (size_t)(T0 + 32 * qb0 + r32) * 2048 + h * 256 + 8 * hi;
  bf16x8 q0[16], q1[16];
#pragma unroll
  for (int s = 0; s < 16; ++s) { q0[s] = *reinterpret_cast<const bf16x8*>(Q0 + 16 * s); q1[s] = *reinterpret_cast<const bf16x8*>(Q0 + (size_t)32 * 2048 + 16 * s); }
  asm volatile("s_waitcnt vmcnt(0)" ::: "memory");
  __builtin_amdgcn_s_barrier(); asm volatile("" ::: "memory");
  const unsigned blk = (lane >> 4) & 1u, qq = (lane & 15u) >> 2, pp = lane & 3u;
  const unsigned ldsb = (unsigned)(size_t)ldsl;
  f32x16 acc0 = {}, acc1 = {};
#pragma unroll
  for (int ks = 0; ks < 16; ++ks) {
    const unsigned a0 = ldsb + ktoff(16u * ks + 8u * hi + qq, 4u * kb + 2u * blk + (pp >> 1)) + 8u * (pp & 1u);
    const unsigned a1 = ldsb + ktoff(16u * ks + 8u * hi + 4u + qq, 4u * kb + 2u * blk + (pp >> 1)) + 8u * (pp & 1u);
    s16x4 lo, hi4;
    asm volatile("ds_read_b64_tr_b16 %0, %2\n\tds_read_b64_tr_b16 %1, %3\n\ts_waitcnt lgkmcnt(0)" : "=&v"(lo), "=&v"(hi4) : "v"(a0), "v"(a1) : "memory");
    const bf16x8 a = (bf16x8){lo[0], lo[1], lo[2], lo[3], hi4[0], hi4[1], hi4[2], hi4[3]};
    acc0 = __builtin_amdgcn_mfma_f32_32x32x16_bf16(a, q0[ks], acc0, 0, 0, 0);
    acc1 = __builtin_amdgcn_mfma_f32_32x32x16_bf16(a, q1[ks], acc1, 0, 0, 0);
  }
  bf16* Pf = PP + ((size_t)(bh * 32 + n) * 128) * 128;
  bf16* Pb = Pf + (size_t)1024 * 128 * 128;
#pragma unroll
  for (int t = 0; t < 2; ++t) {
    const int q = 32 * (qb0 + t) + r32;
#pragma unroll
    for (int g = 0; g < 4; ++g) {
      const int k0 = 32 * kb + 8 * g + 4 * hi;
      float vf[4], vb[4];
#pragma unroll
      for (int j = 0; j < 4; ++j) { const int k = k0 + j; const float sc = t ? acc1[4 * g + j] : acc0[4 * g + j];
        vf[j] = (k <= q) ? sc : 0.f;
        vb[j] = (k > q) ? sc : 0.f; }
      u32x2 wf = {cvt_pk_bf16(vf[0], vf[1]), cvt_pk_bf16(vf[2], vf[3])}, wb = {cvt_pk_bf16(vb[0], vb[1]), cvt_pk_bf16(vb[2], vb[3])};
      *reinterpret_cast<u32x2*>(Pf + (size_t)q * 128 + k0) = wf;
      *reinterpret_cast<u32x2*>(Pb + (size_t)q * 128 + k0) = wb;
    }
  }
  asm volatile("s_waitcnt lgkmcnt(0)" ::: "memory"); __builtin_amdgcn_s_barrier(); asm volatile("" ::: "memory");
}

#if defined(CH_WAVE)
#define CSTAMP(seg) do { if (blockIdx.x == 0 && wid == CH_WAVE && lane == 0) { const unsigned now_ = (unsigned)__builtin_amdgcn_s_memrealtime(); volatile unsigned* m_ = (volatile unsigned*)(lds + 159744 + 4 * 450); m_[seg] += now_ - m_[15]; m_[15] = now_; } } while (0)
#else
#define CSTAMP(seg) do { } while (0)
#endif
__device__ __forceinline__ void chain_item(int item, const bf16* Qm, const bf16* KVT, const bf16* PP, bf16* Rf, bf16* Rb, const float* lg2f, const float* lg2b, char* lds) {
  int tid_ = threadIdx.x; asm volatile("" : "+v"(tid_));
  const int tid = tid_, wid = __builtin_amdgcn_readfirstlane(tid >> 6), lane = tid & 63, r32 = lane & 31, hi = lane >> 5;
  const int j = item & 3, dir = (item >> 2) & 1, bh = item >> 3, b = bh >> 3, h = bh & 7;
  const float lg2 = dir ? lg2b[h] : lg2f[h];
  const float cdec = __builtin_amdgcn_exp2f(lg2 * 128.f);
  bf16* Rout = dir ? Rb : Rf;
  const bf16* VTg = KVT + (size_t)(2048 + h * 512 + 128 * j) * 16384;
  const bf16* KTg = KVT + (size_t)(h * 256) * 16384;
  const bf16* PPd = PP + (size_t)dir * 1024 * 128 * 128 + (size_t)(bh * 32) * 128 * 128;
  char* STl = lds + OFF_ST;
  { unsigned z = 0u; asm volatile("" : "+v"(z));
    for (int i = tid; i < ST_BYTES / 16; i += 512) *reinterpret_cast<u32x4*>(STl + i * 16) = (u32x4){z, z, z, z}; }
#define VDMA(T0, buf) do { const char* vg = (const char*)(VTg + (T0)); int l_ = lane; asm volatile("" : "+v"(l_)); _Pragma("unroll") for (int i = 0; i < 4; ++i) { \
      const int v_ = 16 * wid + 4 * i + (l_ >> 4); const unsigned so_ = (unsigned)v_ * 32768u + (unsigned)(((l_ & 15) ^ (v_ & 15)) * 16); \
      __builtin_amdgcn_global_load_lds((const unsigned*)(vg + so_), (LAS unsigned*)(ldsl + OFF_VT + (buf) * VT_BYTES + (4 * wid + i) * 1024), 16, 0, 0); } } while (0)
  LAS unsigned char* ldsl = (LAS unsigned char*)lds;
  { const int n0 = dir ? 31 : 0; VDMA(b * 4096 + n0 * 128, 0); asm volatile("s_waitcnt vmcnt(0)" ::: "memory"); }
#define WGBAR() do { asm volatile("s_waitcnt lgkmcnt(0)" ::: "memory"); __builtin_amdgcn_s_barrier(); asm volatile("" ::: "memory"); } while (0)
#define VSCALE(buf) do { float lq_ = lg2; asm volatile("" : "+v"(lq_)); const int kc_ = 8 * ((tid & 15) ^ ((tid >> 4) & 15)); float kq_[8]; \
      _Pragma("unroll") for (int e = 0; e < 8; ++e) kq_[e] = __builtin_amdgcn_exp2f(dir ? lq_ * (float)(kc_ + e - 128) : -lq_ * (float)(kc_ + e + 1)); \
      _Pragma("unroll") for (int i = 0; i < 4; ++i) { u32x4* p_ = reinterpret_cast<u32x4*>(lds + OFF_VT + (buf) * VT_BYTES + (tid + 512 * i) * 16); const u32x4 x_ = *p_; u32x4 w_; \
        w_.x = cvt_pk_bf16(bf_lo(x_.x) * kq_[0], bf_hi(x_.x) * kq_[1]); w_.y = cvt_pk_bf16(bf_lo(x_.y) * kq_[2], bf_hi(x_.y) * kq_[3]); w_.z = cvt_pk_bf16(bf_lo(x_.z) * kq_[4], bf_hi(x_.z) * kq_[5]); w_.w = cvt_pk_bf16(bf_lo(x_.w) * kq_[6], bf_hi(x_.w) * kq_[7]); \
        *p_ = w_; } } while (0)
  WGBAR();
  VSCALE(0);
  WGBAR();
  if (wid < 4) {
#ifndef RET_NO_Q
    const int qb = wid; int buf = 0;
    bf16x8 pf[8], qf[16];
    const unsigned qlo = (unsigned)(r32 * 2048 + 8 * hi), plo = (unsigned)(r32 * 128 + 8 * hi), rlo = (unsigned)(4 * hi * 4096 + r32);
    { const int n = dir ? 31 : 0; const int T0 = b * 4096 + n * 128;
      const bf16* Qr = Qm + (size_t)(T0 + 32 * qb) * 2048 + h * 256 + qlo; const bf16* Pr = PPd + ((size_t)n * 128 + 32 * qb) * 128 + plo;
#pragma unroll
      for (int s = 0; s < 8; ++s) pf[s] = *reinterpret_cast<const bf16x8*>(Pr + 16 * s);
#pragma unroll
      for (int s = 0; s < 16; ++s) qf[s] = *reinterpret_cast<const bf16x8*>(Qr + 16 * s); }
    const int vrow = r32 * 256 + ((hi ^ (r32 & 1)) << 4), vx = (r32 & 14) << 4, srow = r32 * ST_PITCH + 16 * hi;
    for (int ci = 0; ci < 32; ++ci) {
      const int n = dir ? 31 - ci : ci; const int T0 = b * 4096 + n * 128;
      const int nn = dir ? n - 1 : n + 1; const int T1 = b * 4096 + nn * 128;
      if (ci < 31) VDMA(T1, buf ^ 1);
      const char* VTl = lds + OFF_VT + buf * VT_BYTES + vrow; const char* STr = STl + srow;
      f32x16 o[4];
#pragma unroll
      for (int v = 0; v < 4; ++v) o[v] = f32x16{};
      bf16x8 b0[4];
#define RB(dst, t) do { _Pragma("unroll") for (int v = 0; v < 4; ++v) dst[v] = ((t) < 8) ? *reinterpret_cast<const bf16x8*>(VTl + (32 * v) * 256 + ((32 * (t)) ^ vx)) : *reinterpret_cast<const bf16x8*>(STr + (32 * v) * ST_PITCH + 32 * ((t) - 8)); } while (0)
#define RA(t) (((t) < 8) ? pf[(t) & 7] : qf[((t) - 8) & 15])
#pragma unroll
      for (int t = 0; t < 24; ++t) {
        RB(b0, t);
#pragma unroll
        for (int v = 0; v < 4; ++v) o[v] = __builtin_amdgcn_mfma_f32_32x32x16_bf16(RA(t), b0[v], o[v], 0, 0, 0);
        SBAR();
        if (t == 7 && ci < 31) {
          const bf16* Pr = PPd + ((size_t)nn * 128 + 32 * qb) * 128 + plo;
#pragma unroll
          for (int s = 0; s < 8; ++s) pf[s] = *reinterpret_cast<const bf16x8*>(Pr + 16 * s);
          asm volatile("s_waitcnt vmcnt(8)" ::: "memory");
          SBAR(); }
      }
#undef RB
#undef RA
      if (ci < 31) {
        const bf16* Qr = Qm + (size_t)(T1 + 32 * qb) * 2048 + h * 256 + qlo;
#pragma unroll
        for (int s = 0; s < 16; ++s) qf[s] = *reinterpret_cast<const bf16x8*>(Qr + 16 * s); }
      WGBAR();
      float lgc = lg2; asm volatile("" : "+v"(lgc));
      bf16* rb = Rout + (size_t)(T0 + 32 * qb) * 4096 + h * 512 + 128 * j;
#pragma unroll
      for (int r = 0; r < 16; ++r) { const int q = 32 * qb + crow(r, hi);
        const float qd = __builtin_amdgcn_exp2f(dir ? lgc * (float)(128 - q) : lgc * (float)(q + 1));
        bf16* orow = rb + (size_t)(((r & 3) + 8 * (r >> 2)) * 4096);
#pragma unroll
        for (int v = 0; v < 4; ++v) orow[32 * v + rlo] = f2bf(o[v][r] * qd); }
      if (ci < 31) VSCALE(buf ^ 1);
      WGBAR();
      buf ^= 1;
    }
#endif
  } else {
#ifndef RET_NO_S
    const int sw = wid - 4; int buf = 0;
    f32x16 st[2][4];
#pragma unroll
    for (int a = 0; a < 2; ++a)
#pragma unroll
      for (int v = 0; v < 4; ++v) st[a][v] = f32x16{};
    u32x4 kr0[8], kr1[8];
    const unsigned klo = (unsigned)(r32 * 16384 + 8 * hi); const bf16* Kl = KTg + (size_t)(64 * sw) * 16384;
    { const int n = dir ? 31 : 0; const bf16* K0 = Kl + b * 4096 + n * 128;
#pragma unroll
      for (int s = 0; s < 4; ++s) { kr0[s] = *reinterpret_cast<const u32x4*>(K0 + 16 * s + klo); kr1[s] = *reinterpret_cast<const u32x4*>(K0 + (size_t)32 * 16384 + 16 * s + klo); } }
    const int vrow = r32 * 256 + ((hi ^ (r32 & 1)) << 4), vx = (r32 & 14) << 4;
    for (int ci = 0; ci < 32; ++ci) {
      const int n = dir ? 31 - ci : ci;
      const int nn = dir ? n - 1 : n + 1; const int T1 = b * 4096 + nn * 128;
      CSTAMP(0);
      if (ci < 31) VDMA(T1, buf ^ 1);
      const char* VTl = lds + OFF_VT + buf * VT_BYTES + vrow;
      { const bf16* K0 = Kl + b * 4096 + n * 128;
#pragma unroll
        for (int s = 4; s < 8; ++s) { kr0[s] = *reinterpret_cast<const u32x4*>(K0 + 16 * s + klo); kr1[s] = *reinterpret_cast<const u32x4*>(K0 + (size_t)32 * 16384 + 16 * s + klo); } }
      CSTAMP(1);
#pragma unroll
      for (int s = 0; s < 8; ++s) {
        if (s == 4) CSTAMP(2);
        const bf16x8 f0 = __builtin_bit_cast(bf16x8, kr0[s]), f1 = __builtin_bit_cast(bf16x8, kr1[s]);
#pragma unroll
        for (int v = 0; v < 4; ++v) { const bf16x8 bv = *reinterpret_cast<const bf16x8*>(VTl + (32 * v) * 256 + ((32 * s) ^ vx));
          st[0][v] = __builtin_amdgcn_mfma_f32_32x32x16_bf16(f0, bv, st[0][v], 0, 0, 0);
          st[1][v] = __builtin_amdgcn_mfma_f32_32x32x16_bf16(f1, bv, st[1][v], 0, 0, 0); }
        SBAR();
      }
      CSTAMP(3);
      asm volatile("s_waitcnt vmcnt(0)" ::: "memory");
      CSTAMP(4);
      if (ci < 31) { const bf16* K0 = Kl + T1;
#pragma unroll
        for (int s = 0; s < 4; ++s) { kr0[s] = *reinterpret_cast<const u32x4*>(K0 + 16 * s + klo); kr1[s] = *reinterpret_cast<const u32x4*>(K0 + (size_t)32 * 16384 + 16 * s + klo); } }
#pragma unroll
      for (int a = 0; a < 2; ++a)
#pragma unroll
        for (int v = 0; v < 4; ++v) st[a][v] = st[a][v] * cdec;
      CSTAMP(5);
      WGBAR();
      CSTAMP(6);
#pragma unroll
      for (int a = 0; a < 2; ++a)
#pragma unroll
        for (int v = 0; v < 4; ++v)
#pragma unroll
          for (int g = 0; g < 4; ++g) { const int d = 64 * sw + 32 * a + 8 * g + 4 * hi;
            u32x2 w = {cvt_pk_bf16(st[a][v][4 * g + 0], st[a][v][4 * g + 1]), cvt_pk_bf16(st[a][v][4 * g + 2], st[a][v][4 * g + 3])};
            *reinterpret_cast<u32x2*>(STl + (32 * v + r32) * ST_PITCH + d * 2) = w; }
      if (ci < 31) VSCALE(buf ^ 1);
      CSTAMP(7);
      WGBAR();
      CSTAMP(9);
      buf ^= 1;
    }
#endif
  }
  WGBAR();
#undef WGBAR
#undef VDMA
#undef VSCALE
}
}

#ifndef PHMASK
#define PHMASK 0xFFFFFFFFu
#endif
#define PH(k) ((PHMASK >> (k)) & 1u)
#ifndef REPMASK
#define REPMASK 0u
#endif
#define PHASE_OPQ int tid_o = threadIdx.x; asm volatile("" : "+v"(tid_o)); const int ptid = tid_o, plane = tid_o & 63; (void)ptid; (void)plane; int gwp = gw, ngwp = NGW, pbx = blockIdx.x, pvcu = F.vcu, pG = F.G; asm volatile("" : "+s"(gwp), "+s"(ngwp), "+s"(pbx), "+s"(pvcu), "+s"(pG)); (void)gwp; (void)ngwp; (void)pbx; (void)pvcu; (void)pG;
#if REPMASK == 0u
#define PHASE_BEGIN(k) if (PH(k)) { PHASE_OPQ
#else
#define PHASE_BEGIN(k) if (PH(k)) for (int rep_ = 0; rep_ <= (int)((REPMASK >> (k)) & 1u); ++rep_) { if (rep_) xcd_barrier(bar); PHASE_OPQ
#endif
#if defined(STAMP_A) && defined(STAMP_B)
#ifndef STAMP_AMP
#define STAMP_AMP 8
#endif
#define STAMP() do { if (threadIdx.x == 0 && blockIdx.x == 0) { const unsigned n_ = F.MISC[400]; F.MISC[401 + n_] = (unsigned)__builtin_amdgcn_s_memrealtime(); F.MISC[400] = n_ + 1u; } } while (0)
#else
#define STAMP() do { } while (0)
#endif
#define GBAR() do { xcd_barrier(bar); STAMP(); } while (0)
constexpr int NTOK = 16384, SEQ = 4096, DM = 2048, NWAVES = 8;
constexpr float DN_ALPHA = 1.4142135623730951f;
constexpr float LN_EPS = 1e-5f, RMS_EPS = 1e-6f;
constexpr size_t MiB = 1u << 20;
constexpr size_t WS_CTL = 0, CTL_ZERO_BYTES = 1 * MiB;
constexpr int CW_BAR = 4096;
constexpr int CW_CNT = 8192;
constexpr size_t WS_ABIN = 1 * MiB;
constexpr size_t WS_UQ   = 17 * MiB;
constexpr size_t WS_UKV  = WS_UQ + 1536 * 512 * 2;
constexpr size_t WS_ABOUT = WS_UKV + 2048 * 256 * 2;
constexpr size_t WS_CIN  = WS_ABOUT + 8 * MiB;
constexpr size_t WS_COUT = WS_CIN + 48 * MiB;
constexpr size_t WS_PLEG = WS_COUT + 16 * MiB;
constexpr size_t WS_PLEP = WS_PLEG + 18 * MiB;
constexpr size_t WS_TAB  = WS_PLEP + 2 * MiB;
constexpr size_t WS_PB   = WS_TAB + 10 * MiB;
constexpr size_t WS_GU   = WS_PB + 16 * MiB;
constexpr size_t WS_DN   = WS_GU + 128 * MiB;
constexpr size_t WS_XB   = WS_DN + 64 * MiB;
constexpr size_t WS_AR   = WS_XB + 64 * MiB;
static_assert(WS_AR == 393 * MiB + 512 * 1024, "map");
constexpr size_t A_H = WS_AR, A_Q = A_H + 128 * MiB, A_KV = A_Q + 48 * MiB, A_AO = A_KV + 64 * MiB, A_KPE = A_AO + 64 * MiB, A_CQN = A_KPE + 2 * MiB, A_CKVN = A_CQN + 16 * MiB;
constexpr size_t C_HB = WS_AR, C_PROJ = WS_AR + 128 * MiB, C_YB = C_PROJ + 64 * MiB, C_PLE = C_YB + 160 * MiB, C_LOG = C_PLE + 64 * MiB, C_RT = C_LOG + 4 * MiB;
static_assert(C_RT + 2 * MiB <= WS_AR + 704 * MiB, "arena");
constexpr size_t B_Q = WS_AR, B_KVT = B_Q + 64 * MiB, B_G = B_KVT + 192 * MiB, B_PP = B_G + 128 * MiB, B_K = B_PP + 64 * MiB, B_RF = B_K, B_RB = B_RF + 128 * MiB, B_A = WS_AR, WS_END = B_RB + 128 * MiB;
constexpr int MAXSLOT = 40960;
constexpr size_t RT_E = 0, RT_W = RT_E + 16384 * 8, RT_R = RT_W + 16384 * 8, RT_S = RT_R + 16384 * 8, RT_ST = RT_S + 16384 * 8, RT_BC = RT_ST + 40960 * 4;
constexpr int RING_BYTES = 159744, MISC_OFF = RING_BYTES, LDS_BYTES = 163840;
static_assert(ret::RET_LDS <= RING_BYTES && att::ATT_LDS <= RING_BYTES && pg8::STAGE_BYTES <= RING_BYTES, "LDS map");

struct Frame {
    LAS unsigned char* lds; volatile LAS unsigned* MISC; unsigned* ctl;
    int tid, lane, wave, vcu, G;
};
__device__ __forceinline__ unsigned long long ld_ptr(const Frame& F, int k) {
    volatile LAS unsigned* p = F.MISC + 256 + 2 * k; const unsigned lo = __builtin_amdgcn_readfirstlane(p[0]), hi = __builtin_amdgcn_readfirstlane(p[1]);
    return ((unsigned long long)hi << 32) | lo;
}
#define INP(k) ((const float*)(GAS const float*)ld_ptr(F, (k)))
#define WSB() ((unsigned char*)(GAS unsigned char*)ld_ptr(F, 28))
#define OUTP() ((float*)(GAS float*)ld_ptr(F, 27))
struct Args { const float* in[27]; float* out; unsigned char* ws; };

constexpr int TR_WAVE_BYTES = 64 * 68 * 4;
__device__ __forceinline__ void transpose_item(const float* W, int ldw, bf16* WT, int ldt, int k0, int n0, int dst_row0, LAS float* scr, int lane) {
    const float* src = W + (size_t)(k0 + (lane >> 4)) * ldw + n0 + 4 * (lane & 15);
#pragma unroll
    for (int i = 0; i < 16; ++i) { const int kk = 4 * i + (lane >> 4); const f32x4 v = *(const f32x4*)(src + (size_t)(4 * i) * ldw);
        *(LAS f32x4*)(scr + kk * 68 + ((4 * (lane & 15)) ^ (((kk >> 3) & 7) << 2))) = v; }
    LDS_WAIT(); asm volatile("" ::: "memory");
    const int c = lane & 7;
#pragma unroll
    for (int j = 0; j < 8; ++j) { const int n = (lane >> 3) + 8 * j; const LAS float* p = scr + (8 * c) * 68 + (n ^ (c << 2));
        v4u o; o.x = cvt_pk_bf16(p[0 * 68], p[1 * 68]); o.y = cvt_pk_bf16(p[2 * 68], p[3 * 68]); o.z = cvt_pk_bf16(p[4 * 68], p[5 * 68]); o.w = cvt_pk_bf16(p[6 * 68], p[7 * 68]);
        *(v4u*)(WT + (size_t)(dst_row0 + n) * ldt + k0 + 8 * c) = o; }
    LDS_WAIT(); asm volatile("" ::: "memory");
}
__device__ __forceinline__ void transpose_plain(const float* W, int K, int N, bf16* WT, int item, LAS float* scr, int lane) {
    const int nblk = N / 64, kb = item / nblk, nb = item % nblk;
    transpose_item(W, N, WT, K, 64 * kb, 64 * nb, 64 * nb, scr, lane);
}
struct TrItem { const float* src; bf16* dst; int ldw, ldt; };
__device__ __forceinline__ void tr_load(const TrItem& t, f32x4 (&v)[16], int lane) {
    const float* p = t.src + (size_t)(lane >> 4) * t.ldw + 4 * (lane & 15);
#pragma unroll
    for (int i = 0; i < 16; ++i) v[i] = *(const f32x4*)(p + (size_t)(4 * i) * t.ldw);
}
__device__ __forceinline__ void tr_store(const TrItem& t, const f32x4 (&v)[16], LAS float* scr, int lane) {
#pragma unroll
    for (int i = 0; i < 16; ++i) { const int kk = 4 * i + (lane >> 4); *(LAS f32x4*)(scr + kk * 68 + ((4 * (lane & 15)) ^ (((kk >> 3) & 7) << 2))) = v[i]; }
    LDS_WAIT(); asm volatile("" ::: "memory");
    const int c = lane & 7;
#pragma unroll
    for (int j = 0; j < 8; ++j) { const int n = (lane >> 3) + 8 * j; const LAS float* p = scr + (8 * c) * 68 + (n ^ (c << 2));
        v4u o; o.x = cvt_pk_bf16(p[0 * 68], p[1 * 68]); o.y = cvt_pk_bf16(p[2 * 68], p[3 * 68]); o.z = cvt_pk_bf16(p[4 * 68], p[5 * 68]); o.w = cvt_pk_bf16(p[6 * 68], p[7 * 68]);
        *(v4u*)(t.dst + (size_t)n * t.ldt + 8 * c) = o; }
    LDS_WAIT(); asm volatile("" ::: "memory");
}
__device__ __forceinline__ TrItem moe_decode(int it, const float* wg, const float* wu, const float* wd, bf16* GU, bf16* DN) {
    const int which = it >> 13, r = it & 8191, e = r >> 8, q = r & 255; TrItem t;
    if (which < 2) { const int kb = q >> 3, n0 = 64 * (q & 7);
        t.src = (which ? wu : wg) + (size_t)e * 2048 * 512 + (size_t)(64 * kb) * 512 + n0; t.ldw = 512; t.ldt = 2048;
        t.dst = GU + (size_t)(e * 1024 + (n0 >> 7) * 256 + (which ? 128 : 0) + (n0 & 127)) * 2048 + 64 * kb; }
    else { const int kb = q >> 5, n0 = 64 * (q & 31);
        t.src = wd + (size_t)e * 512 * 2048 + (size_t)(64 * kb) * 2048 + n0; t.ldw = 2048; t.ldt = 512; t.dst = DN + (size_t)(e * 2048 + n0) * 512 + 64 * kb; }
    return t;
}
__device__ __forceinline__ void moe_convert_items(int first, int stride, int lane, const float* wg, const float* wu, const float* wd, bf16* GU, bf16* DN, LAS float* scr) {
    f32x4 cur[16], nxt[16]; int it = first;
    if (it >= 3 * 8192) return;
    TrItem tc = moe_decode(it, wg, wu, wd, GU, DN); tr_load(tc, cur, lane);
    for (;;) {
        const int in = it + stride; const bool more = in < 3 * 8192; TrItem tn = tc;
        if (more) { tn = moe_decode(in, wg, wu, wd, GU, DN); tr_load(tn, nxt, lane); }
        tr_store(tc, cur, scr, lane);
        if (!more) break;
#pragma unroll
        for (int i = 0; i < 16; ++i) cur[i] = nxt[i];
        tc = tn; it = in;
    }
}
__device__ __forceinline__ void cvt_rows(const Frame& F, int tid, const float* src, bf16* dst, size_t n8) {
    for (size_t i = (size_t)(F.vcu * 512 + tid); i < n8; i += (size_t)F.G * 512) {
        const f32x4 a = *(const f32x4*)(src + i * 8), b = *(const f32x4*)(src + i * 8 + 4);
        *(u32x4*)(dst + i * 8) = pg8::pack8(a, b); }
}
__device__ __forceinline__ void sincos_acc(int pos, float inv, float& c, float& s) {
    const double a = (double)pos * (double)inv; const double k = __builtin_rint(a * 0.15915494309189535); const float r = (float)(a - k * 6.283185307179586);
    s = sinf(r); c = cosf(r);
}

#define x_in INP(0)
#define p_in INP(1)
#define ab_w_in INP(2)
#define ab_rpb INP(3)
#define ab_q_norm INP(4)
#define ab_w_uq INP(5)
#define ab_kv_norm INP(6)
#define ab_w_ukv INP(7)
#define ab_w_out INP(8)
#define c_w_in INP(9)
#define c_lrf INP(10)
#define c_lrb INP(11)
#define c_w_out INP(12)
#define ln1_g INP(13)
#define ln1_b INP(14)
#define moe_w_group INP(15)
#define moe_b_group INP(16)
#define moe_w_router INP(17)
#define moe_b_router INP(18)
#define moe_w_gate INP(19)
#define moe_w_up INP(20)
#define moe_w_down INP(21)
#define ple_w_proj INP(22)
#define ple_w_gate INP(23)
#define ple_b_gate INP(24)
#define ln2_g INP(25)
#define ln2_b INP(26)
#define W_ABIN ((bf16*)(WSB() + WS_ABIN))
#define W_UQ ((bf16*)(WSB() + WS_UQ))
#define W_UKV ((bf16*)(WSB() + WS_UKV))
#define W_ABOUT ((bf16*)(WSB() + WS_ABOUT))
#define W_CIN ((bf16*)(WSB() + WS_CIN))
#define W_COUT ((bf16*)(WSB() + WS_COUT))
#define W_PLEG ((bf16*)(WSB() + WS_PLEG))
#define W_PLEP ((bf16*)(WSB() + WS_PLEP))
#define T_COSM ((float*)(WSB() + WS_TAB))
#define T_SINM (T_COSM + 4096 * 32)
#define T_COSR (T_COSM + 2 * 4096 * 32)
#define T_SINR (T_COSR + 4096 * 128)
#define T_COSRT (T_COSR + 2 * 4096 * 128)
#define T_SINRT (T_COSR + 3 * 4096 * 128)
#define T_LG (T_COSR + 4 * 4096 * 128)
#define PB ((bf16*)(WSB() + WS_PB))
#define W_GU ((bf16*)(WSB() + WS_GU))
#define W_DN ((bf16*)(WSB() + WS_DN))
#define XB ((bf16*)(WSB() + WS_XB))
#define PRE OUTP()
#define H ((bf16*)(WSB() + A_H))
#define Qb ((bf16*)(WSB() + A_Q))
#define KVb ((bf16*)(WSB() + A_KV))
#define AO ((bf16*)(WSB() + A_AO))
#define KPE ((bf16*)(WSB() + A_KPE))
#define CQN ((bf16*)(WSB() + A_CQN))
#define CKVN ((bf16*)(WSB() + A_CKVN))
#define Qm ((bf16*)(WSB() + B_Q))
#define KVT ((bf16*)(WSB() + B_KVT))
#define Gm ((bf16*)(WSB() + B_G))
#define PP ((bf16*)(WSB() + B_PP))
#define Km ((bf16*)(WSB() + B_K))
#define Rf ((bf16*)(WSB() + B_RF))
#define Rb ((bf16*)(WSB() + B_RB))
#define Am ((bf16*)(WSB() + B_A))
#define PROJ ((bf16*)(WSB() + C_PROJ))
#define HB ((bf16*)(WSB() + C_HB))
#define YB ((bf16*)(WSB() + C_YB))
#define PLE ((bf16*)(WSB() + C_PLE))
#define LOG ((float*)(WSB() + C_LOG))
#define TOK_E ((int*)(WSB() + C_RT + RT_E))
#define TOK_W ((float*)(WSB() + C_RT + RT_W))
#define TOK_R ((int*)(WSB() + C_RT + RT_R))
#define TOK_S ((int*)(WSB() + C_RT + RT_S))
#define SLOT_TOK ((int*)(WSB() + C_RT + RT_ST))
#define BLKCNT ((int*)(WSB() + C_RT + RT_BC))
#define MOE_CONVERT(LAYER) do { int tq_ = threadIdx.x; asm volatile("" : "+v"(tq_)); const int lane_ = tq_ & 63; int g0_ = gw, gs_ = NGW; asm volatile("" : "+s"(g0_), "+s"(gs_)); \
        LAS float* scr_ = (LAS float*)(F.lds + F.wave * TR_WAVE_BYTES); const size_t lo_ = (size_t)(LAYER) * 32 * 2048 * 512; \
        moe_convert_items(g0_, gs_, lane_, moe_w_gate + lo_, moe_w_up + lo_, moe_w_down + lo_, W_GU, W_DN, scr_); \
        __syncthreads(); } while (0)
__global__ void __launch_bounds__(512, 2) fwd_kernel(Args args) {
    extern __shared__ __attribute__((aligned(16))) unsigned char lds[];
    Frame F;
    F.lds = (LAS unsigned char*)lds; F.MISC = (volatile LAS unsigned*)(F.lds + MISC_OFF);
    F.tid = threadIdx.x; F.lane = F.tid & 63; F.wave = __builtin_amdgcn_readfirstlane(F.tid >> 6);
    F.G = gridDim.x; { const int bx = blockIdx.x; F.vcu = (F.G % 8 == 0) ? (bx % 8) * (F.G / 8) + bx / 8 : bx; }
    F.ctl = (unsigned*)(args.ws + WS_CTL);
    for (int u = F.tid; u < (LDS_BYTES - MISC_OFF) / 4; u += 512) ((LAS unsigned*)(F.lds + MISC_OFF))[u] = 0u;
    __syncthreads();
    if (F.tid == 0) {
#pragma unroll
        for (int i = 0; i < 27; ++i) { const unsigned long long v = (unsigned long long)args.in[i]; F.MISC[256 + 2 * i] = (unsigned)v; F.MISC[257 + 2 * i] = (unsigned)(v >> 32); }
        { const unsigned long long v = (unsigned long long)args.out; F.MISC[256 + 54] = (unsigned)v; F.MISC[257 + 54] = (unsigned)(v >> 32); }
        { const unsigned long long v = (unsigned long long)args.ws; F.MISC[256 + 56] = (unsigned)v; F.MISC[257 + 56] = (unsigned)(v >> 32); }
    }
    __syncthreads();
    XcdBarrier bar = xcd_barrier_post(F.ctl + CW_BAR, F.MISC + 8);
    STAMP();
    const int gw = F.vcu * NWAVES + F.wave, NGW = F.G * NWAVES;
    char* ldsg = (char*)lds;


        PHASE_BEGIN(0)
    {
        LAS float* scr = (LAS float*)(F.lds + F.wave * TR_WAVE_BYTES);
        constexpr int I_ABIN = 32 * 61, I_UQ = 8 * 24, I_UKV = 4 * 32, I_ABOUT = 32 * 32, I_CIN = 32 * 192, I_COUT = 64 * 32, I_PLEG = 32 * 32, I_PLEP = 4 * 32;
        constexpr int NIT = I_ABIN + I_UQ + I_UKV + I_ABOUT + I_CIN + I_COUT + 2 * I_PLEG + 2 * I_PLEP;
        moe_convert_items(gwp, ngwp, plane, moe_w_gate, moe_w_up, moe_w_down, W_GU, W_DN, scr);
        for (int it = gwp; it < NIT; it += ngwp) {
            int r = it;
            if (r < I_ABIN) { transpose_plain(ab_w_in, 2048, 3904, W_ABIN, r, scr, plane); continue; } r -= I_ABIN;
            if (r < I_UQ) { transpose_plain(ab_w_uq, 512, 1536, W_UQ, r, scr, plane); continue; } r -= I_UQ;
            if (r < I_UKV) { transpose_plain(ab_w_ukv, 256, 2048, W_UKV, r, scr, plane); continue; } r -= I_UKV;
            if (r < I_ABOUT) { transpose_plain(ab_w_out, 2048, 2048, W_ABOUT, r, scr, plane); continue; } r -= I_ABOUT;
            if (r < I_CIN) { transpose_plain(c_w_in, 2048, 12288, W_CIN, r, scr, plane); continue; } r -= I_CIN;
            if (r < I_COUT) { transpose_plain(c_w_out, 4096, 2048, W_COUT, r, scr, plane); continue; } r -= I_COUT;
            if (r < 2 * I_PLEG) { const int L = r / I_PLEG; transpose_plain(ple_w_gate + (size_t)L * 2048 * 2048, 2048, 2048, W_PLEG + (size_t)L * 2304 * 2048, r % I_PLEG, scr, plane); continue; } r -= 2 * I_PLEG;
            { const int L = r / I_PLEP; transpose_plain(ple_w_proj + (size_t)L * 256 * 2048, 256, 2048, W_PLEP + (size_t)L * 2048 * 256, r % I_PLEP, scr, plane); }
        }
        const size_t gt = (size_t)pvcu * 512 + ptid, GT = (size_t)pG * 512;
        for (size_t i = gt; i < (size_t)192 * 2048 / 8; i += GT) *(u32x4*)(W_ABIN + (size_t)3904 * 2048 + i * 8) = (u32x4){0u, 0u, 0u, 0u};
        for (size_t i = gt; i < (size_t)2 * 220 * 2048 / 8; i += GT) { const size_t L = i / (220 * 2048 / 8), r = i % (220 * 2048 / 8); *(u32x4*)(W_PLEG + (L * 2304 + 2084) * 2048 + r * 8) = (u32x4){0u, 0u, 0u, 0u}; }
        for (size_t i = gt; i < (size_t)2 * 36 * 2048; i += GT) { const int L = (int)(i / (36 * 2048)), r = (int)(i % (36 * 2048)), row = r / 2048, k = r % 2048;
            const float v = row < 4 ? moe_w_group[((size_t)L * 2048 + k) * 4 + row] : moe_w_router[(((size_t)L * 4 + ((row - 4) >> 3)) * 2048 + k) * 8 + ((row - 4) & 7)];
            W_PLEG[((size_t)L * 2304 + 2048 + row) * 2048 + k] = f2bf(v); }
        cvt_rows(F, ptid, x_in, XB, (size_t)NTOK * DM / 8);
        cvt_rows(F, ptid, p_in, PB, (size_t)2 * NTOK * 256 / 8);
        for (size_t i = gt; i < (size_t)4096 * 32; i += GT) { const int s = (int)(i >> 5), f = (int)(i & 31); float c, sn; sincos_acc(s, expf((float)(2 * f) * (-9.210340371976184f / 64.f)), c, sn); T_COSM[i] = c; T_SINM[i] = sn; }
        for (size_t i = gt; i < (size_t)4096 * 128; i += GT) { const int s = (int)(i >> 7), f = (int)(i & 127); float c, sn; sincos_acc(s, expf((float)(2 * f) * (-9.210340371976184f / 256.f)), c, sn);
            T_COSR[i] = c; T_SINR[i] = sn; T_COSRT[(size_t)f * 4096 + s] = c; T_SINRT[(size_t)f * 4096 + s] = sn; }
        if (gt < 16) { const float lr = gt < 8 ? c_lrf[gt] : c_lrb[gt - 8]; T_LG[gt] = log1pf(-expf(lr)) * 1.4426950408889634f; }
    }
        }
    GBAR();

#pragma unroll 1
    for (int L = 0; L < 2; ++L) {
        if (L == 0) {
        PHASE_BEGIN(1)
            { pg8::DenseOrder S{(const char*)XB, (const char*)W_ABIN, 2048, 64, 16, pG, pbx, 1 << 30, 0}; pg8::EpiPlain E{H, 4096};
              pg8::gemm_phase<pg8::EpiPlain, pg8::DenseOrder, true, false>(F.lds, 2048, S, E); }
        }
            GBAR();
        PHASE_BEGIN(2)
            for (int m = gwp; m < NTOK; m += ngwp) {
                const bf16* hr = H + (size_t)m * 4096;
                { const u32x4 w = *(const u32x4*)(hr + 3072 + 8 * plane); float v[8] = {bf_lo(w.x), bf_hi(w.x), bf_lo(w.y), bf_hi(w.y), bf_lo(w.z), bf_hi(w.z), bf_lo(w.w), bf_hi(w.w)};
                  float ss = 0.f;
#pragma unroll
                  for (int j = 0; j < 8; ++j) ss += v[j] * v[j];
                  const float rs = 1.0f / sqrtf(wave_sum(ss, plane) * (1.f / 512.f) + RMS_EPS);
                  const f32x4 g0 = *(const f32x4*)(ab_q_norm + 8 * plane), g1 = *(const f32x4*)(ab_q_norm + 8 * plane + 4);
                  const f32x4 o0 = {v[0] * rs * g0[0], v[1] * rs * g0[1], v[2] * rs * g0[2], v[3] * rs * g0[3]}, o1 = {v[4] * rs * g1[0], v[5] * rs * g1[1], v[6] * rs * g1[2], v[7] * rs * g1[3]};
                  *(u32x4*)(CQN + (size_t)m * 512 + 8 * plane) = pg8::pack8(o0, o1); }
                { const u32x2 w = *(const u32x2*)(hr + 3584 + 4 * plane); float v[4] = {bf_lo(w.x), bf_hi(w.x), bf_lo(w.y), bf_hi(w.y)};
                  const float ss = v[0] * v[0] + v[1] * v[1] + v[2] * v[2] + v[3] * v[3];
                  const float rs = 1.0f / sqrtf(wave_sum(ss, plane) * (1.f / 256.f) + RMS_EPS);
                  const f32x4 g0 = *(const f32x4*)(ab_kv_norm + 4 * plane);
                  u32x2 o; o.x = cvt_pk_bf16(v[0] * rs * g0[0], v[1] * rs * g0[1]); o.y = cvt_pk_bf16(v[2] * rs * g0[2], v[3] * rs * g0[3]);
                  *(u32x2*)(CKVN + (size_t)m * 256 + 4 * plane) = o; }
                { const int i = plane & 31, s = m & 4095; const float x1 = bf2f(hr[3840 + i]), x2 = bf2f(hr[3872 + i]); const float c = T_COSM[s * 32 + i], sn = T_SINM[s * 32 + i];
                  KPE[(size_t)m * 64 + plane] = f2bf(plane < 32 ? x1 * c - x2 * sn : x2 * c + x1 * sn); }
            }
        }
            GBAR();
        PHASE_BEGIN(3)
            { pg8::DenseOrder S{(const char*)CQN, (const char*)W_UQ, 512, 64, 6, pG, pbx, 1 << 30, 0}; pg8::EpiPlain E{Qb, 1536};
              pg8::gemm_phase<pg8::EpiPlain, pg8::DenseOrder, true, false>(F.lds, 512, S, E); }
            { pg8::DenseOrder S{(const char*)CKVN, (const char*)W_UKV, 256, 64, 8, pG, pbx, 1 << 30, 0}; pg8::EpiPlain E{KVb, 2048};
              pg8::gemm_phase<pg8::EpiPlain, pg8::DenseOrder, true, false>(F.lds, 256, S, E); }
        }
            GBAR();
        PHASE_BEGIN(4)
            for (int rep2_ = 0; rep2_ <= (int)((REPMASK >> 20) & 1u); ++rep2_) for (int it = pvcu; it < 512; it += pG) {
                const int bh = it >> 4, qb = it & 15, b = bh >> 3, h = bh & 7; const size_t t0 = (size_t)b * 4096 + qb * 256;
                att::AttnArgs A; A.Qp = Qb + t0 * 1536 + h * 192; A.Kp = KVb + (size_t)b * 4096 * 2048 + h * 256; A.Vp = A.Kp + 128;
                A.Pp = KPE + (size_t)b * 4096 * 64; A.Op = AO + t0 * 2048 + 1024 + h * 128; A.cosM = T_COSM; A.sinM = T_SINM; A.s0 = qb * 256; A.NT = 64; A.kr0 = 0; A.rg = 0;
                att::attn_item<0>(A, ldsg);
            }
            for (int rep2_ = 0; rep2_ <= (int)((REPMASK >> 21) & 1u); ++rep2_) for (int it = pvcu; it < 512; it += pG) {
                const int bh = it >> 4, rg = it & 15, b = bh >> 3, h = bh & 7; const size_t t0 = (size_t)b * 4096 + rg * 256;
                int klo = min(max(4 * rg - 4, 0), 56), khi = min(max(4 * rg - 1, 0), 56) + 7;
                if ((khi - klo + 1) & 1) { if (khi < 63) ++khi; else --klo; }
                for (int i = ptid; i < 465; i += 512) ((float*)(ldsg + att::OFF_BIAS))[i] = ab_rpb[h * 465 + i] * 11.313708498984761f;
                att::AttnArgs A; A.Qp = H + t0 * 4096 + h * 128; A.Kp = H + ((size_t)b * 4096 + klo * 64) * 4096 + 1024 + h * 128; A.Vp = A.Kp + 1024;
                A.Pp = nullptr; A.Op = AO + t0 * 2048 + h * 128; A.cosM = nullptr; A.sinM = nullptr; A.s0 = 0; A.NT = khi - klo + 1; A.kr0 = klo; A.rg = rg;
                att::attn_item<1>(A, ldsg);
            }
        }
            GBAR();
        } else {
        PHASE_BEGIN(6)
            { pg8::DenseOrder S{(const char*)XB, (const char*)W_CIN, 2048, 64, 24, pG, pbx, 8, 24}; pg8::EpiCinN E{Qm, Gm, T_COSR, T_SINR};
              pg8::gemm_phase<pg8::EpiCinN, pg8::DenseOrder, true, false>(F.lds, 2048, S, E); }
            { pg8::DenseOrder S{(const char*)(W_CIN + (size_t)2048 * 2048), (const char*)XB, 2048, 24, 64, pG, pbx, 1 << 30, 0}; pg8::EpiCinT E{KVT, T_COSRT, T_SINRT};
              pg8::gemm_phase<pg8::EpiCinT, pg8::DenseOrder, true, false>(F.lds, 2048, S, E); }
        }
            GBAR();
        PHASE_BEGIN(7)
            for (int it = pvcu; it < 1024; it += pG) ret::pprime_item(it, Qm, KVT, PP, T_LG, T_LG + 8, ldsg);
            __syncthreads();
#ifdef STAMP_MID_B2
            STAMP();
#endif
        }
            GBAR();
        PHASE_BEGIN(8)
            if (pvcu & 1) MOE_CONVERT(1);
            for (int it = pvcu; it < 256; it += pG) ret::chain_item(it, Qm, KVT, PP, Rf, Rb, T_LG, T_LG + 8, ldsg);
            if (!(pvcu & 1)) MOE_CONVERT(1);
        }
            GBAR();
        PHASE_BEGIN(9)
            for (int u = gwp; u < NTOK * 8; u += 4 * ngwp) {
                u32x4 a[4], bq[4], gq[4]; size_t off[4];
#pragma unroll
                for (int r = 0; r < 4; ++r) { const int uu = u + r * ngwp; off[r] = (size_t)(uu >> 3) * 4096 + (uu & 7) * 512 + 8 * plane;
                    a[r] = *(const u32x4*)(Rf + off[r]); bq[r] = *(const u32x4*)(Rb + off[r]); gq[r] = *(const u32x4*)(Gm + off[r]); }
#pragma unroll
                for (int r = 0; r < 4; ++r) {
                    float rr[8] = {bf_lo(a[r].x) + bf_lo(bq[r].x), bf_hi(a[r].x) + bf_hi(bq[r].x), bf_lo(a[r].y) + bf_lo(bq[r].y), bf_hi(a[r].y) + bf_hi(bq[r].y), bf_lo(a[r].z) + bf_lo(bq[r].z), bf_hi(a[r].z) + bf_hi(bq[r].z), bf_lo(a[r].w) + bf_lo(bq[r].w), bf_hi(a[r].w) + bf_hi(bq[r].w)};
                    const float g[8] = {bf_lo(gq[r].x), bf_hi(gq[r].x), bf_lo(gq[r].y), bf_hi(gq[r].y), bf_lo(gq[r].z), bf_hi(gq[r].z), bf_lo(gq[r].w), bf_hi(gq[r].w)};
                    float s = 0.f;
#pragma unroll
                    for (int j = 0; j < 8; ++j) s += rr[j];
                    const float mean = wave_sum(s, plane) * (1.f / 512.f); float s2 = 0.f;
#pragma unroll
                    for (int j = 0; j < 8; ++j) { rr[j] -= mean; s2 += rr[j] * rr[j]; }
                    const float rstd = 1.0f / sqrtf(wave_sum(s2, plane) * (1.f / 512.f) + LN_EPS);
                    f32x4 o0, o1;
#pragma unroll
                    for (int j = 0; j < 4; ++j) { o0[j] = g[j] * sigmoidf_(g[j]) * rr[j] * rstd; o1[j] = g[4 + j] * sigmoidf_(g[4 + j]) * rr[4 + j] * rstd; }
                    *(u32x4*)(Am + off[r]) = pg8::pack8(o0, o1);
                }
            }
        }
            GBAR();
        }
        PHASE_BEGIN(5)
        { pg8::DenseOrder S{(const char*)(L ? Am : AO), (const char*)(L ? W_COUT : W_ABOUT), L ? 4096 : 2048, 64, 8, pG, pbx, 1 << 30, 0}; pg8::EpiPre E{PRE, XB, DN_ALPHA};
          pg8::gemm_phase<pg8::EpiPre, pg8::DenseOrder, true, false>(F.lds, L ? 4096 : 2048, S, E); }
        { pg8::DenseOrder S{(const char*)(PB + (size_t)L * NTOK * 256), (const char*)(W_PLEP + (size_t)L * 2048 * 256), 256, 64, 8, pG, pbx, 1 << 30, 0}; pg8::EpiPlain E{PROJ, 2048};
          pg8::gemm_phase<pg8::EpiPlain, pg8::DenseOrder, true, false>(F.lds, 256, S, E); }
        }
        GBAR();
        PHASE_BEGIN(11)
        { int tid_q = threadIdx.x; asm volatile("" : "+v"(tid_q)); const int plane = tid_q & 63; int gwp = gw, ngwp = NGW; asm volatile("" : "+s"(gwp), "+s"(ngwp));
        for (int m = gwp; m < NTOK; m += 2 * ngwp) {
            f32x4 v[2][8]; float s[2] = {0.f, 0.f};
#pragma unroll
            for (int r = 0; r < 2; ++r) { const f32x4* xr = (const f32x4*)(PRE + (size_t)(m + r * ngwp) * DM) + plane;
#pragma unroll
                for (int j = 0; j < 8; ++j) v[r][j] = xr[64 * j]; }
#pragma unroll
            for (int r = 0; r < 2; ++r)
#pragma unroll
                for (int j = 0; j < 8; ++j) s[r] += (v[r][j][0] + v[r][j][1]) + (v[r][j][2] + v[r][j][3]);
            const float mean[2] = {wave_sum(s[0], plane) * (1.f / DM), wave_sum(s[1], plane) * (1.f / DM)}; float s2[2] = {0.f, 0.f};
#pragma unroll
            for (int r = 0; r < 2; ++r)
#pragma unroll
                for (int j = 0; j < 8; ++j) { v[r][j] = v[r][j] - mean[r]; s2[r] += (v[r][j][0] * v[r][j][0] + v[r][j][1] * v[r][j][1]) + (v[r][j][2] * v[r][j][2] + v[r][j][3] * v[r][j][3]); }
            const float rstd[2] = {1.0f / sqrtf(wave_sum(s2[0], plane) * (1.f / DM) + LN_EPS), 1.0f / sqrtf(wave_sum(s2[1], plane) * (1.f / DM) + LN_EPS)};
            const f32x4* gr = (const f32x4*)(ln1_g + L * DM) + plane; const f32x4* br = (const f32x4*)(ln1_b + L * DM) + plane;
#pragma unroll
            for (int j = 0; j < 8; ++j) { const f32x4 g = gr[64 * j], bb = br[64 * j];
#pragma unroll
                for (int r = 0; r < 2; ++r) { const f32x4 y = v[r][j] * rstd[r] * g + bb; u32x2 w; w.x = cvt_pk_bf16(y[0], y[1]); w.y = cvt_pk_bf16(y[2], y[3]); ((u32x2*)(XB + (size_t)(m + r * ngwp) * DM) + plane)[64 * j] = w; } }
        } }
        }
        GBAR();
        PHASE_BEGIN(12)
        { pg8::DenseOrder S{(const char*)XB, (const char*)(W_PLEG + (size_t)L * 2304 * 2048), 2048, 64, 9, pG, pbx, 1 << 30, 0}; pg8::EpiPle E{PLE, PROJ, ple_b_gate + L * DM, LOG};
          pg8::gemm_phase<pg8::EpiPle, pg8::DenseOrder, true, false>(F.lds, 2048, S, E); }
        }
        GBAR();
        PHASE_BEGIN(13)
        if (ptid < 64) {
            const int n = pvcu * 64 + ptid;
            const float* lg = LOG + (size_t)n * 64;
            float gl[4]; int gi = 0;
#pragma unroll
            for (int g = 0; g < 4; ++g) gl[g] = lg[g] + moe_b_group[L * 4 + g];
            float gm = gl[0];
#pragma unroll
            for (int g = 1; g < 4; ++g) if (gl[g] > gm) { gm = gl[g]; gi = g; }
            float gs = 0.f;
#pragma unroll
            for (int g = 0; g < 4; ++g) gs += fast_exp(gl[g] - gm);
            const float pg = 1.0f / gs;
            float el[8];
#pragma unroll
            for (int e = 0; e < 8; ++e) el[e] = lg[4 + gi * 8 + e] + moe_b_router[(L * 4 + gi) * 8 + e];
            int i0 = 0; float m0 = el[0];
#pragma unroll
            for (int e = 1; e < 8; ++e) if (el[e] > m0) { m0 = el[e]; i0 = e; }
            int i1 = -1; float m1 = -3.0e38f;
#pragma unroll
            for (int e = 0; e < 8; ++e) if (e != i0 && el[e] > m1) { m1 = el[e]; i1 = e; }
            float one = 1.0f; asm volatile("" : "+v"(one));
            const float t1 = fast_exp(m1 - m0), den = one / (one + t1);
            const int e0 = gi * 8 + i0, e1 = gi * 8 + i1;
            int r0 = 0, r1 = 0, mycnt = 0; const unsigned long long ltm = (1ull << ptid) - 1ull;
#pragma unroll 1
            for (int e = 0; e < 32; ++e) {
                const unsigned long long b0 = __ballot(e0 == e), b1 = __ballot(e1 == e);
                const int below = __popcll(b0 & ltm) + __popcll(b1 & ltm);
                if (e0 == e) r0 = below; if (e1 == e) r1 = below;
                if (ptid == e) mycnt = __popcll(b0) + __popcll(b1);
            }
            TOK_E[2 * n] = e0; TOK_E[2 * n + 1] = e1; TOK_W[2 * n] = pg * den; TOK_W[2 * n + 1] = pg * t1 * den; TOK_R[2 * n] = r0; TOK_R[2 * n + 1] = r1;
            if (ptid < 32) BLKCNT[pvcu * 32 + ptid] = mycnt;
        }
        }
        GBAR();
        volatile LAS int* EOFF = (volatile LAS int*)(F.MISC + 16);
        PHASE_BEGIN(14)
        { volatile LAS int* red = (volatile LAS int*)F.lds;
          const int e = ptid & 31, grp = ptid >> 5; int tot = 0, bel = 0;
          for (int b2 = grp; b2 < pG; b2 += 16) { const int c = BLKCNT[b2 * 32 + e]; tot += c; bel += (b2 < pvcu) ? c : 0; }
          red[ptid] = tot; red[512 + ptid] = bel;
          __syncthreads();
          if (ptid < 32) { int t = 0, q = 0; for (int g = 0; g < 16; ++g) { t += red[g * 32 + ptid]; q += red[512 + g * 32 + ptid]; } red[1024 + ptid] = t; red[1056 + ptid] = q; }
          __syncthreads();
          if (ptid == 0) { int acc = 0; for (int q = 0; q < 32; ++q) { EOFF[q] = acc; acc += (red[1024 + q] + 255) & ~255; } EOFF[32] = acc; }
          __syncthreads();
          if (ptid < 64) { const int n = pvcu * 64 + ptid;
#pragma unroll
            for (int k = 0; k < 2; ++k) { const int ee = TOK_E[2 * n + k]; const int slot = EOFF[ee] + red[1056 + ee] + TOK_R[2 * n + k]; SLOT_TOK[slot] = n; TOK_S[2 * n + k] = slot; } }
          for (int ee = pvcu; ee < 32; ee += pG) { const int c = red[1024 + ee]; const int pe = (c + 255) & ~255;
            for (int i = c + ptid; i < pe; i += 512) SLOT_TOK[EOFF[ee] + i] = 0; }
          __syncthreads();
        }
        }
        GBAR();
        const int ntiles = EOFF[32] >> 8;
        PHASE_BEGIN(15)
        {
            struct MoeGU { const char* A; const char* Bt; const int* slot_tok; volatile LAS int* eoff; int nun, G, c;
                __device__ __forceinline__ bool next(int i, pg8::Unit& u) const { const long Lq = (long)i * G + c; if (Lq >= nun) return false; const int t = (int)(Lq >> 2), pn = (int)(Lq & 3);
                    int e = 0;
#pragma unroll 1
                    for (int q = 1; q < 32; ++q) if (eoff[q] <= t * 256) e = q;
                    u.pm = t; u.pn = pn; u.a = A; u.b = Bt + ((size_t)e * 1024 + pn * 256) * 2048 * 2; return true; }
                __device__ __forceinline__ void rows(const pg8::Unit& u, int R, int C, unsigned (&o0)[2], unsigned (&o1)[2]) const {
                    int Ro = R; asm volatile("" : "+v"(Ro));
                    const int* st = slot_tok + u.pm * 256 + Ro;
                    o0[0] = (unsigned)st[0] * 4096u + (unsigned)C * 2u; o0[1] = (unsigned)st[64] * 4096u + (unsigned)C * 2u; o1[0] = (unsigned)st[128] * 4096u + (unsigned)C * 2u; o1[1] = (unsigned)st[192] * 4096u + (unsigned)C * 2u; }
            } S{(const char*)XB, (const char*)W_GU, SLOT_TOK, EOFF, ntiles * 4, pG, pvcu};
            pg8::EpiGU E{HB};
            pg8::gemm_phase<pg8::EpiGU, MoeGU, true, true>(F.lds, 2048, S, E);
        }
        }
        GBAR();
        PHASE_BEGIN(16)
        {
            struct MoeDN { const char* A; const char* Bt; volatile LAS int* eoff; int nun, G, c;
                __device__ __forceinline__ bool next(int i, pg8::Unit& u) const { const long Lq = (long)i * G + c; if (Lq >= nun) return false; const int t = (int)(Lq >> 3), pn = (int)(Lq & 7);
                    int e = 0;
#pragma unroll 1
                    for (int q = 1; q < 32; ++q) if (eoff[q] <= t * 256) e = q;
                    u.pm = t; u.pn = pn; u.a = A + (size_t)t * 256 * 512 * 2; u.b = Bt + ((size_t)e * 2048 + pn * 256) * 512 * 2; return true; }
                __device__ __forceinline__ void rows(const pg8::Unit&, int, int, unsigned (&)[2], unsigned (&)[2]) const {}
            } S{(const char*)HB, (const char*)W_DN, EOFF, ntiles * 8, pG, pvcu};
            pg8::EpiPlain E{YB, 2048};
            pg8::gemm_phase<pg8::EpiPlain, MoeDN, true, false>(F.lds, 512, S, E);
        }
        }
        GBAR();
        PHASE_BEGIN(17)
        for (int m = gwp; m < NTOK; m += ngwp) {
            const int s0 = TOK_S[2 * m], s1 = TOK_S[2 * m + 1]; const float w0 = TOK_W[2 * m], w1 = TOK_W[2 * m + 1];
            const u32x4* xr = (const u32x4*)(XB + (size_t)m * DM) + plane; const u32x4* y0 = (const u32x4*)(YB + (size_t)s0 * DM) + plane; const u32x4* y1 = (const u32x4*)(YB + (size_t)s1 * DM) + plane;
            const u32x4* pr = (const u32x4*)(PLE + (size_t)m * DM) + plane;
            float v[4][8]; float s = 0.f;
#pragma unroll
            for (int j = 0; j < 4; ++j) { const u32x4 a = xr[64 * j], b0 = y0[64 * j], b1 = y1[64 * j], c = pr[64 * j];
                const unsigned aw[4] = {a.x, a.y, a.z, a.w}, b0w[4] = {b0.x, b0.y, b0.z, b0.w}, b1w[4] = {b1.x, b1.y, b1.z, b1.w}, cw[4] = {c.x, c.y, c.z, c.w};
#pragma unroll
                for (int q = 0; q < 4; ++q) { v[j][2 * q] = DN_ALPHA * bf_lo(aw[q]) + w0 * bf_lo(b0w[q]) + w1 * bf_lo(b1w[q]) + bf_lo(cw[q]); v[j][2 * q + 1] = DN_ALPHA * bf_hi(aw[q]) + w0 * bf_hi(b0w[q]) + w1 * bf_hi(b1w[q]) + bf_hi(cw[q]);
                    s += v[j][2 * q] + v[j][2 * q + 1]; } }
            const float mean = wave_sum(s, plane) * (1.f / DM); float s2 = 0.f;
#pragma unroll
            for (int j = 0; j < 4; ++j)
#pragma unroll
                for (int q = 0; q < 8; ++q) { v[j][q] -= mean; s2 += v[j][q] * v[j][q]; }
            const float rstd = 1.0f / sqrtf(wave_sum(s2, plane) * (1.f / DM) + LN_EPS);
            u32x4* ox = (u32x4*)(XB + (size_t)m * DM) + plane;
#pragma unroll
            for (int j = 0; j < 4; ++j) { const int c0 = 512 * j + 8 * plane;
                const f32x4 g0 = *(const f32x4*)(ln2_g + L * DM + c0), g1 = *(const f32x4*)(ln2_g + L * DM + c0 + 4), b0 = *(const f32x4*)(ln2_b + L * DM + c0), b1 = *(const f32x4*)(ln2_b + L * DM + c0 + 4);
                f32x4 y0v, y1v;
#pragma unroll
                for (int q = 0; q < 4; ++q) { y0v[q] = v[j][q] * rstd * g0[q] + b0[q]; y1v[q] = v[j][4 + q] * rstd * g1[q] + b1[q]; }
                if (L == 1) { *(f32x4*)(OUTP() + (size_t)m * DM + c0) = y0v; *(f32x4*)(OUTP() + (size_t)m * DM + c0 + 4) = y1v; }
                else ox[64 * j] = pg8::pack8(y0v, y1v); }
        }
        }
        if (L == 0) GBAR();
    }
#if defined(STAMP_A) && defined(STAMP_B)
    STAMP();
#if defined(CH_WAVE)
    if (threadIdx.x == 0 && blockIdx.x == 0) { const unsigned dt = F.MISC[450 + CH_SEG]; const unsigned long long t0 = __builtin_amdgcn_s_memrealtime();
#else
    if (threadIdx.x == 0 && blockIdx.x == 0) { const unsigned dt = F.MISC[401 + STAMP_B] - F.MISC[401 + STAMP_A]; const unsigned long long t0 = __builtin_amdgcn_s_memrealtime();
#endif
        while (__builtin_amdgcn_s_memrealtime() - t0 < (unsigned long long)dt * STAMP_AMP) __builtin_amdgcn_s_sleep(32); }
#endif
}

extern "C" void kernel_launch(void* const* d_in, const int* in_sizes, int n_in, void* d_out, int out_size, void* d_ws, size_t ws_size, hipStream_t stream) {
    static int grid = 0;
    if (grid == 0) {
        if (n_in != 27 || out_size != NTOK * DM || ws_size < WS_END) { fprintf(stderr, "kernel_launch: unexpected shapes (n_in %d out %d ws %zu need %zu)\n", n_in, out_size, ws_size, (size_t)WS_END); grid = -1; return; }
        int dev = 0, cus = 0;
        if (hipGetDevice(&dev) != hipSuccess || hipDeviceGetAttribute(&cus, hipDeviceAttributeMultiprocessorCount, dev) != hipSuccess) { grid = -1; return; }
        if (hipFuncSetAttribute((const void*)fwd_kernel, hipFuncAttributeMaxDynamicSharedMemorySize, LDS_BYTES) != hipSuccess) { grid = -1; return; }
        if (cus < 256) { fprintf(stderr, "kernel_launch: needs 256 CUs\n"); grid = -1; return; }
        grid = 256;
    }
    if (grid < 0) return;
    (void)hipMemsetAsync((char*)d_ws + WS_CTL, 0, CTL_ZERO_BYTES, stream);
    Args a{};
    for (int i = 0; i < 27; ++i) a.in[i] = (const float*)d_in[i];
    a.out = (float*)d_out; a.ws = (unsigned char*)d_ws;
    hipLaunchKernelGGL(fwd_kernel, dim3(grid), dim3(512), LDS_BYTES, stream, a);
}
```

```cpp
#include <hip/hip_runtime.h>
#include <cstdio>
#include <cstdint>

#define GAS __attribute__((address_space(1)))
#define LAS __attribute__((address_space(3)))
typedef unsigned short bf16;
typedef unsigned short bf16_t;
typedef short bf16x8 __attribute__((ext_vector_type(8)));
typedef short s16x4 __attribute__((ext_vector_type(4)));
typedef float f32x4 __attribute__((ext_vector_type(4)));
typedef float f32x2 __attribute__((ext_vector_type(2)));
typedef float f32x8 __attribute__((ext_vector_type(8)));
typedef float f32x16 __attribute__((ext_vector_type(16)));
typedef unsigned u32x4 __attribute__((ext_vector_type(4)));
typedef unsigned u32x2 __attribute__((ext_vector_type(2)));
typedef unsigned v4u __attribute__((ext_vector_type(4)));

#define LDS_WAIT() asm volatile("s_waitcnt lgkmcnt(0)" ::: "memory")
#define VM_WAIT() asm volatile("s_waitcnt vmcnt(0)" ::: "memory")
#define SBAR() __builtin_amdgcn_sched_barrier(0)

__device__ __forceinline__ unsigned cvt_pk_bf16(float lo, float hi) { unsigned r; asm volatile("v_cvt_pk_bf16_f32 %0, %1, %2" : "=v"(r) : "v"(lo), "v"(hi)); return r; }
__device__ __forceinline__ float bf_lo(unsigned w) { return __uint_as_float(w << 16); }
__device__ __forceinline__ float bf_hi(unsigned w) { return __uint_as_float(w & 0xffff0000u); }
__device__ __forceinline__ float bf2f(bf16 h) { return __uint_as_float(((unsigned)h) << 16); }
__device__ __forceinline__ bf16 f2bf(float f) { return (bf16)(cvt_pk_bf16(f, 0.f) & 0xffffu); }
__device__ __forceinline__ float dpp_add(float v, const int ctrl, const int row_mask) { return v; }
#define DPP_ADD(v, ctrl, rmask) ((v) + __int_as_float(__builtin_amdgcn_update_dpp(0, __float_as_int(v), (ctrl), (rmask), 0xF, false)))
__device__ __forceinline__ float wave_sum(float v, int) {
    v = DPP_ADD(v, 0xB1, 0xF);
    v = DPP_ADD(v, 0x4E, 0xF);
    v = DPP_ADD(v, 0x141, 0xF);
    v = DPP_ADD(v, 0x140, 0xF);
    v = DPP_ADD(v, 0x142, 0xA);
    v = DPP_ADD(v, 0x143, 0xC);
    return __int_as_float(__builtin_amdgcn_readlane(__float_as_int(v), 63));
}
__device__ __forceinline__ float fast_exp(float x) { return __builtin_amdgcn_exp2f(x * 1.4426950408889634f); }
__device__ __forceinline__ float sigmoidf_(float x) { return __builtin_amdgcn_rcpf(1.0f + fast_exp(-x)); }

#define XB_TMO      128
#define XB_XCNT(j)  (256  + 64 * (j))
#define XB_XSUB(j)  (1280 + 64 * (j))
#define XB_XGEN(j)  (2304 + 64 * (j))
#define XB_TOP      3328
#define XB_TOPGEN   3392
#define XCD_BAR_WORDS 3456
#define XB_SPIN_CAP (1u << 18)

__device__ __forceinline__ unsigned xb_ld(unsigned* p)              { return __hip_atomic_load(p, __ATOMIC_RELAXED, __HIP_MEMORY_SCOPE_AGENT); }
__device__ __forceinline__ unsigned xb_add(unsigned* p, unsigned v) { return __hip_atomic_fetch_add(p, v, __ATOMIC_RELAXED, __HIP_MEMORY_SCOPE_AGENT); }
__device__ __forceinline__ unsigned xb_xcc_id() { return (unsigned)__builtin_amdgcn_s_getreg((3 << 11) | 20) & 0xFu; }
#define XB_SPIN(cond, bar) do { unsigned _sp = 0; while (cond) { __builtin_amdgcn_s_sleep(1); \
    if ((++_sp & 255u) == 0u) { if (xb_ld(&(bar)[XB_TMO])) break; if (_sp > XB_SPIN_CAP) { atomicAdd(&(bar)[XB_TMO], 1u); break; } } } } while (0)

struct XcdBarrier { unsigned* bar; unsigned x; volatile LAS unsigned* st; };

__device__ __forceinline__ XcdBarrier xcd_barrier_post(unsigned* bar, volatile LAS unsigned* st) {
    XcdBarrier b; b.bar = bar; b.x = xb_xcc_id(); b.st = st;
    if (threadIdx.x == 0) (void)xb_add(&bar[XB_XCNT(b.x)], 1u);
    return b;
}
__device__ __forceinline__ void xcd_barrier_complete(unsigned* bar, unsigned x, unsigned& nloc, unsigned& nx) {
    const unsigned G = gridDim.x * gridDim.y * gridDim.z;
    unsigned sum, cnt, mine, sp = 0u;
    for (;;) {
        sum = 0u; cnt = 0u; mine = 0u;
#pragma unroll
        for (unsigned j = 0; j < 16; ++j) { const unsigned c = xb_ld(&bar[XB_XCNT(j)]); sum += c; cnt += (c > 0u) ? 1u : 0u; mine = (j == x) ? c : mine; }
        if (sum == G) break;
        __builtin_amdgcn_s_sleep(1);
        if ((++sp & 255u) == 0u) { if (xb_ld(&bar[XB_TMO])) break; if (sp > XB_SPIN_CAP) { atomicAdd(&bar[XB_TMO], 1u); break; } }
    }
    nloc = mine > 0u ? mine : 1u; nx = cnt > 0u ? cnt : 1u;
}
__device__ __forceinline__ void xcd_barrier(const XcdBarrier& b) {
    asm volatile("s_waitcnt vmcnt(0)" ::: "memory");
    __syncthreads();
    if (threadIdx.x == 0) {
        unsigned* bar = b.bar; asm volatile("" : "+s"(bar));
        __builtin_amdgcn_s_waitcnt(0);
        unsigned nloc = b.st[0], nx = b.st[1]; unsigned bx = b.x; asm volatile("" : "+s"(bx));
        if (nloc == 0u) { xcd_barrier_complete(bar, bx, nloc, nx); b.st[0] = nloc; b.st[1] = nx; }
        const unsigned old = xb_add(&bar[XB_XSUB(bx)], 1u);
        const unsigned gen = old / nloc;
        if (old + 1u == (gen + 1u) * nloc) {
            __builtin_amdgcn_fence(__ATOMIC_RELEASE, "agent");
            asm volatile("s_waitcnt vmcnt(0)" ::: "memory");
            const unsigned og = xb_add(&bar[XB_TOP], 1u);
            const unsigned tg = og / nx;
            if (og + 1u == (tg + 1u) * nx) xb_add(&bar[XB_TOPGEN], 1u);
            else XB_SPIN(xb_ld(&bar[XB_TOPGEN]) == tg, bar);
            __builtin_amdgcn_fence(__ATOMIC_ACQUIRE, "agent");
            xb_add(&bar[XB_XGEN(bx)], 1u);
            asm volatile("s_waitcnt vmcnt(0)" ::: "memory");
        } else {
            XB_SPIN(xb_ld(&bar[XB_XGEN(bx)]) == gen, bar);
            __builtin_amdgcn_fence(__ATOMIC_ACQUIRE, "agent");
            asm volatile("s_waitcnt vmcnt(0)" ::: "memory");
        }
    }
    __syncthreads();
}

namespace pg8 {
constexpr int BM = 256, BK = 64, HALF = 128, HTB = HALF * BK * 2, STAGE_BYTES = 8 * HTB, NXCD = 8, WGM = 8;
__host__ __device__ __forceinline__ int lds_byte(int r, int c) { const int st = (r >> 4) * 2 + (c >> 5), rr = r & 15, cc = c & 31, ob = rr * 64 + cc * 2; return st * 1024 + (ob ^ (((ob >> 9) & 1) << 5)); }
__host__ __device__ __forceinline__ void stage_rc(int b, int& R, int& C) { const int st = b / 1024, sb = b % 1024, swz = sb ^ (((sb >> 9) & 1) << 5); R = (st >> 1) * 16 + swz / 64; C = (st & 1) * 32 + (swz % 64) / 2; }
__host__ __device__ __forceinline__ int perm32(int rho) { const int n = rho >> 4, i = rho & 15; return 8 * (i >> 2) + 4 * n + (i & 3); }

struct Unit { const char* a; const char* b; int pm, pn; };

__device__ __forceinline__ bool static_tile(int i, int G, int c, int nM, int nN, int& pm, int& pn) {
    const int nwg = nM * nN; const long L = (long)i * G + c; if (L >= nwg) return false;
    int wgid = (int)L; { const int q = nwg / NXCD, r = nwg % NXCD, xcd = wgid % NXCD, off = wgid / NXCD; wgid = (xcd < r ? xcd * (q + 1) : r * (q + 1) + (xcd - r) * q) + off; }
    const int nig = WGM * nN, gid = wgid / nig, fm = gid * WGM, gsz = (nM - fm) < WGM ? (nM - fm) : WGM;
    pm = fm + ((wgid % nig) % gsz); pn = (wgid % nig) / gsz; return true;
}
struct DenseOrder {
    const char* A; const char* Bt; int K, nM, nN, G, c, split, skip;
    __device__ __forceinline__ bool next(int i, Unit& u) const {
        int pm, pn; if (!static_tile(i, G, c, nM, nN, pm, pn)) return false;
        const int pp = pn < split ? pn : pn + skip;
        u.pm = pm; u.pn = pn; u.a = A + (size_t)pm * 256 * K * 2; u.b = Bt + (size_t)pp * 256 * K * 2; return true;
    }
    __device__ __forceinline__ void rows(const Unit&, int, int, unsigned (&)[2], unsigned (&)[2]) const {}
};

#if defined(GEMM_STAMP)
#define GSTAMP(seg) do { if (blockIdx.x == 0 && wid == 0 && lane == 0) { volatile LAS unsigned* m_ = (volatile LAS unsigned*)(lds + 159744 + 4 * 450); if (m_[14]) { const unsigned now_ = (unsigned)__builtin_amdgcn_s_memrealtime(); m_[seg] += now_ - m_[15]; m_[15] = now_; } } } while (0)
#else
#define GSTAMP(seg) do { } while (0)
#endif
template <class Epi, class Sched, bool ALIGN_EPI, bool GATHER>
__device__ __forceinline__ void gemm_phase(LAS unsigned char* lds, const int K, const Sched& S, const Epi& E) {
    int tid_ = threadIdx.x; asm volatile("" : "+v"(tid_));
    const int tid = tid_, wid = __builtin_amdgcn_readfirstlane(tid >> 6), lane = tid & 63, wr = wid >> 2, wc = wid & 3, fr = lane & 15, fq = lane >> 4;
    const int nt = K / BK;
    unsigned voffA[2], voffB[2]; int stR = 0, stC = 0;
#pragma unroll
    for (int i = 0; i < 2; ++i) { int R, C; stage_rc(tid * 16 + i * 8192, R, C); const int Rb = Epi::PERM ? ((R & ~31) + perm32(R & 31)) : R;
        voffA[i] = (unsigned)(R * K + C) * 2u; voffB[i] = (unsigned)(Rb * K + C) * 2u; if (i == 0) { stR = R; stC = C; } }
    const size_t kstep = (size_t)(BK * 2);
    const size_t hstep = (size_t)HALF * K * 2;
    const unsigned ldsw = (unsigned)wid * 1024u;
    const int aoff = lds_byte(wr * 64 + fr, fq * 8), boff = lds_byte(wc * 32 + fr, fq * 8);
    unsigned ga0[2] = {0u, 0u}, ga1[2] = {0u, 0u};
#define PG8_SA(b, h) (((b) * 2 + (h)) * HTB)
#define PG8_SB(b, h) ((4 + (b) * 2 + (h)) * HTB)
#define PG8_STAGE(bufoff, gbase, voff) do { _Pragma("unroll") for (int _i = 0; _i < 2; ++_i) \
        __builtin_amdgcn_global_load_lds((const unsigned*)((const char*)(gbase) + (voff)[_i]), (LAS unsigned*)(lds + (bufoff) + ldsw + _i * 8192), 16, 0, 0); } while (0)
#define PG8_STAGE_A(bufoff, gbase, h, nx) do { if constexpr (GATHER) { if (h) PG8_STAGE(bufoff, gbase, ga1); else PG8_STAGE(bufoff, gbase, ga0); } \
        else { PG8_STAGE(bufoff, (gbase) + (h) * hstep, voffA); } } while (0)
#define PG8_LDA(dst, b, h) do { _Pragma("unroll") for (int m = 0; m < 4; ++m) _Pragma("unroll") for (int k = 0; k < 2; ++k) dst[m][k] = *(const LAS bf16x8*)(lds + PG8_SA(b, h) + aoff + m * 2048 + k * 1024); } while (0)
#define PG8_LDB(dst, b, h) do { _Pragma("unroll") for (int n = 0; n < 2; ++n) _Pragma("unroll") for (int k = 0; k < 2; ++k) dst[n][k] = *(const LAS bf16x8*)(lds + PG8_SB(b, h) + boff + n * 2048 + k * 1024); } while (0)
#define PG8_MMA(ai, bj, At, Bt) do { __builtin_amdgcn_s_setprio(1); _Pragma("unroll") for (int m = 0; m < 4; ++m) _Pragma("unroll") for (int n = 0; n < 2; ++n) _Pragma("unroll") for (int k = 0; k < 2; ++k) \
        acc[ai][bj][m][n] = __builtin_amdgcn_mfma_f32_16x16x32_bf16(Bt[n][k], At[m][k], acc[ai][bj][m][n], 0, 0, 0); __builtin_amdgcn_s_setprio(0); } while (0)
#define PG8_WAIT_V(n) asm volatile("s_waitcnt vmcnt(" #n ")" ::: "memory")
#define PG8_WAIT_L(n) asm volatile("s_waitcnt lgkmcnt(" #n ")" ::: "memory")
#define PG8_BAR __builtin_amdgcn_s_barrier()
#define PG8_SCHED __builtin_amdgcn_sched_barrier(0)
    Unit cur, nxt; int ui = 0;
    if (!S.next(0, cur)) return;
    f32x4 acc[2][2][4][2];
#pragma unroll
    for (int a = 0; a < 2; ++a)
#pragma unroll
        for (int b = 0; b < 2; ++b)
#pragma unroll
            for (int m = 0; m < 4; ++m)
#pragma unroll
                for (int n = 0; n < 2; ++n) acc[a][b][m][n] = (f32x4){0.f, 0.f, 0.f, 0.f};
    bf16x8 At[4][2], B0[2][2], B1[2][2];
    const char* cA = cur.a; const char* cB = cur.b;
    if constexpr (GATHER) { S.rows(cur, stR, stC, ga0, ga1); }
    PG8_STAGE(PG8_SB(0, 0), cB, voffB); PG8_STAGE(PG8_SB(0, 1), cB + hstep, voffB); PG8_STAGE_A(PG8_SA(0, 0), cA, 0, false); PG8_STAGE_A(PG8_SA(0, 1), cA, 1, false);
    if (wr == 1) PG8_BAR;
    PG8_WAIT_V(2); PG8_BAR;
    PG8_STAGE(PG8_SB(1, 0), cB + kstep, voffB); PG8_STAGE_A(PG8_SA(1, 0), cA + kstep, 0, false); PG8_STAGE(PG8_SB(1, 1), cB + hstep + kstep, voffB);
    PG8_WAIT_V(6); PG8_BAR;
    for (;;) {
        const bool has_next = S.next(ui + 1, nxt);
        const char* nA = has_next ? nxt.a : cA; const char* nB = has_next ? nxt.b : cB;
        GSTAMP(0);
#pragma unroll 1
        for (int t = 0; t < nt; t += 2) {
            const bool last = (t == nt - 2);
            const char* a1 = cA + (size_t)(t + 1) * kstep;
            const char* a2 = last ? nA : cA + (size_t)(t + 2) * kstep; const char* b2 = last ? nB : cB + (size_t)(t + 2) * kstep;
            const char* a3 = a2 + kstep; const char* b3 = b2 + kstep;
            PG8_LDB(B0, 0, 0); PG8_LDB(B1, 0, 1); PG8_SCHED; PG8_LDA(At, 0, 0); PG8_STAGE_A(PG8_SA(1, 1), a1, 1, false);
            if constexpr (GATHER) { if (last && has_next) S.rows(nxt, stR, stC, ga0, ga1); }
            PG8_WAIT_V(8); PG8_WAIT_L(0); PG8_BAR; PG8_MMA(0, 0, At, B0); PG8_MMA(0, 1, At, B1); PG8_BAR; PG8_SCHED;
            PG8_LDA(At, 0, 1); PG8_STAGE(PG8_SB(0, 0), b2, voffB); PG8_STAGE(PG8_SB(0, 1), b2 + hstep, voffB); PG8_STAGE_A(PG8_SA(0, 0), a2, 0, last);
            PG8_WAIT_V(8); PG8_WAIT_L(0); PG8_BAR; PG8_MMA(1, 0, At, B0); PG8_MMA(1, 1, At, B1); PG8_BAR; PG8_SCHED;
            PG8_LDB(B0, 1, 0); PG8_LDB(B1, 1, 1); PG8_SCHED; PG8_LDA(At, 1, 0); PG8_STAGE_A(PG8_SA(0, 1), a2, 1, last);
            PG8_WAIT_V(8); PG8_WAIT_L(0); PG8_BAR; PG8_MMA(0, 0, At, B0); PG8_MMA(0, 1, At, B1); PG8_BAR; PG8_SCHED;
            PG8_LDA(At, 1, 1); PG8_STAGE(PG8_SB(1, 0), b3, voffB); PG8_STAGE(PG8_SB(1, 1), b3 + hstep, voffB); PG8_STAGE_A(PG8_SA(1, 0), a3, 0, last);
            PG8_WAIT_V(8); PG8_WAIT_L(0); PG8_BAR; PG8_MMA(1, 0, At, B0); PG8_MMA(1, 1, At, B1); PG8_BAR; PG8_SCHED;
        }
        GSTAMP(1);
        if constexpr (ALIGN_EPI) { if (wr == 0) PG8_BAR; }
        E(acc, cur, wr, wc, fr, fq);
        if (!has_next) break;
#pragma unroll
        for (int a = 0; a < 2; ++a)
#pragma unroll
            for (int b = 0; b < 2; ++b)
#pragma unroll
                for (int m = 0; m < 4; ++m)
#pragma unroll
                    for (int n = 0; n < 2; ++n) acc[a][b][m][n] = (f32x4){0.f, 0.f, 0.f, 0.f};
        cur = nxt; cA = nA; cB = nB; ++ui;
        if constexpr (ALIGN_EPI) { if (wr == 1) PG8_BAR; }
    }
    PG8_WAIT_V(0);
    if constexpr (!ALIGN_EPI) { if (wr == 0) PG8_BAR; }
    PG8_BAR;
#undef PG8_SA
#undef PG8_SB
#undef PG8_STAGE
#undef PG8_STAGE_A
#undef PG8_LDA
#undef PG8_LDB
#undef PG8_MMA
#undef PG8_WAIT_V
#undef PG8_WAIT_L
#undef PG8_BAR
#undef PG8_SCHED
}

__device__ __forceinline__ u32x4 pack8(const f32x4 v0, const f32x4 v1) { u32x4 w; w.x = cvt_pk_bf16(v0[0], v0[1]); w.y = cvt_pk_bf16(v0[2], v0[3]); w.z = cvt_pk_bf16(v1[0], v1[1]); w.w = cvt_pk_bf16(v1[2], v1[3]); return w; }

struct EpiPlain {
    static constexpr bool PERM = true;
    bf16_t* O; int ldc;
    __device__ __forceinline__ void operator()(const f32x4 (&acc)[2][2][4][2], const Unit& u, int wr, int wc, int fr, int fq) const {
        bf16_t* base = O + (size_t)u.pm * BM * ldc + u.pn * BM;
        const unsigned lo = (unsigned)((wr * 64 + fr) * ldc + wc * 32 + 8 * fq);
#pragma unroll
        for (int ai = 0; ai < 2; ++ai)
#pragma unroll
            for (int m = 0; m < 4; ++m)
#pragma unroll
                for (int bj = 0; bj < 2; ++bj) *(u32x4*)(base + (size_t)((ai * HALF + m * 16) * ldc + bj * HALF) + lo) = pack8(acc[ai][bj][m][0], acc[ai][bj][m][1]);
    }
};
struct EpiPre {
    static constexpr bool PERM = false;
    float* out; const bf16_t* xb; float alpha;
    __device__ __forceinline__ void operator()(const f32x4 (&acc)[2][2][4][2], const Unit& u, int wr, int wc, int fr, int fq) const {
        const size_t ub = (size_t)u.pm * BM * 2048 + u.pn * BM; float* ob = out + ub; const bf16_t* xbb = xb + ub;
        const unsigned lo = (unsigned)((wr * 64 + fr) * 2048 + wc * 32 + 4 * fq);
#pragma unroll
        for (int ai = 0; ai < 2; ++ai)
#pragma unroll
            for (int m = 0; m < 4; ++m)
#pragma unroll
                for (int bj = 0; bj < 2; ++bj)
#pragma unroll
                    for (int n = 0; n < 2; ++n) { const unsigned uo = (unsigned)((ai * HALF + m * 16) * 2048 + bj * HALF + n * 16);
                        const u32x2 xw = *(const u32x2*)(xbb + uo + lo);
                        f32x4 o; o[0] = alpha * bf_lo(xw.x) + acc[ai][bj][m][n][0]; o[1] = alpha * bf_hi(xw.x) + acc[ai][bj][m][n][1]; o[2] = alpha * bf_lo(xw.y) + acc[ai][bj][m][n][2]; o[3] = alpha * bf_hi(xw.y) + acc[ai][bj][m][n][3];
                        *(f32x4*)(ob + uo + lo) = o; }
    }
};
struct EpiCinN {
    static constexpr bool PERM = true;
    bf16_t* Q; bf16_t* G; const float* cs; const float* sn;
    __device__ __forceinline__ void operator()(const f32x4 (&acc)[2][2][4][2], const Unit& u, int wr, int wc, int fr, int fq) const {
        if (u.pn < 8) {
            bf16_t* base = Q + (size_t)u.pm * BM * 2048 + u.pn * 256;
            const int i0 = wc * 32 + 8 * fq; const unsigned lo = (unsigned)((wr * 64 + fr) * 2048 + i0);
            const int s0 = ((u.pm * BM) & 4095) + wr * 64 + fr;
            const unsigned to = (unsigned)(s0 * 128 + i0);
#pragma unroll
            for (int ai = 0; ai < 2; ++ai)
#pragma unroll
                for (int m = 0; m < 4; ++m) { const unsigned tt = to + (unsigned)((ai * HALF + m * 16) * 128);
                    const f32x4 c0 = *(const f32x4*)(cs + tt), c1 = *(const f32x4*)(cs + tt + 4), s0v = *(const f32x4*)(sn + tt), s1v = *(const f32x4*)(sn + tt + 4);
                    const f32x4 x10 = acc[ai][0][m][0], x11 = acc[ai][0][m][1], x20 = acc[ai][1][m][0], x21 = acc[ai][1][m][1];
                    const f32x4 o10 = x10 * c0 - x20 * s0v, o11 = x11 * c1 - x21 * s1v, o20 = x20 * c0 + x10 * s0v, o21 = x21 * c1 + x11 * s1v;
                    bf16_t* rowp = base + (size_t)((ai * HALF + m * 16) * 2048) + lo;
                    *(u32x4*)(rowp) = pack8(o10, o11); *(u32x4*)(rowp + 128) = pack8(o20, o21); }
        } else {
            bf16_t* base = G + (size_t)u.pm * BM * 4096 + (u.pn - 8) * BM; const unsigned lo = (unsigned)((wr * 64 + fr) * 4096 + wc * 32 + 8 * fq);
#pragma unroll
            for (int ai = 0; ai < 2; ++ai)
#pragma unroll
                for (int m = 0; m < 4; ++m)
#pragma unroll
                    for (int bj = 0; bj < 2; ++bj) *(u32x4*)(base + (size_t)((ai * HALF + m * 16) * 4096 + bj * HALF) + lo) = pack8(acc[ai][bj][m][0], acc[ai][bj][m][1]);
        }
    }
};
struct EpiCinT {
    static constexpr bool PERM = true;
    bf16_t* O; const float* csT; const float* snT;
    __device__ __forceinline__ void operator()(const f32x4 (&acc)[2][2][4][2], const Unit& u, int wr, int wc, int fr, int fq) const {
        bf16_t* base = O + (size_t)u.pm * BM * 16384 + u.pn * BM; const unsigned lo = (unsigned)((wr * 64 + fr) * 16384 + wc * 32 + 8 * fq);
        if (u.pm < 8) {
            const unsigned to = (unsigned)((wr * 64 + fr) * 4096 + ((u.pn * BM) & 4095) + wc * 32 + 8 * fq);
#pragma unroll
            for (int m = 0; m < 4; ++m)
#pragma unroll
                for (int bj = 0; bj < 2; ++bj) { const unsigned tt = to + (unsigned)(m * 16 * 4096 + bj * HALF);
                    const f32x4 c0 = *(const f32x4*)(csT + tt), c1 = *(const f32x4*)(csT + tt + 4), s0 = *(const f32x4*)(snT + tt), s1 = *(const f32x4*)(snT + tt + 4);
                    const f32x4 x10 = acc[0][bj][m][0], x11 = acc[0][bj][m][1], x20 = acc[1][bj][m][0], x21 = acc[1][bj][m][1];
                    const f32x4 o10 = (x10 * c0 - x20 * s0) * 0.0625f, o11 = (x11 * c1 - x21 * s1) * 0.0625f, o20 = (x20 * c0 + x10 * s0) * 0.0625f, o21 = (x21 * c1 + x11 * s1) * 0.0625f;
                    *(u32x4*)(base + (size_t)(m * 16 * 16384 + bj * HALF) + lo) = pack8(o10, o11);
                    *(u32x4*)(base + (size_t)((HALF + m * 16) * 16384 + bj * HALF) + lo) = pack8(o20, o21); }
        } else {
#pragma unroll
            for (int ai = 0; ai < 2; ++ai)
#pragma unroll
                for (int m = 0; m < 4; ++m)
#pragma unroll
                    for (int bj = 0; bj < 2; ++bj) *(u32x4*)(base + (size_t)((ai * HALF + m * 16) * 16384 + bj * HALF) + lo) = pack8(acc[ai][bj][m][0], acc[ai][bj][m][1]);
        }
    }
};
struct EpiPle {
    static constexpr bool PERM = true;
    bf16_t* PLE; const bf16_t* PROJ; const float* bias; float* LOG;
    __device__ __forceinline__ void operator()(const f32x4 (&acc)[2][2][4][2], const Unit& u, int wr, int wc, int fr, int fq) const {
        if (u.pn < 8) {
            const size_t ub = (size_t)u.pm * BM * 2048 + u.pn * BM; bf16_t* pb = PLE + ub; const bf16_t* jb = PROJ + ub; const float* bb = bias + u.pn * BM;
            const unsigned lo = (unsigned)((wr * 64 + fr) * 2048 + wc * 32 + 8 * fq), lc = (unsigned)(wc * 32 + 8 * fq);
#pragma unroll
            for (int bj = 0; bj < 2; ++bj) { const f32x4 bv0 = *(const f32x4*)(bb + lc + bj * HALF), bv1 = *(const f32x4*)(bb + lc + bj * HALF + 4);
#pragma unroll
                for (int ai = 0; ai < 2; ++ai)
#pragma unroll
                    for (int m = 0; m < 4; ++m) { const unsigned uo = (unsigned)((ai * HALF + m * 16) * 2048 + bj * HALF); const u32x4 pw = *(const u32x4*)(jb + uo + lo);
                        f32x4 v0 = acc[ai][bj][m][0] + bv0, v1 = acc[ai][bj][m][1] + bv1;
                        v0[0] = sigmoidf_(v0[0]) * bf_lo(pw.x); v0[1] = sigmoidf_(v0[1]) * bf_hi(pw.x); v0[2] = sigmoidf_(v0[2]) * bf_lo(pw.y); v0[3] = sigmoidf_(v0[3]) * bf_hi(pw.y);
                        v1[0] = sigmoidf_(v1[0]) * bf_lo(pw.z); v1[1] = sigmoidf_(v1[1]) * bf_hi(pw.z); v1[2] = sigmoidf_(v1[2]) * bf_lo(pw.w); v1[3] = sigmoidf_(v1[3]) * bf_hi(pw.w);
                        *(u32x4*)(pb + uo + lo) = pack8(v0, v1); } }
        } else if (wc < 2) {
            float* lb = LOG + (size_t)u.pm * BM * 64; const unsigned lo = (unsigned)((wr * 64 + fr) * 64 + wc * 32 + 8 * fq);
#pragma unroll
            for (int ai = 0; ai < 2; ++ai)
#pragma unroll
                for (int m = 0; m < 4; ++m) { float* rowp = lb + (ai * HALF + m * 16) * 64 + lo;
                    *(f32x4*)(rowp) = acc[ai][0][m][0]; *(f32x4*)(rowp + 4) = acc[ai][0][m][1]; }
        }
    }
};
struct EpiGU {
    static constexpr bool PERM = true;
    bf16_t* HB;
    __device__ __forceinline__ void operator()(const f32x4 (&acc)[2][2][4][2], const Unit& u, int wr, int wc, int fr, int fq) const {
        bf16_t* base = HB + (size_t)u.pm * BM * 512 + u.pn * 128; const unsigned lo = (unsigned)((wr * 64 + fr) * 512 + wc * 32 + 8 * fq);
#pragma unroll
        for (int ai = 0; ai < 2; ++ai)
#pragma unroll
            for (int m = 0; m < 4; ++m) { f32x4 h0, h1;
#pragma unroll
                for (int j = 0; j < 4; ++j) { const float g0 = acc[ai][0][m][0][j], g1 = acc[ai][0][m][1][j]; h0[j] = g0 * sigmoidf_(g0) * acc[ai][1][m][0][j]; h1[j] = g1 * sigmoidf_(g1) * acc[ai][1][m][1][j]; }
                *(u32x4*)(base + (size_t)((ai * HALF + m * 16) * 512) + lo) = pack8(h0, h1); }
    }
};
}

namespace att {
constexpr int KVBLK = 64;
constexpr int SHM_V = 16384, SHM_K = 16384, SHM_P = 8192;
constexpr int OFF_V = 0, OFF_K = 2 * SHM_V, OFF_P = OFF_K + 2 * SHM_K, OFF_WS = OFF_P + 2 * SHM_P, OFF_BIAS = OFF_WS + 8 * 64 * 4, OFF_QPE = OFF_BIAS + 512 * 4, OFF_QNO = OFF_QPE + 256 * 128, ATT_LDS = OFF_QNO + 256 * 128;
#define KSWZ(row, colB) ((row) * 256 + ((colB) ^ (((row) & 7) << 4)))
#define PSWZ(row, colB) ((row) * 128 + ((colB) ^ (((row) & 7) << 4)))
__device__ __forceinline__ int crow(int r, int hi) { return (r & 3) + 8 * (r >> 2) + 4 * hi; }

template <int MODE> struct Cfg;
template <> struct Cfg<0> { static constexpr int NQ = 4; static constexpr float SCALE = 0.07216878364870323f; static constexpr int LDQ = 1536, LDK = 2048, LDO = 2048; };
template <> struct Cfg<1> { static constexpr int NQ = 4;  static constexpr float SCALE = 0.08838834764831845f; static constexpr int LDQ = 4096, LDK = 4096, LDO = 2048; };
constexpr float THRN = 8.f;

template <int MODE>
__device__ __forceinline__ void partialSM(f32x16& p0, f32x16& p1, float& m_reg, float& mn, float& alpha) {
  constexpr float SCALE = Cfg<MODE>::SCALE; constexpr float C = SCALE * 1.4426950408889634f;
  float pmax = p0[0];
#pragma unroll
  for (int r = 1; r < 16; ++r) pmax = fmaxf(pmax, p0[r]);
#pragma unroll
  for (int r = 0; r < 16; ++r) pmax = fmaxf(pmax, p1[r]);
  { auto rr = __builtin_amdgcn_permlane32_swap(__float_as_uint(pmax), __float_as_uint(pmax), false, false);
    pmax = fmaxf(__uint_as_float(rr[0]), __uint_as_float(rr[1])); }
  if (__builtin_expect(__all(pmax - m_reg <= THRN / SCALE), 1)) { mn = m_reg; alpha = 1.f; }
  else { mn = fmaxf(m_reg, pmax); alpha = __builtin_amdgcn_exp2f((m_reg - mn) * C); m_reg = mn; }
  float mnC = -mn * C;
#pragma unroll
  for (int r = 0; r < 16; ++r) p0[r] = fmaf(p0[r], C, mnC);
#pragma unroll
  for (int r = 0; r < 16; ++r) p1[r] = fmaf(p1[r], C, mnC);
#pragma unroll
  for (int r = 0; r < 16; ++r) p0[r] = __builtin_amdgcn_exp2f(p0[r]);
}
__device__ __forceinline__ void finishSM(f32x16& p0, f32x16& p1, float alpha, float& l_reg, bf16x8& pa0, bf16x8& pa1, bf16x8& pa2, bf16x8& pa3) {
#pragma unroll
  for (int r = 0; r < 16; ++r) p1[r] = __builtin_amdgcn_exp2f(p1[r]);
  float ps = 0;
#pragma unroll
  for (int r = 0; r < 16; ++r) ps += p0[r];
#pragma unroll
  for (int r = 0; r < 16; ++r) ps += p1[r];
  { auto rr = __builtin_amdgcn_permlane32_swap(__float_as_uint(ps), __float_as_uint(ps), false, false);
    ps = __uint_as_float(rr[0]) + __uint_as_float(rr[1]); }
  l_reg = l_reg * alpha + ps;
#define PK4(P, BASE, OUT) do { unsigned a0 = cvt_pk_bf16(P[BASE + 0], P[BASE + 1]), a1 = cvt_pk_bf16(P[BASE + 2], P[BASE + 3]);   \
    unsigned b0 = cvt_pk_bf16(P[BASE + 4], P[BASE + 5]), b1 = cvt_pk_bf16(P[BASE + 6], P[BASE + 7]);                              \
    auto r0 = __builtin_amdgcn_permlane32_swap(a0, b0, false, false); auto r1 = __builtin_amdgcn_permlane32_swap(a1, b1, false, false); \
    u32x4 w = {r0[0], r1[0], r0[1], r1[1]}; OUT = *reinterpret_cast<bf16x8*>(&w); } while (0)
  PK4(p0, 0, pa0); PK4(p0, 8, pa1); PK4(p1, 0, pa2); PK4(p1, 8, pa3);
#undef PK4
}
template <int MODE>
__device__ __forceinline__ void qkt(f32x16& p0, f32x16& p1, const char* Ks, const char* Ps, const bf16x8* qr, const char* qpe, int r32, int hi) {
  p0 = f32x16{}; p1 = f32x16{};
#pragma unroll
  for (int d0 = 0; d0 < 8; ++d0) { int cb = (d0 * 16 + hi * 8) * 2;
    bf16x8 b0 = *reinterpret_cast<const bf16x8*>(Ks + KSWZ(r32, cb));
    bf16x8 b1 = *reinterpret_cast<const bf16x8*>(Ks + KSWZ(32 + r32, cb));
    const bf16x8 qf = d0 < 4 ? qr[d0 & 3] : *reinterpret_cast<const bf16x8*>(qpe + 256 * 128 + ((((d0 - 4) * 16 + hi * 8) * 2) ^ ((r32 & 7) << 4)));
    p0 = __builtin_amdgcn_mfma_f32_32x32x16_bf16(b0, qf, p0, 0, 0, 0);
    p1 = __builtin_amdgcn_mfma_f32_32x32x16_bf16(b1, qf, p1, 0, 0, 0); }
  if constexpr (MODE == 0) {
#pragma unroll
    for (int d0 = 0; d0 < 4; ++d0) { int cb = (d0 * 16 + hi * 8) * 2;
      bf16x8 b0 = *reinterpret_cast<const bf16x8*>(Ps + PSWZ(r32, cb));
      bf16x8 b1 = *reinterpret_cast<const bf16x8*>(Ps + PSWZ(32 + r32, cb));
      const bf16x8 qp = *reinterpret_cast<const bf16x8*>(qpe + (cb ^ ((r32 & 7) << 4)));
      p0 = __builtin_amdgcn_mfma_f32_32x32x16_bf16(b0, qp, p0, 0, 0, 0);
      p1 = __builtin_amdgcn_mfma_f32_32x32x16_bf16(b1, qp, p1, 0, 0, 0); }
  }
}
__device__ __forceinline__ int v_st(int k, int c) { const int kk = (k & ~0xC) | ((k & 4) << 1) | ((k & 8) >> 1); return ((kk >> 3) * 4 + (c >> 5)) * 512 + ((kk & 7) * 32 + (c & 31)) * 2; }
__device__ __forceinline__ int v_rd_base(int lane) { return ((lane & 3) << 3) | (((lane >> 2) & 3) << 6) | (((lane >> 4) & 1) << 5) | (((lane >> 5) & 1) << 8); }
constexpr int v_rd_off(int d0, int ks, int half) { return d0 * 512 + ks * 4096 + half * 2048; }
template <int OFF> __device__ __forceinline__ s16x4 tr_read(int vb) {
  s16x4 r; asm volatile("ds_read_b64_tr_b16 %0, %1 offset:%2" : "=&v"(r) : "v"(vb), "i"(OFF) : "memory"); return r;
}
template <int D0> __device__ __forceinline__ void pv_one(f32x16& od, int vb, bf16x8 pa0, bf16x8 pa1, bf16x8 pa2, bf16x8 pa3) {
  const s16x4 l0 = tr_read<v_rd_off(D0, 0, 0)>(vb), h0 = tr_read<v_rd_off(D0, 0, 1)>(vb), l1 = tr_read<v_rd_off(D0, 1, 0)>(vb), h1 = tr_read<v_rd_off(D0, 1, 1)>(vb);
  const s16x4 l2 = tr_read<v_rd_off(D0, 2, 0)>(vb), h2 = tr_read<v_rd_off(D0, 2, 1)>(vb), l3 = tr_read<v_rd_off(D0, 3, 0)>(vb), h3 = tr_read<v_rd_off(D0, 3, 1)>(vb);
  asm volatile("s_waitcnt lgkmcnt(0)" ::: "memory"); SBAR();
#define PKV(L, H) (bf16x8){L[0], L[1], L[2], L[3], H[0], H[1], H[2], H[3]}
  od = __builtin_amdgcn_mfma_f32_32x32x16_bf16(pa0, PKV(l0, h0), od, 0, 0, 0);
  od = __builtin_amdgcn_mfma_f32_32x32x16_bf16(pa1, PKV(l1, h1), od, 0, 0, 0);
  od = __builtin_amdgcn_mfma_f32_32x32x16_bf16(pa2, PKV(l2, h2), od, 0, 0, 0);
  od = __builtin_amdgcn_mfma_f32_32x32x16_bf16(pa3, PKV(l3, h3), od, 0, 0, 0);
#undef PKV
}
__device__ __forceinline__ void pv_d0(f32x16* o, int vb, bf16x8 pa0, bf16x8 pa1, bf16x8 pa2, bf16x8 pa3) {
  pv_one<0>(o[0], vb, pa0, pa1, pa2, pa3); pv_one<1>(o[1], vb, pa0, pa1, pa2, pa3); pv_one<2>(o[2], vb, pa0, pa1, pa2, pa3); pv_one<3>(o[3], vb, pa0, pa1, pa2, pa3);
}
__device__ __forceinline__ void na_mask(f32x16& p0, f32x16& p1, const float* biasS, int kr, int rq, int cq, int hi) {
  const int rs = min(max(rq - 4, 0), 56), cs = min(max(cq - 8, 0), 48);
  const bool rowok = (kr >= rs) && (kr <= rs + 7);
  int lo = (rowok ? cs : 1000) - 4 * hi;
  int bidx = (kr - rq + 7) * 31 - cq + 15 + 4 * hi;
  asm volatile("" : "+v"(bidx), "+v"(lo));
  const float* bp = biasS + bidx;
#pragma unroll
  for (int r = 0; r < 16; ++r) {
    const int c0 = (r & 3) + 8 * (r >> 2), c1 = 32 + c0;
    const bool ok0 = (unsigned)(c0 - lo) < 16u, ok1 = (unsigned)(c1 - lo) < 16u;
    const float b0 = bp[c0], b1 = bp[c1];
    p0[r] = ok0 ? p0[r] + b0 : -3.0e38f; p1[r] = ok1 ? p1[r] + b1 : -3.0e38f;
  }
}

struct AttnArgs {
  const bf16* Qp;
  const bf16* Kp; const bf16* Vp;
  const bf16* Pp;
  bf16* Op;
  const float* cosM; const float* sinM;
  int s0;
  int NT;
  int kr0;
  int rg;
};

template <int MODE>
__device__ __forceinline__ void attn_item(const AttnArgs& A, char* lds) {
  constexpr int NQ = Cfg<MODE>::NQ, LDQ = Cfg<MODE>::LDQ, LDK = Cfg<MODE>::LDK, LDO = Cfg<MODE>::LDO;
  int tid_ = threadIdx.x; asm volatile("" : "+v"(tid_));
  const int tid = tid_, wid = tid >> 6, lane = tid & 63, r32 = lane & 31, hi = lane >> 5;
  char* V_lds = lds + OFF_V; char* K_lds = lds + OFF_K; char* P_lds = lds + OFF_P;
  float* ws = (float*)(lds + OFF_WS) + wid * 64; float* li_l = ws; float* al_l = ws + 32;
  const float* biasS = (const float*)(lds + OFF_BIAS);
  float m_reg = -1e30f, l_reg = 0; f32x16 o[4] = {}; bf16x8 qr[NQ];
  char* qpe_row = lds + OFF_QPE + (wid * 32 + r32) * 128;
  const bf16* Qw = A.Qp + (wid * 32 + r32) * LDQ + hi * 8;
#pragma unroll
  for (int d0 = 0; d0 < 4; ++d0) qr[d0] = *reinterpret_cast<const bf16x8*>(Qw + d0 * 16);
#pragma unroll
  for (int d0 = 4; d0 < 8; ++d0) *reinterpret_cast<bf16x8*>(qpe_row + 256 * 128 + ((((d0 - 4) * 16 + hi * 8) * 2) ^ ((r32 & 7) << 4))) = *reinterpret_cast<const bf16x8*>(Qw + d0 * 16);
  if constexpr (MODE == 0) {
    const int s = A.s0 + wid * 32 + r32;
#pragma unroll
    for (int c = 0; c < 2; ++c) {
      const u32x4 x1 = *reinterpret_cast<const u32x4*>(Qw + (8 + c) * 16), x2 = *reinterpret_cast<const u32x4*>(Qw + (10 + c) * 16);
      const int i0 = c * 16 + hi * 8;
      const f32x4 ca = *(const f32x4*)(A.cosM + s * 32 + i0), cb = *(const f32x4*)(A.cosM + s * 32 + i0 + 4), sa = *(const f32x4*)(A.sinM + s * 32 + i0), sb = *(const f32x4*)(A.sinM + s * 32 + i0 + 4);
      float a[8], b[8], cc[8], ss[8];
      a[0] = bf_lo(x1.x); a[1] = bf_hi(x1.x); a[2] = bf_lo(x1.y); a[3] = bf_hi(x1.y); a[4] = bf_lo(x1.z); a[5] = bf_hi(x1.z); a[6] = bf_lo(x1.w); a[7] = bf_hi(x1.w);
      b[0] = bf_lo(x2.x); b[1] = bf_hi(x2.x); b[2] = bf_lo(x2.y); b[3] = bf_hi(x2.y); b[4] = bf_lo(x2.z); b[5] = bf_hi(x2.z); b[6] = bf_lo(x2.w); b[7] = bf_hi(x2.w);
#pragma unroll
      for (int j = 0; j < 4; ++j) { cc[j] = ca[j]; cc[4 + j] = cb[j]; ss[j] = sa[j]; ss[4 + j] = sb[j]; }
      float o1[8], o2[8];
#pragma unroll
      for (int j = 0; j < 8; ++j) { o1[j] = a[j] * cc[j] - b[j] * ss[j]; o2[j] = b[j] * cc[j] + a[j] * ss[j]; }
      u32x4 w1 = {cvt_pk_bf16(o1[0], o1[1]), cvt_pk_bf16(o1[2], o1[3]), cvt_pk_bf16(o1[4], o1[5]), cvt_pk_bf16(o1[6], o1[7])};
      u32x4 w2 = {cvt_pk_bf16(o2[0], o2[1]), cvt_pk_bf16(o2[2], o2[3]), cvt_pk_bf16(o2[4], o2[5]), cvt_pk_bf16(o2[6], o2[7])};
      *reinterpret_cast<u32x4*>(qpe_row + (((c * 16 + hi * 8) * 2) ^ ((r32 & 7) << 4))) = w1; *reinterpret_cast<u32x4*>(qpe_row + (((32 + c * 16 + hi * 8) * 2) ^ ((r32 & 7) << 4))) = w2;
    }
  }
  const int rq = A.rg * 4 + (wid >> 1), cq = 32 * (wid & 1) + r32;
  const int sr = tid >> 4, sc = (tid & 15) * 8, vst0 = v_st(sr, sc), vst1 = v_st(32 + sr, sc);
  const int pr = tid >> 3, pc = (tid & 7) * 8;
  const int vb0 = (int)(uintptr_t)V_lds + v_rd_base(lane);
  bf16x8 vs0, vs1, ks0, ks1, ps0;
  const int kvo0 = sr * LDK + sc, kvo1 = (32 + sr) * LDK + sc, po0 = pr * 64 + pc;
#define SLOAD(k0) do { const bf16* Vt = A.Vp + (size_t)(k0) * LDK; const bf16* Kt = A.Kp + (size_t)(k0) * LDK; \
    vs0 = *reinterpret_cast<const bf16x8*>(Vt + kvo0); vs1 = *reinterpret_cast<const bf16x8*>(Vt + kvo1); \
    ks0 = *reinterpret_cast<const bf16x8*>(Kt + kvo0); ks1 = *reinterpret_cast<const bf16x8*>(Kt + kvo1); \
    if constexpr (MODE == 0) ps0 = *reinterpret_cast<const bf16x8*>(A.Pp + (size_t)(k0) * 64 + po0); } while (0)
#define SWRITE(b) do { *(bf16x8*)(V_lds + (b) * SHM_V + vst0) = vs0; *(bf16x8*)(V_lds + (b) * SHM_V + vst1) = vs1; int kc = sc * 2; \
    *(bf16x8*)(K_lds + (b) * SHM_K + KSWZ(sr, kc)) = ks0; *(bf16x8*)(K_lds + (b) * SHM_K + KSWZ(32 + sr, kc)) = ks1; \
    if constexpr (MODE == 0) *(bf16x8*)(P_lds + (b) * SHM_P + PSWZ(pr, pc * 2)) = ps0; } while (0)
#define SWAIT() asm volatile("s_waitcnt vmcnt(0)" ::: "memory")
#define RESC(a) do { if (__any((a) < 1.f)) { if (hi == 0) al_l[r32] = (a); asm volatile("s_waitcnt lgkmcnt(0)" ::: "memory"); \
    _Pragma("unroll") for (int d = 0; d < 4; ++d) _Pragma("unroll") for (int r = 0; r < 16; ++r) o[d][r] *= al_l[crow(r, hi)]; } } while (0)
#define NAM(P0, P1, j) do { if constexpr (MODE == 1) na_mask(P0, P1, biasS, A.kr0 + (j), rq, cq, hi); } while (0)
  f32x16 pA0, pA1, pB0, pB1; float mnA, mnB, alA, alB; bf16x8 pa0, pa1, pa2, pa3; const int NT = A.NT;
  SLOAD(0); asm volatile("s_waitcnt vmcnt(0)" ::: "memory"); SWRITE(0); __syncthreads();
  qkt<MODE>(pA0, pA1, K_lds, P_lds, qr, qpe_row, r32, hi); NAM(pA0, pA1, 0); partialSM<MODE>(pA0, pA1, m_reg, mnA, alA);
  SLOAD(KVBLK);
  SWAIT(); SWRITE(1); __syncthreads();
  for (int j = 1; j + 1 < NT; j += 2) {
    SBAR(); qkt<MODE>(pB0, pB1, K_lds + SHM_K, P_lds + SHM_P, qr, qpe_row, r32, hi); NAM(pB0, pB1, j);
    finishSM(pA0, pA1, alA, l_reg, pa0, pa1, pa2, pa3); SBAR();
    SLOAD((j + 1) * KVBLK); SBAR();
    pv_d0(o, vb0, pa0, pa1, pa2, pa3); partialSM<MODE>(pB0, pB1, m_reg, mnB, alB);
    __syncthreads(); SWAIT(); SWRITE(0);
    RESC(alB); __syncthreads();
    SBAR(); qkt<MODE>(pA0, pA1, K_lds, P_lds, qr, qpe_row, r32, hi); NAM(pA0, pA1, j + 1);
    finishSM(pB0, pB1, alB, l_reg, pa0, pa1, pa2, pa3); SBAR();
    SLOAD((j + 2) * KVBLK); SBAR();
    pv_d0(o, vb0 + SHM_V, pa0, pa1, pa2, pa3); partialSM<MODE>(pA0, pA1, m_reg, mnA, alA);
    __syncthreads(); SWAIT(); SWRITE(1);
    RESC(alA); __syncthreads();
  }
  SBAR(); qkt<MODE>(pB0, pB1, K_lds + SHM_K, P_lds + SHM_P, qr, qpe_row, r32, hi); NAM(pB0, pB1, NT - 1);
  finishSM(pA0, pA1, alA, l_reg, pa0, pa1, pa2, pa3); SBAR();
  pv_d0(o, vb0, pa0, pa1, pa2, pa3); partialSM<MODE>(pB0, pB1, m_reg, mnB, alB);
  __syncthreads(); RESC(alB);
  finishSM(pB0, pB1, alB, l_reg, pa0, pa1, pa2, pa3); SBAR();
  pv_d0(o, vb0 + SHM_V, pa0, pa1, pa2, pa3);
  if (hi == 0) li_l[r32] = l_reg; asm volatile("s_waitcnt lgkmcnt(0)" ::: "memory");
  float rli[16];
#pragma unroll
  for (int r = 0; r < 16; ++r) rli[r] = __builtin_amdgcn_rcpf(li_l[crow(r, hi)]);
  bf16* Ow = A.Op + (wid * 32) * LDO + r32;
#pragma unroll
  for (int r = 0; r < 16; ++r) { const int orow = crow(r, hi);
#pragma unroll
    for (int d0 = 0; d0 < 4; ++d0) Ow[orow * LDO + d0 * 32] = f2bf(o[d0][r] * rli[r]); }
  __syncthreads();
#undef SLOAD
#undef SWRITE
#undef SWAIT
#undef RESC
#undef NAM
}
}

namespace ret {
constexpr int ST_PITCH = 528;
constexpr int OFF_VT = 0, VT_BYTES = 128 * 256, OFF_ST = 2 * VT_BYTES, ST_BYTES = 128 * ST_PITCH, RET_LDS = OFF_ST + ST_BYTES;
__device__ __forceinline__ int crow(int r, int hi) { return (r & 3) + 8 * (r >> 2) + 4 * hi; }

__device__ __forceinline__ unsigned ktoff(unsigned row, unsigned ch) { return 256u * row + 16u * (ch ^ (((row & 3u) << 2) | ((row >> 2) & 3u))); }
__device__ __forceinline__ void pprime_item(int item, const bf16* Qm, const bf16* KVT, bf16* PP, const float* lg2f, const float* lg2b, char* lds) {
  int tid_ = threadIdx.x; asm volatile("" : "+v"(tid_));
  const int tid = tid_, wid = __builtin_amdgcn_readfirstlane(tid >> 6), lane = tid & 63, r32 = lane & 31, hi = lane >> 5;
  const int bh = item >> 5, n = item & 31, b = bh >> 3, h = bh & 7;
  const int T0 = b * 4096 + n * 128;
  const int kb = wid >> 1, qb0 = 2 * (wid & 1);
  LAS unsigned char* ldsl = (LAS unsigned char*)lds;
  const char* kg = (const char*)(KVT + (size_t)(h * 256) * 16384 + T0);
#pragma unroll
  for (int i = 0; i < 8; ++i) { const unsigned d = 32u * wid + 4u * i + (lane >> 4); const unsigned ch = (lane & 15u) ^ (((d & 3u) << 2) | ((d >> 2) & 3u));
    __builtin_amdgcn_global_load_lds((const unsigned*)(kg + (size_t)d * 32768 + ch * 16), (LAS unsigned*)(ldsl + (8 * wid + i) * 1024), 16, 0, 0); }
  const bf16* Q0 = Qm + (size_t)(T0 + 32 * qb0 + r32) * 2048 + h * 256 + 8 * hi;
  bf16x8 q0[16], q1[16];
#pragma unroll
  for (int s = 0; s < 16; ++s) { q0[s] = *reinterpret_cast<const bf16x8*>(Q0 + 16 * s); q1[s] = *reinterpret_cast<const bf16x8*>(Q0 + (size_t)32 * 2048 + 16 * s); }
  asm volatile("s_waitcnt vmcnt(0)" ::: "memory");
  __builtin_amdgcn_s_barrier(); asm volatile("" ::: "memory");
  const unsigned blk = (lane >> 4) & 1u, qq = (lane & 15u) >> 2, pp = lane & 3u;
  const unsigned ldsb = (unsigned)(size_t)ldsl;
  f32x16 acc0 = {}, acc1 = {};
#pragma unroll
  for (int ks = 0; ks < 16; ++ks) {
    const unsigned a0 = ldsb + ktoff(16u * ks + 8u * hi + qq, 4u * kb + 2u * blk + (pp >> 1)) + 8u * (pp & 1u);
    const unsigned a1 = ldsb + ktoff(16u * ks + 8u * hi + 4u + qq, 4u * kb + 2u * blk + (pp >> 1)) + 8u * (pp & 1u);
    s16x4 lo, hi4;
    asm volatile("ds_read_b64_tr_b16 %0, %2\n\tds_read_b64_tr_b16 %1, %3\n\ts_waitcnt lgkmcnt(0)" : "=&v"(lo), "=&v"(hi4) : "v"(a0), "v"(a1) : "memory");
    const bf16x8 a = (bf16x8){lo[0], lo[1], lo[2], lo[3], hi4[0], hi4[1], hi4[2], hi4[3]};
    acc0 = __builtin_amdgcn_mfma_f32_32x32x16_bf16(a, q0[ks], acc0, 0, 0, 0);
    acc1 = __builtin_amdgcn_mfma_f32_32x32x16_bf16(a, q1[ks], acc1, 0, 0, 0);
  }
  bf16* Pf = PP + ((size_t)(bh * 32 + n) * 128) * 128;
  bf16* Pb = Pf + (size_t)1024 * 128 * 128;
#pragma unroll
  for (int t = 0; t < 2; ++t) {
    const int q = 32 * (qb0 + t) + r32;
#pragma unroll
    for (int g = 0; g < 4; ++g) {
      const int k0 = 32 * kb + 8 * g + 4 * hi;
      float vf[4], vb[4];
#pragma unroll
      for (int j = 0; j < 4; ++j) { const int k = k0 + j; const float sc = t ? acc1[4 * g + j] : acc0[4 * g + j];
        vf[j] = (k <= q) ? sc : 0.f;
        vb[j] = (k > q) ? sc : 0.f; }
      u32x2 wf = {cvt_pk_bf16(vf[0], vf[1]), cvt_pk_bf16(vf[2], vf[3])}, wb = {cvt_pk_bf16(vb[0], vb[1]), cvt_pk_bf16(vb[2], vb[3])};
      *reinterpret_cast<u32x2*>(Pf + (size_t)q * 128 + k0) = wf;
      *reinterpret_cast<u32x2*>(Pb + (size_t)q * 128 + k0) = wb;
    }
  }
  asm volatile("s_waitcnt lgkmcnt(0)" ::: "memory"); __builtin_amdgcn_s_barrier(); asm volatile("" ::: "memory");
}

#if defined(CH_WAVE)
#define CSTAMP(seg) do { if (blockIdx.x == 0 && wid == CH_WAVE && lane == 0) { const unsigned now_ = (unsigned)__builtin_amdgcn_s_memrealtime(); volatile unsigned* m_ = (volatile unsigned*)(lds + 159744 + 4 * 450); m_[seg] += now_ - m_[15]; m_[15] = now_; } } while (0)
#else
#define CSTAMP(seg) do { } while (0)
#endif
__device__ __forceinline__ void chain_item(int item, const bf16* Qm, const bf16* KVT, const bf16* PP, bf16* Rf, bf16* Rb, const float* lg2f, const float* lg2b, char* lds) {
  int tid_ = threadIdx.x; asm volatile("" : "+v"(tid_));
  const int tid = tid_, wid = __builtin_amdgcn_readfirstlane(tid >> 6), lane = tid & 63, r32 = lane & 31, hi = lane >> 5;
  const int j = item & 3, dir = (item >> 2) & 1, bh = item >> 3, b = bh >> 3, h = bh & 7;
  const float lg2 = dir ? lg2b[h] : lg2f[h];
  const float cdec = __builtin_amdgcn_exp2f(lg2 * 128.f);
  bf16* Rout = dir ? Rb : Rf;
  const bf16* VTg = KVT + (size_t)(2048 + h * 512 + 128 * j) * 16384;
  const bf16* KTg = KVT + (size_t)(h * 256) * 16384;
  const bf16* PPd = PP + (size_t)dir * 1024 * 128 * 128 + (size_t)(bh * 32) * 128 * 128;
  char* STl = lds + OFF_ST;
  { unsigned z = 0u; asm volatile("" : "+v"(z));
    for (int i = tid; i < ST_BYTES / 16; i += 512) *reinterpret_cast<u32x4*>(STl + i * 16) = (u32x4){z, z, z, z}; }
#define VDMA(T0, buf) do { const char* vg = (const char*)(VTg + (T0)); int l_ = lane; asm volatile("" : "+v"(l_)); _Pragma("unroll") for (int i = 0; i < 4; ++i) { \
      const int v_ = 16 * wid + 4 * i + (l_ >> 4); const unsigned so_ = (unsigned)v_ * 32768u + (unsigned)(((l_ & 15) ^ (v_ & 15)) * 16); \
      __builtin_amdgcn_global_load_lds((const unsigned*)(vg + so_), (LAS unsigned*)(ldsl + OFF_VT + (buf) * VT_BYTES + (4 * wid + i) * 1024), 16, 0, 0); } } while (0)
  LAS unsigned char* ldsl = (LAS unsigned char*)lds;
  { const int n0 = dir ? 31 : 0; VDMA(b * 4096 + n0 * 128, 0); asm volatile("s_waitcnt vmcnt(0)" ::: "memory"); }
#define WGBAR() do { asm volatile("s_waitcnt lgkmcnt(0)" ::: "memory"); __builtin_amdgcn_s_barrier(); asm volatile("" ::: "memory"); } while (0)
#define VSCALE(buf) do { float lq_ = lg2; asm volatile("" : "+v"(lq_)); const int kc_ = 8 * ((tid & 15) ^ ((tid >> 4) & 15)); float kq_[8]; \
      _Pragma("unroll") for (int e = 0; e < 8; ++e) kq_[e] = __builtin_amdgcn_exp2f(dir ? lq_ * (float)(kc_ + e - 128) : -lq_ * (float)(kc_ + e + 1)); \
      _Pragma("unroll") for (int i = 0; i < 4; ++i) { u32x4* p_ = reinterpret_cast<u32x4*>(lds + OFF_VT + (buf) * VT_BYTES + (tid + 512 * i) * 16); const u32x4 x_ = *p_; u32x4 w_; \
        w_.x = cvt_pk_bf16(bf_lo(x_.x) * kq_[0], bf_hi(x_.x) * kq_[1]); w_.y = cvt_pk_bf16(bf_lo(x_.y) * kq_[2], bf_hi(x_.y) * kq_[3]); w_.z = cvt_pk_bf16(bf_lo(x_.z) * kq_[4], bf_hi(x_.z) * kq_[5]); w_.w = cvt_pk_bf16(bf_lo(x_.w) * kq_[6], bf_hi(x_.w) * kq_[7]); \
        *p_ = w_; } } while (0)
  WGBAR();
  VSCALE(0);
  WGBAR();
  if (wid < 4) {
#ifndef RET_NO_Q
    const int qb = wid; int buf = 0;
    bf16x8 pf[8], qf[16];
    const unsigned qlo = (unsigned)(r32 * 2048 + 8 * hi), plo = (unsigned)(r32 * 128 + 8 * hi), rlo = (unsigned)(4 * hi * 4096 + r32);
    { const int n = dir ? 31 : 0; const int T0 = b * 4096 + n * 128;
      const bf16* Qr = Qm + (size_t)(T0 + 32 * qb) * 2048 + h * 256 + qlo; const bf16* Pr = PPd + ((size_t)n * 128 + 32 * qb) * 128 + plo;
#pragma unroll
      for (int s = 0; s < 8; ++s) pf[s] = *reinterpret_cast<const bf16x8*>(Pr + 16 * s);
#pragma unroll
      for (int s = 0; s < 16; ++s) qf[s] = *reinterpret_cast<const bf16x8*>(Qr + 16 * s); }
    const int vrow = r32 * 256 + ((hi ^ (r32 & 1)) << 4), vx = (r32 & 14) << 4, srow = r32 * ST_PITCH + 16 * hi;
    for (int ci = 0; ci < 32; ++ci) {
      const int n = dir ? 31 - ci : ci; const int T0 = b * 4096 + n * 128;
      const int nn = dir ? n - 1 : n + 1; const int T1 = b * 4096 + nn * 128;
      CSTAMP(0);
      if (ci < 31) VDMA(T1, buf ^ 1);
      const char* VTl = lds + OFF_VT + buf * VT_BYTES + vrow; const char* STr = STl + srow;
      f32x16 o[4];
#pragma unroll
      for (int v = 0; v < 4; ++v) o[v] = f32x16{};
      bf16x8 b0[4];
#define RB(dst, t) do { _Pragma("unroll") for (int v = 0; v < 4; ++v) dst[v] = ((t) < 8) ? *reinterpret_cast<const bf16x8*>(VTl + (32 * v) * 256 + ((32 * (t)) ^ vx)) : *reinterpret_cast<const bf16x8*>(STr + (32 * v) * ST_PITCH + 32 * ((t) - 8)); } while (0)
#define RA(t) (((t) < 8) ? pf[(t) & 7] : qf[((t) - 8) & 15])
#pragma unroll
      for (int t = 0; t < 24; ++t) {
        RB(b0, t);
#pragma unroll
        for (int v = 0; v < 4; ++v) o[v] = __builtin_amdgcn_mfma_f32_32x32x16_bf16(RA(t), b0[v], o[v], 0, 0, 0);
        SBAR();
        if (t == 7) CSTAMP(1);
        if (t == 7 && ci < 31) {
          const bf16* Pr = PPd + ((size_t)nn * 128 + 32 * qb) * 128 + plo;
#pragma unroll
          for (int s = 0; s < 8; ++s) pf[s] = *reinterpret_cast<const bf16x8*>(Pr + 16 * s);
          SBAR(); }
      }
#undef RB
#undef RA
      CSTAMP(2);
      if (ci < 31) {
        const bf16* Qr = Qm + (size_t)(T1 + 32 * qb) * 2048 + h * 256 + qlo;
#pragma unroll
        for (int s = 0; s < 16; ++s) qf[s] = *reinterpret_cast<const bf16x8*>(Qr + 16 * s);
        asm volatile("s_waitcnt vmcnt(24)" ::: "memory"); }
      CSTAMP(3);
      WGBAR();
      CSTAMP(4);
      float lgc = lg2; asm volatile("" : "+v"(lgc));
      bf16* rb = Rout + (size_t)(T0 + 32 * qb) * 4096 + h * 512 + 128 * j;
#pragma unroll
      for (int r = 0; r < 16; ++r) { const int q = 32 * qb + crow(r, hi);
        const float qd = __builtin_amdgcn_exp2f(dir ? lgc * (float)(128 - q) : lgc * (float)(q + 1));
        bf16* orow = rb + (size_t)(((r & 3) + 8 * (r >> 2)) * 4096);
#pragma unroll
        for (int v = 0; v < 4; ++v) orow[32 * v + rlo] = f2bf(o[v][r] * qd); }
      if (ci < 31) VSCALE(buf ^ 1);
      CSTAMP(5);
      WGBAR();
      CSTAMP(6);
      buf ^= 1;
    }
#endif
  } else {
#ifndef RET_NO_S
    const int sw = wid - 4; int buf = 0;
    f32x16 st[2][4];
#pragma unroll
    for (int a = 0; a < 2; ++a)
#pragma unroll
      for (int v = 0; v < 4; ++v) st[a][v] = f32x16{};
    u32x4 kr0[8], kr1[8];
    const unsigned klo = (unsigned)(r32 * 16384 + 8 * hi); const bf16* Kl = KTg + (size_t)(64 * sw) * 16384;
    { const int n = dir ? 31 : 0; const bf16* K0 = Kl + b * 4096 + n * 128;
#pragma unroll
      for (int s = 0; s < 4; ++s) { kr0[s] = *reinterpret_cast<const u32x4*>(K0 + 16 * s + klo); kr1[s] = *reinterpret_cast<const u32x4*>(K0 + (size_t)32 * 16384 + 16 * s + klo); } }
    const int vrow = r32 * 256 + ((hi ^ (r32 & 1)) << 4), vx = (r32 & 14) << 4;
    for (int ci = 0; ci < 32; ++ci) {
      const int n = dir ? 31 - ci : ci;
      const int nn = dir ? n - 1 : n + 1; const int T1 = b * 4096 + nn * 128;
      CSTAMP(0);
      const char* VTl = lds + OFF_VT + buf * VT_BYTES + vrow;
      { const bf16* K0 = Kl + b * 4096 + n * 128;
#pragma unroll
        for (int s = 4; s < 8; ++s) { kr0[s] = *reinterpret_cast<const u32x4*>(K0 + 16 * s + klo); kr1[s] = *reinterpret_cast<const u32x4*>(K0 + (size_t)32 * 16384 + 16 * s + klo); } }
      SBAR();
      if (ci < 31) VDMA(T1, buf ^ 1);
      SBAR();
      CSTAMP(1);
#pragma unroll
      for (int s = 0; s < 8; ++s) {
        if (s == 4) CSTAMP(2);
        const bf16x8 f0 = __builtin_bit_cast(bf16x8, kr0[s]), f1 = __builtin_bit_cast(bf16x8, kr1[s]);
#pragma unroll
        for (int v = 0; v < 4; ++v) { const bf16x8 bv = *reinterpret_cast<const bf16x8*>(VTl + (32 * v) * 256 + ((32 * s) ^ vx));
          st[0][v] = __builtin_amdgcn_mfma_f32_32x32x16_bf16(f0, bv, st[0][v], 0, 0, 0);
          st[1][v] = __builtin_amdgcn_mfma_f32_32x32x16_bf16(f1, bv, st[1][v], 0, 0, 0); }
        SBAR();
        if (s == 3 && ci < 31) { const bf16* K0 = Kl + T1;
#pragma unroll
          for (int s2 = 0; s2 < 4; ++s2) { kr0[s2] = *reinterpret_cast<const u32x4*>(K0 + 16 * s2 + klo); kr1[s2] = *reinterpret_cast<const u32x4*>(K0 + (size_t)32 * 16384 + 16 * s2 + klo); }
          SBAR(); }
      }
      CSTAMP(3);
      if (ci < 31) asm volatile("s_waitcnt vmcnt(8)" ::: "memory");
      else asm volatile("s_waitcnt vmcnt(0)" ::: "memory");
      CSTAMP(4);
#pragma unroll
      for (int a = 0; a < 2; ++a)
#pragma unroll
        for (int v = 0; v < 4; ++v) st[a][v] = st[a][v] * cdec;
      CSTAMP(5);
      WGBAR();
      CSTAMP(6);
#pragma unroll
      for (int a = 0; a < 2; ++a)
#pragma unroll
        for (int v = 0; v < 4; ++v)
#pragma unroll
          for (int g = 0; g < 4; ++g) { const int d = 64 * sw + 32 * a + 8 * g + 4 * hi;
            u32x2 w = {cvt_pk_bf16(st[a][v][4 * g + 0], st[a][v][4 * g + 1]), cvt_pk_bf16(st[a][v][4 * g + 2], st[a][v][4 * g + 3])};
            *reinterpret_cast<u32x2*>(STl + (32 * v + r32) * ST_PITCH + d * 2) = w; }
      if (ci < 31) VSCALE(buf ^ 1);
      CSTAMP(7);
      WGBAR();
      CSTAMP(9);
      buf ^= 1;
    }
#endif
  }
  WGBAR();
#undef WGBAR
#undef VDMA
#undef VSCALE
}
}

#ifndef PHMASK
#define PHMASK 0xFFFFFFFFu
#endif
#define PH(k) ((PHMASK >> (k)) & 1u)
#ifndef REPMASK
#define REPMASK 0u
#endif
#define PHASE_OPQ int tid_o = threadIdx.x; asm volatile("" : "+v"(tid_o)); const int ptid = tid_o, plane = tid_o & 63; (void)ptid; (void)plane; int gwp = gw, ngwp = NGW, pbx = blockIdx.x, pvcu = F.vcu, pG = F.G; asm volatile("" : "+s"(gwp), "+s"(ngwp), "+s"(pbx), "+s"(pvcu), "+s"(pG)); (void)gwp; (void)ngwp; (void)pbx; (void)pvcu; (void)pG;
#if REPMASK == 0u
#define PHASE_BEGIN(k) if (PH(k)) { PHASE_OPQ
#else
#define PHASE_BEGIN(k) if (PH(k)) for (int rep_ = 0; rep_ <= (int)((REPMASK >> (k)) & 1u); ++rep_) { if (rep_) xcd_barrier(bar); PHASE_OPQ
#endif
#if defined(STAMP_A) && defined(STAMP_B)
#ifndef STAMP_AMP
#define STAMP_AMP 8
#endif
#define STAMP() do { if (threadIdx.x == 0 && blockIdx.x == 0) { const unsigned n_ = F.MISC[400]; F.MISC[401 + n_] = (unsigned)__builtin_amdgcn_s_memrealtime(); F.MISC[400] = n_ + 1u; } } while (0)
#else
#define STAMP() do { } while (0)
#endif
#define GBAR() do { xcd_barrier(bar); STAMP(); } while (0)
constexpr int NTOK = 16384, SEQ = 4096, DM = 2048, NWAVES = 8;
constexpr float DN_ALPHA = 1.4142135623730951f;
constexpr float LN_EPS = 1e-5f, RMS_EPS = 1e-6f;
constexpr size_t MiB = 1u << 20;
constexpr size_t WS_CTL = 0, CTL_ZERO_BYTES = 1 * MiB;
constexpr int CW_BAR = 4096;
constexpr int CW_CNT = 8192;
constexpr size_t WS_ABIN = 1 * MiB;
constexpr size_t WS_UQ   = 17 * MiB;
constexpr size_t WS_UKV  = WS_UQ + 1536 * 512 * 2;
constexpr size_t WS_ABOUT = WS_UKV + 2048 * 256 * 2;
constexpr size_t WS_CIN  = WS_ABOUT + 8 * MiB;
constexpr size_t WS_COUT = WS_CIN + 48 * MiB;
constexpr size_t WS_PLEG = WS_COUT + 16 * MiB;
constexpr size_t WS_PLEP = WS_PLEG + 18 * MiB;
constexpr size_t WS_TAB  = WS_PLEP + 2 * MiB;
constexpr size_t WS_PB   = WS_TAB + 10 * MiB;
constexpr size_t WS_GU   = WS_PB + 16 * MiB;
constexpr size_t WS_DN   = WS_GU + 128 * MiB;
constexpr size_t WS_XB   = WS_DN + 64 * MiB;
constexpr size_t WS_AR   = WS_XB + 64 * MiB;
static_assert(WS_AR == 393 * MiB + 512 * 1024, "map");
constexpr size_t A_H = WS_AR, A_Q = A_H + 128 * MiB, A_KV = A_Q + 48 * MiB, A_AO = A_KV + 64 * MiB, A_KPE = A_AO + 64 * MiB, A_CQN = A_KPE + 2 * MiB, A_CKVN = A_CQN + 16 * MiB;
constexpr size_t C_HB = WS_AR, C_PROJ = WS_AR + 128 * MiB, C_YB = C_PROJ + 64 * MiB, C_PLE = C_YB + 160 * MiB, C_LOG = C_PLE + 64 * MiB, C_RT = C_LOG + 4 * MiB;
static_assert(C_RT + 2 * MiB <= WS_AR + 704 * MiB, "arena");
constexpr size_t B_Q = WS_AR, B_KVT = B_Q + 64 * MiB, B_G = B_KVT + 192 * MiB, B_PP = B_G + 128 * MiB, B_K = B_PP + 64 * MiB, B_RF = B_K, B_RB = B_RF + 128 * MiB, B_A = WS_AR, WS_END = B_RB + 128 * MiB;
constexpr int MAXSLOT = 40960;
constexpr size_t RT_E = 0, RT_W = RT_E + 16384 * 8, RT_R = RT_W + 16384 * 8, RT_S = RT_R + 16384 * 8, RT_ST = RT_S + 16384 * 8, RT_BC = RT_ST + 40960 * 4;
constexpr int RING_BYTES = 159744, MISC_OFF = RING_BYTES, LDS_BYTES = 163840;
static_assert(ret::RET_LDS <= RING_BYTES && att::ATT_LDS <= RING_BYTES && pg8::STAGE_BYTES <= RING_BYTES, "LDS map");

struct Frame {
    LAS unsigned char* lds; volatile LAS unsigned* MISC; unsigned* ctl;
    int tid, lane, wave, vcu, G;
};
__device__ __forceinline__ unsigned long long ld_ptr(const Frame& F, int k) {
    volatile LAS unsigned* p = F.MISC + 256 + 2 * k; const unsigned lo = __builtin_amdgcn_readfirstlane(p[0]), hi = __builtin_amdgcn_readfirstlane(p[1]);
    return ((unsigned long long)hi << 32) | lo;
}
#define INP(k) ((const float*)(GAS const float*)ld_ptr(F, (k)))
#define WSB() ((unsigned char*)(GAS unsigned char*)ld_ptr(F, 28))
#define OUTP() ((float*)(GAS float*)ld_ptr(F, 27))
struct Args { const float* in[27]; float* out; unsigned char* ws; };

constexpr int TR_WAVE_BYTES = 64 * 68 * 4;
__device__ __forceinline__ void transpose_item(const float* W, int ldw, bf16* WT, int ldt, int k0, int n0, int dst_row0, LAS float* scr, int lane) {
    const float* src = W + (size_t)(k0 + (lane >> 4)) * ldw + n0 + 4 * (lane & 15);
#pragma unroll
    for (int i = 0; i < 16; ++i) { const int kk = 4 * i + (lane >> 4); const f32x4 v = *(const f32x4*)(src + (size_t)(4 * i) * ldw);
        *(LAS f32x4*)(scr + kk * 68 + ((4 * (lane & 15)) ^ (((kk >> 3) & 7) << 2))) = v; }
    LDS_WAIT(); asm volatile("" ::: "memory");
    const int c = lane & 7;
#pragma unroll
    for (int j = 0; j < 8; ++j) { const int n = (lane >> 3) + 8 * j; const LAS float* p = scr + (8 * c) * 68 + (n ^ (c << 2));
        v4u o; o.x = cvt_pk_bf16(p[0 * 68], p[1 * 68]); o.y = cvt_pk_bf16(p[2 * 68], p[3 * 68]); o.z = cvt_pk_bf16(p[4 * 68], p[5 * 68]); o.w = cvt_pk_bf16(p[6 * 68], p[7 * 68]);
        *(v4u*)(WT + (size_t)(dst_row0 + n) * ldt + k0 + 8 * c) = o; }
    LDS_WAIT(); asm volatile("" ::: "memory");
}
__device__ __forceinline__ void transpose_plain(const float* W, int K, int N, bf16* WT, int item, LAS float* scr, int lane) {
    const int nblk = N / 64, kb = item / nblk, nb = item % nblk;
    transpose_item(W, N, WT, K, 64 * kb, 64 * nb, 64 * nb, scr, lane);
}
struct TrItem { const float* src; bf16* dst; int ldw, ldt; };
__device__ __forceinline__ void tr_load(const TrItem& t, f32x4 (&v)[16], int lane) {
    const float* p = t.src + (size_t)(lane >> 4) * t.ldw + 4 * (lane & 15);
#pragma unroll
    for (int i = 0; i < 16; ++i) v[i] = *(const f32x4*)(p + (size_t)(4 * i) * t.ldw);
}
__device__ __forceinline__ void tr_store(const TrItem& t, const f32x4 (&v)[16], LAS float* scr, int lane) {
#pragma unroll
    for (int i = 0; i < 16; ++i) { const int kk = 4 * i + (lane >> 4); *(LAS f32x4*)(scr + kk * 68 + ((4 * (lane & 15)) ^ (((kk >> 3) & 7) << 2))) = v[i]; }
    LDS_WAIT(); asm volatile("" ::: "memory");
    const int c = lane & 7;
#pragma unroll
    for (int j = 0; j < 8; ++j) { const int n = (lane >> 3) + 8 * j; const LAS float* p = scr + (8 * c) * 68 + (n ^ (c << 2));
        v4u o; o.x = cvt_pk_bf16(p[0 * 68], p[1 * 68]); o.y = cvt_pk_bf16(p[2 * 68], p[3 * 68]); o.z = cvt_pk_bf16(p[4 * 68], p[5 * 68]); o.w = cvt_pk_bf16(p[6 * 68], p[7 * 68]);
        *(v4u*)(t.dst + (size_t)n * t.ldt + 8 * c) = o; }
    LDS_WAIT(); asm volatile("" ::: "memory");
}
__device__ __forceinline__ TrItem moe_decode(int it, const float* wg, const float* wu, const float* wd, bf16* GU, bf16* DN) {
    const int which = it >> 13, r = it & 8191, e = r >> 8, q = r & 255; TrItem t;
    if (which < 2) { const int kb = q >> 3, n0 = 64 * (q & 7);
        t.src = (which ? wu : wg) + (size_t)e * 2048 * 512 + (size_t)(64 * kb) * 512 + n0; t.ldw = 512; t.ldt = 2048;
        t.dst = GU + (size_t)(e * 1024 + (n0 >> 7) * 256 + (which ? 128 : 0) + (n0 & 127)) * 2048 + 64 * kb; }
    else { const int kb = q >> 5, n0 = 64 * (q & 31);
        t.src = wd + (size_t)e * 512 * 2048 + (size_t)(64 * kb) * 2048 + n0; t.ldw = 2048; t.ldt = 512; t.dst = DN + (size_t)(e * 2048 + n0) * 512 + 64 * kb; }
    return t;
}
__device__ __forceinline__ void moe_convert_items(int first, int stride, int lane, const float* wg, const float* wu, const float* wd, bf16* GU, bf16* DN, LAS float* scr) {
    f32x4 cur[16], nxt[16]; int it = first;
    if (it >= 3 * 8192) return;
    TrItem tc = moe_decode(it, wg, wu, wd, GU, DN); tr_load(tc, cur, lane);
    for (;;) {
        const int in = it + stride; const bool more = in < 3 * 8192; TrItem tn = tc;
        if (more) { tn = moe_decode(in, wg, wu, wd, GU, DN); tr_load(tn, nxt, lane); }
        tr_store(tc, cur, scr, lane);
        if (!more) break;
#pragma unroll
        for (int i = 0; i < 16; ++i) cur[i] = nxt[i];
        tc = tn; it = in;
    }
}
__device__ __forceinline__ void cvt_rows(const Frame& F, int tid, const float* src, bf16* dst, size_t n8) {
    for (size_t i = (size_t)(F.vcu * 512 + tid); i < n8; i += (size_t)F.G * 512) {
        const f32x4 a = *(const f32x4*)(src + i * 8), b = *(const f32x4*)(src + i * 8 + 4);
        *(u32x4*)(dst + i * 8) = pg8::pack8(a, b); }
}
__device__ __forceinline__ void sincos_acc(int pos, float inv, float& c, float& s) {
    const double a = (double)pos * (double)inv; const double k = __builtin_rint(a * 0.15915494309189535); const float r = (float)(a - k * 6.283185307179586);
    s = sinf(r); c = cosf(r);
}

#define x_in INP(0)
#define p_in INP(1)
#define ab_w_in INP(2)
#define ab_rpb INP(3)
#define ab_q_norm INP(4)
#define ab_w_uq INP(5)
#define ab_kv_norm INP(6)
#define ab_w_ukv INP(7)
#define ab_w_out INP(8)
#define c_w_in INP(9)
#define c_lrf INP(10)
#define c_lrb INP(11)
#define c_w_out INP(12)
#define ln1_g INP(13)
#define ln1_b INP(14)
#define moe_w_group INP(15)
#define moe_b_group INP(16)
#define moe_w_router INP(17)
#define moe_b_router INP(18)
#define moe_w_gate INP(19)
#define moe_w_up INP(20)
#define moe_w_down INP(21)
#define ple_w_proj INP(22)
#define ple_w_gate INP(23)
#define ple_b_gate INP(24)
#define ln2_g INP(25)
#define ln2_b INP(26)
#define W_ABIN ((bf16*)(WSB() + WS_ABIN))
#define W_UQ ((bf16*)(WSB() + WS_UQ))
#define W_UKV ((bf16*)(WSB() + WS_UKV))
#define W_ABOUT ((bf16*)(WSB() + WS_ABOUT))
#define W_CIN ((bf16*)(WSB() + WS_CIN))
#define W_COUT ((bf16*)(WSB() + WS_COUT))
#define W_PLEG ((bf16*)(WSB() + WS_PLEG))
#define W_PLEP ((bf16*)(WSB() + WS_PLEP))
#define T_COSM ((float*)(WSB() + WS_TAB))
#define T_SINM (T_COSM + 4096 * 32)
#define T_COSR (T_COSM + 2 * 4096 * 32)
#define T_SINR (T_COSR + 4096 * 128)
#define T_COSRT (T_COSR + 2 * 4096 * 128)
#define T_SINRT (T_COSR + 3 * 4096 * 128)
#define T_LG (T_COSR + 4 * 4096 * 128)
#define PB ((bf16*)(WSB() + WS_PB))
#define W_GU ((bf16*)(WSB() + WS_GU))
#define W_DN ((bf16*)(WSB() + WS_DN))
#define XB ((bf16*)(WSB() + WS_XB))
#define PRE OUTP()
#define H ((bf16*)(WSB() + A_H))
#define Qb ((bf16*)(WSB() + A_Q))
#define KVb ((bf16*)(WSB() + A_KV))
#define AO ((bf16*)(WSB() + A_AO))
#define KPE ((bf16*)(WSB() + A_KPE))
#define CQN ((bf16*)(WSB() + A_CQN))
#define CKVN ((bf16*)(WSB() + A_CKVN))
#define Qm ((bf16*)(WSB() + B_Q))
#define KVT ((bf16*)(WSB() + B_KVT))
#define Gm ((bf16*)(WSB() + B_G))
#define PP ((bf16*)(WSB() + B_PP))
#define Km ((bf16*)(WSB() + B_K))
#define Rf ((bf16*)(WSB() + B_RF))
#define Rb ((bf16*)(WSB() + B_RB))
#define Am ((bf16*)(WSB() + B_A))
#define PROJ ((bf16*)(WSB() + C_PROJ))
#define HB ((bf16*)(WSB() + C_HB))
#define YB ((bf16*)(WSB() + C_YB))
#define PLE ((bf16*)(WSB() + C_PLE))
#define LOG ((float*)(WSB() + C_LOG))
#define TOK_E ((int*)(WSB() + C_RT + RT_E))
#define TOK_W ((float*)(WSB() + C_RT + RT_W))
#define TOK_R ((int*)(WSB() + C_RT + RT_R))
#define TOK_S ((int*)(WSB() + C_RT + RT_S))
#define SLOT_TOK ((int*)(WSB() + C_RT + RT_ST))
#define BLKCNT ((int*)(WSB() + C_RT + RT_BC))
#define MOE_CONVERT(LAYER) do { int tq_ = threadIdx.x; asm volatile("" : "+v"(tq_)); const int lane_ = tq_ & 63; int g0_ = gw, gs_ = NGW; asm volatile("" : "+s"(g0_), "+s"(gs_)); \
        LAS float* scr_ = (LAS float*)(F.lds + F.wave * TR_WAVE_BYTES); const size_t lo_ = (size_t)(LAYER) * 32 * 2048 * 512; \
        moe_convert_items(g0_, gs_, lane_, moe_w_gate + lo_, moe_w_up + lo_, moe_w_down + lo_, W_GU, W_DN, scr_); \
        __syncthreads(); } while (0)
__global__ void __launch_bounds__(512, 2) fwd_kernel(Args args) {
    extern __shared__ __attribute__((aligned(16))) unsigned char lds[];
    Frame F;
    F.lds = (LAS unsigned char*)lds; F.MISC = (volatile LAS unsigned*)(F.lds + MISC_OFF);
    F.tid = threadIdx.x; F.lane = F.tid & 63; F.wave = __builtin_amdgcn_readfirstlane(F.tid >> 6);
    F.G = gridDim.x; { const int bx = blockIdx.x; F.vcu = (F.G % 8 == 0) ? (bx % 8) * (F.G / 8) + bx / 8 : bx; }
    F.ctl = (unsigned*)(args.ws + WS_CTL);
    for (int u = F.tid; u < (LDS_BYTES - MISC_OFF) / 4; u += 512) ((LAS unsigned*)(F.lds + MISC_OFF))[u] = 0u;
    __syncthreads();
    if (F.tid == 0) {
#pragma unroll
        for (int i = 0; i < 27; ++i) { const unsigned long long v = (unsigned long long)args.in[i]; F.MISC[256 + 2 * i] = (unsigned)v; F.MISC[257 + 2 * i] = (unsigned)(v >> 32); }
        { const unsigned long long v = (unsigned long long)args.out; F.MISC[256 + 54] = (unsigned)v; F.MISC[257 + 54] = (unsigned)(v >> 32); }
        { const unsigned long long v = (unsigned long long)args.ws; F.MISC[256 + 56] = (unsigned)v; F.MISC[257 + 56] = (unsigned)(v >> 32); }
    }
    __syncthreads();
    XcdBarrier bar = xcd_barrier_post(F.ctl + CW_BAR, F.MISC + 8);
    STAMP();
    const int gw = F.vcu * NWAVES + F.wave, NGW = F.G * NWAVES;
    char* ldsg = (char*)lds;


        PHASE_BEGIN(0)
    {
        LAS float* scr = (LAS float*)(F.lds + F.wave * TR_WAVE_BYTES);
        constexpr int I_ABIN = 32 * 61, I_UQ = 8 * 24, I_UKV = 4 * 32, I_ABOUT = 32 * 32, I_CIN = 32 * 192, I_COUT = 64 * 32, I_PLEG = 32 * 32, I_PLEP = 4 * 32;
        constexpr int NIT = I_ABIN + I_UQ + I_UKV + I_ABOUT + I_CIN + I_COUT + 2 * I_PLEG + 2 * I_PLEP;
        moe_convert_items(gwp, ngwp, plane, moe_w_gate, moe_w_up, moe_w_down, W_GU, W_DN, scr);
        for (int it = gwp; it < NIT; it += ngwp) {
            int r = it;
            if (r < I_ABIN) { transpose_plain(ab_w_in, 2048, 3904, W_ABIN, r, scr, plane); continue; } r -= I_ABIN;
            if (r < I_UQ) { transpose_plain(ab_w_uq, 512, 1536, W_UQ, r, scr, plane); continue; } r -= I_UQ;
            if (r < I_UKV) { transpose_plain(ab_w_ukv, 256, 2048, W_UKV, r, scr, plane); continue; } r -= I_UKV;
            if (r < I_ABOUT) { transpose_plain(ab_w_out, 2048, 2048, W_ABOUT, r, scr, plane); continue; } r -= I_ABOUT;
            if (r < I_CIN) { transpose_plain(c_w_in, 2048, 12288, W_CIN, r, scr, plane); continue; } r -= I_CIN;
            if (r < I_COUT) { transpose_plain(c_w_out, 4096, 2048, W_COUT, r, scr, plane); continue; } r -= I_COUT;
            if (r < 2 * I_PLEG) { const int L = r / I_PLEG; transpose_plain(ple_w_gate + (size_t)L * 2048 * 2048, 2048, 2048, W_PLEG + (size_t)L * 2304 * 2048, r % I_PLEG, scr, plane); continue; } r -= 2 * I_PLEG;
            { const int L = r / I_PLEP; transpose_plain(ple_w_proj + (size_t)L * 256 * 2048, 256, 2048, W_PLEP + (size_t)L * 2048 * 256, r % I_PLEP, scr, plane); }
        }
        const size_t gt = (size_t)pvcu * 512 + ptid, GT = (size_t)pG * 512;
        for (size_t i = gt; i < (size_t)192 * 2048 / 8; i += GT) *(u32x4*)(W_ABIN + (size_t)3904 * 2048 + i * 8) = (u32x4){0u, 0u, 0u, 0u};
        for (size_t i = gt; i < (size_t)2 * 220 * 2048 / 8; i += GT) { const size_t L = i / (220 * 2048 / 8), r = i % (220 * 2048 / 8); *(u32x4*)(W_PLEG + (L * 2304 + 2084) * 2048 + r * 8) = (u32x4){0u, 0u, 0u, 0u}; }
        for (size_t i = gt; i < (size_t)2 * 36 * 2048; i += GT) { const int L = (int)(i / (36 * 2048)), r = (int)(i % (36 * 2048)), row = r / 2048, k = r % 2048;
            const float v = row < 4 ? moe_w_group[((size_t)L * 2048 + k) * 4 + row] : moe_w_router[(((size_t)L * 4 + ((row - 4) >> 3)) * 2048 + k) * 8 + ((row - 4) & 7)];
            W_PLEG[((size_t)L * 2304 + 2048 + row) * 2048 + k] = f2bf(v); }
        cvt_rows(F, ptid, x_in, XB, (size_t)NTOK * DM / 8);
        cvt_rows(F, ptid, p_in, PB, (size_t)2 * NTOK * 256 / 8);
        for (size_t i = gt; i < (size_t)4096 * 32; i += GT) { const int s = (int)(i >> 5), f = (int)(i & 31); float c, sn; sincos_acc(s, expf((float)(2 * f) * (-9.210340371976184f / 64.f)), c, sn); T_COSM[i] = c; T_SINM[i] = sn; }
        for (size_t i = gt; i < (size_t)4096 * 128; i += GT) { const int s = (int)(i >> 7), f = (int)(i & 127); float c, sn; sincos_acc(s, expf((float)(2 * f) * (-9.210340371976184f / 256.f)), c, sn);
            T_COSR[i] = c; T_SINR[i] = sn; T_COSRT[(size_t)f * 4096 + s] = c; T_SINRT[(size_t)f * 4096 + s] = sn; }
        if (gt < 16) { const float lr = gt < 8 ? c_lrf[gt] : c_lrb[gt - 8]; T_LG[gt] = log1pf(-expf(lr)) * 1.4426950408889634f; }
    }
        }
    GBAR();

#pragma unroll 1
    for (int L = 0; L < 2; ++L) {
        if (L == 0) {
        PHASE_BEGIN(1)
#if defined(GEMM_STAMP)
            if (GEMM_STAMP == 1) { if (threadIdx.x == 0) { F.MISC[450 + 14] = 1u; F.MISC[450 + 15] = (unsigned)__builtin_amdgcn_s_memrealtime(); } __syncthreads(); }
#endif
            { pg8::DenseOrder S{(const char*)XB, (const char*)W_ABIN, 2048, 64, 16, pG, pbx, 1 << 30, 0}; pg8::EpiPlain E{H, 4096};
              pg8::gemm_phase<pg8::EpiPlain, pg8::DenseOrder, true, false>(F.lds, 2048, S, E); }
        }
            GBAR();
#if defined(GEMM_STAMP)
            if (threadIdx.x == 0) F.MISC[450 + 14] = 0u;
#endif
        PHASE_BEGIN(2)
            for (int m = gwp; m < NTOK; m += ngwp) {
                const bf16* hr = H + (size_t)m * 4096;
                { const u32x4 w = *(const u32x4*)(hr + 3072 + 8 * plane); float v[8] = {bf_lo(w.x), bf_hi(w.x), bf_lo(w.y), bf_hi(w.y), bf_lo(w.z), bf_hi(w.z), bf_lo(w.w), bf_hi(w.w)};
                  float ss = 0.f;
#pragma unroll
                  for (int j = 0; j < 8; ++j) ss += v[j] * v[j];
                  const float rs = 1.0f / sqrtf(wave_sum(ss, plane) * (1.f / 512.f) + RMS_EPS);
                  const f32x4 g0 = *(const f32x4*)(ab_q_norm + 8 * plane), g1 = *(const f32x4*)(ab_q_norm + 8 * plane + 4);
                  const f32x4 o0 = {v[0] * rs * g0[0], v[1] * rs * g0[1], v[2] * rs * g0[2], v[3] * rs * g0[3]}, o1 = {v[4] * rs * g1[0], v[5] * rs * g1[1], v[6] * rs * g1[2], v[7] * rs * g1[3]};
                  *(u32x4*)(CQN + (size_t)m * 512 + 8 * plane) = pg8::pack8(o0, o1); }
                { const u32x2 w = *(const u32x2*)(hr + 3584 + 4 * plane); float v[4] = {bf_lo(w.x), bf_hi(w.x), bf_lo(w.y), bf_hi(w.y)};
                  const float ss = v[0] * v[0] + v[1] * v[1] + v[2] * v[2] + v[3] * v[3];
                  const float rs = 1.0f / sqrtf(wave_sum(ss, plane) * (1.f / 256.f) + RMS_EPS);
                  const f32x4 g0 = *(const f32x4*)(ab_kv_norm + 4 * plane);
                  u32x2 o; o.x = cvt_pk_bf16(v[0] * rs * g0[0], v[1] * rs * g0[1]); o.y = cvt_pk_bf16(v[2] * rs * g0[2], v[3] * rs * g0[3]);
                  *(u32x2*)(CKVN + (size_t)m * 256 + 4 * plane) = o; }
                { const int i = plane & 31, s = m & 4095; const float x1 = bf2f(hr[3840 + i]), x2 = bf2f(hr[3872 + i]); const float c = T_COSM[s * 32 + i], sn = T_SINM[s * 32 + i];
                  KPE[(size_t)m * 64 + plane] = f2bf(plane < 32 ? x1 * c - x2 * sn : x2 * c + x1 * sn); }
            }
        }
            GBAR();
        PHASE_BEGIN(3)
            { pg8::DenseOrder S{(const char*)CQN, (const char*)W_UQ, 512, 64, 6, pG, pbx, 1 << 30, 0}; pg8::EpiPlain E{Qb, 1536};
              pg8::gemm_phase<pg8::EpiPlain, pg8::DenseOrder, true, false>(F.lds, 512, S, E); }
            { pg8::DenseOrder S{(const char*)CKVN, (const char*)W_UKV, 256, 64, 8, pG, pbx, 1 << 30, 0}; pg8::EpiPlain E{KVb, 2048};
              pg8::gemm_phase<pg8::EpiPlain, pg8::DenseOrder, true, false>(F.lds, 256, S, E); }
        }
            GBAR();
        PHASE_BEGIN(4)
            for (int rep2_ = 0; rep2_ <= (int)((REPMASK >> 20) & 1u); ++rep2_) for (int it = pvcu; it < 512; it += pG) {
                const int bh = it >> 4, qb = it & 15, b = bh >> 3, h = bh & 7; const size_t t0 = (size_t)b * 4096 + qb * 256;
                att::AttnArgs A; A.Qp = Qb + t0 * 1536 + h * 192; A.Kp = KVb + (size_t)b * 4096 * 2048 + h * 256; A.Vp = A.Kp + 128;
                A.Pp = KPE + (size_t)b * 4096 * 64; A.Op = AO + t0 * 2048 + 1024 + h * 128; A.cosM = T_COSM; A.sinM = T_SINM; A.s0 = qb * 256; A.NT = 64; A.kr0 = 0; A.rg = 0;
                att::attn_item<0>(A, ldsg);
            }
            for (int rep2_ = 0; rep2_ <= (int)((REPMASK >> 21) & 1u); ++rep2_) for (int it = pvcu; it < 512; it += pG) {
                const int bh = it >> 4, rg = it & 15, b = bh >> 3, h = bh & 7; const size_t t0 = (size_t)b * 4096 + rg * 256;
                int klo = min(max(4 * rg - 4, 0), 56), khi = min(max(4 * rg - 1, 0), 56) + 7;
                if ((khi - klo + 1) & 1) { if (khi < 63) ++khi; else --klo; }
                for (int i = ptid; i < 465; i += 512) ((float*)(ldsg + att::OFF_BIAS))[i] = ab_rpb[h * 465 + i] * 11.313708498984761f;
                att::AttnArgs A; A.Qp = H + t0 * 4096 + h * 128; A.Kp = H + ((size_t)b * 4096 + klo * 64) * 4096 + 1024 + h * 128; A.Vp = A.Kp + 1024;
                A.Pp = nullptr; A.Op = AO + t0 * 2048 + h * 128; A.cosM = nullptr; A.sinM = nullptr; A.s0 = 0; A.NT = khi - klo + 1; A.kr0 = klo; A.rg = rg;
                att::attn_item<1>(A, ldsg);
            }
        }
            GBAR();
        } else {
        PHASE_BEGIN(6)
            { pg8::DenseOrder S{(const char*)XB, (const char*)W_CIN, 2048, 64, 24, pG, pbx, 8, 24}; pg8::EpiCinN E{Qm, Gm, T_COSR, T_SINR};
              pg8::gemm_phase<pg8::EpiCinN, pg8::DenseOrder, true, false>(F.lds, 2048, S, E); }
            { pg8::DenseOrder S{(const char*)(W_CIN + (size_t)2048 * 2048), (const char*)XB, 2048, 24, 64, pG, pbx, 1 << 30, 0}; pg8::EpiCinT E{KVT, T_COSRT, T_SINRT};
              pg8::gemm_phase<pg8::EpiCinT, pg8::DenseOrder, true, false>(F.lds, 2048, S, E); }
        }
            GBAR();
        PHASE_BEGIN(7)
            for (int it = pvcu; it < 1024; it += pG) ret::pprime_item(it, Qm, KVT, PP, T_LG, T_LG + 8, ldsg);
            __syncthreads();
#ifdef STAMP_MID_B2
            STAMP();
#endif
        }
            GBAR();
        PHASE_BEGIN(8)
            if (pvcu & 1) MOE_CONVERT(1);
            for (int it = pvcu; it < 256; it += pG) ret::chain_item(it, Qm, KVT, PP, Rf, Rb, T_LG, T_LG + 8, ldsg);
            if (!(pvcu & 1)) MOE_CONVERT(1);
        }
            GBAR();
        PHASE_BEGIN(9)
            for (int u = gwp; u < NTOK * 8; u += 4 * ngwp) {
                u32x4 a[4], bq[4], gq[4]; size_t off[4];
#pragma unroll
                for (int r = 0; r < 4; ++r) { const int uu = u + r * ngwp; off[r] = (size_t)(uu >> 3) * 4096 + (uu & 7) * 512 + 8 * plane;
                    a[r] = *(const u32x4*)(Rf + off[r]); bq[r] = *(const u32x4*)(Rb + off[r]); gq[r] = *(const u32x4*)(Gm + off[r]); }
#pragma unroll
                for (int r = 0; r < 4; ++r) {
                    float rr[8] = {bf_lo(a[r].x) + bf_lo(bq[r].x), bf_hi(a[r].x) + bf_hi(bq[r].x), bf_lo(a[r].y) + bf_lo(bq[r].y), bf_hi(a[r].y) + bf_hi(bq[r].y), bf_lo(a[r].z) + bf_lo(bq[r].z), bf_hi(a[r].z) + bf_hi(bq[r].z), bf_lo(a[r].w) + bf_lo(bq[r].w), bf_hi(a[r].w) + bf_hi(bq[r].w)};
                    const float g[8] = {bf_lo(gq[r].x), bf_hi(gq[r].x), bf_lo(gq[r].y), bf_hi(gq[r].y), bf_lo(gq[r].z), bf_hi(gq[r].z), bf_lo(gq[r].w), bf_hi(gq[r].w)};
                    float s = 0.f;
#pragma unroll
                    for (int j = 0; j < 8; ++j) s += rr[j];
                    const float mean = wave_sum(s, plane) * (1.f / 512.f); float s2 = 0.f;
#pragma unroll
                    for (int j = 0; j < 8; ++j) { rr[j] -= mean; s2 += rr[j] * rr[j]; }
                    const float rstd = 1.0f / sqrtf(wave_sum(s2, plane) * (1.f / 512.f) + LN_EPS);
                    f32x4 o0, o1;
#pragma unroll
                    for (int j = 0; j < 4; ++j) { o0[j] = g[j] * sigmoidf_(g[j]) * rr[j] * rstd; o1[j] = g[4 + j] * sigmoidf_(g[4 + j]) * rr[4 + j] * rstd; }
                    *(u32x4*)(Am + off[r]) = pg8::pack8(o0, o1);
                }
            }
        }
            GBAR();
        }
        PHASE_BEGIN(5)
        { pg8::DenseOrder S{(const char*)(L ? Am : AO), (const char*)(L ? W_COUT : W_ABOUT), L ? 4096 : 2048, 64, 8, pG, pbx, 1 << 30, 0}; pg8::EpiPre E{PRE, XB, DN_ALPHA};
          pg8::gemm_phase<pg8::EpiPre, pg8::DenseOrder, true, false>(F.lds, L ? 4096 : 2048, S, E); }
        { pg8::DenseOrder S{(const char*)(PB + (size_t)L * NTOK * 256), (const char*)(W_PLEP + (size_t)L * 2048 * 256), 256, 64, 8, pG, pbx, 1 << 30, 0}; pg8::EpiPlain E{PROJ, 2048};
          pg8::gemm_phase<pg8::EpiPlain, pg8::DenseOrder, true, false>(F.lds, 256, S, E); }
        }
        GBAR();
        PHASE_BEGIN(11)
        { int tid_q = threadIdx.x; asm volatile("" : "+v"(tid_q)); const int plane = tid_q & 63; int gwp = gw, ngwp = NGW; asm volatile("" : "+s"(gwp), "+s"(ngwp));
        for (int m = gwp; m < NTOK; m += 2 * ngwp) {
            f32x4 v[2][8]; float s[2] = {0.f, 0.f};
#pragma unroll
            for (int r = 0; r < 2; ++r) { const f32x4* xr = (const f32x4*)(PRE + (size_t)(m + r * ngwp) * DM) + plane;
#pragma unroll
                for (int j = 0; j < 8; ++j) v[r][j] = xr[64 * j]; }
#pragma unroll
            for (int r = 0; r < 2; ++r)
#pragma unroll
                for (int j = 0; j < 8; ++j) s[r] += (v[r][j][0] + v[r][j][1]) + (v[r][j][2] + v[r][j][3]);
            const float mean[2] = {wave_sum(s[0], plane) * (1.f / DM), wave_sum(s[1], plane) * (1.f / DM)}; float s2[2] = {0.f, 0.f};
#pragma unroll
            for (int r = 0; r < 2; ++r)
#pragma unroll
                for (int j = 0; j < 8; ++j) { v[r][j] = v[r][j] - mean[r]; s2[r] += (v[r][j][0] * v[r][j][0] + v[r][j][1] * v[r][j][1]) + (v[r][j][2] * v[r][j][2] + v[r][j][3] * v[r][j][3]); }
            const float rstd[2] = {1.0f / sqrtf(wave_sum(s2[0], plane) * (1.f / DM) + LN_EPS), 1.0f / sqrtf(wave_sum(s2[1], plane) * (1.f / DM) + LN_EPS)};
            const f32x4* gr = (const f32x4*)(ln1_g + L * DM) + plane; const f32x4* br = (const f32x4*)(ln1_b + L * DM) + plane;
#pragma unroll
            for (int j = 0; j < 8; ++j) { const f32x4 g = gr[64 * j], bb = br[64 * j];
#pragma unroll
                for (int r = 0; r < 2; ++r) { const f32x4 y = v[r][j] * rstd[r] * g + bb; u32x2 w; w.x = cvt_pk_bf16(y[0], y[1]); w.y = cvt_pk_bf16(y[2], y[3]); ((u32x2*)(XB + (size_t)(m + r * ngwp) * DM) + plane)[64 * j] = w; } }
        } }
        }
        GBAR();
        PHASE_BEGIN(12)
        { pg8::DenseOrder S{(const char*)XB, (const char*)(W_PLEG + (size_t)L * 2304 * 2048), 2048, 64, 9, pG, pbx, 1 << 30, 0}; pg8::EpiPle E{PLE, PROJ, ple_b_gate + L * DM, LOG};
          pg8::gemm_phase<pg8::EpiPle, pg8::DenseOrder, true, false>(F.lds, 2048, S, E); }
        }
        GBAR();
        PHASE_BEGIN(13)
        if (ptid < 64) {
            const int n = pvcu * 64 + ptid;
            const float* lg = LOG + (size_t)n * 64;
            float gl[4]; int gi = 0;
#pragma unroll
            for (int g = 0; g < 4; ++g) gl[g] = lg[g] + moe_b_group[L * 4 + g];
            float gm = gl[0];
#pragma unroll
            for (int g = 1; g < 4; ++g) if (gl[g] > gm) { gm = gl[g]; gi = g; }
            float gs = 0.f;
#pragma unroll
            for (int g = 0; g < 4; ++g) gs += fast_exp(gl[g] - gm);
            const float pg = 1.0f / gs;
            float el[8];
#pragma unroll
            for (int e = 0; e < 8; ++e) el[e] = lg[4 + gi * 8 + e] + moe_b_router[(L * 4 + gi) * 8 + e];
            int i0 = 0; float m0 = el[0];
#pragma unroll
            for (int e = 1; e < 8; ++e) if (el[e] > m0) { m0 = el[e]; i0 = e; }
            int i1 = -1; float m1 = -3.0e38f;
#pragma unroll
            for (int e = 0; e < 8; ++e) if (e != i0 && el[e] > m1) { m1 = el[e]; i1 = e; }
            float one = 1.0f; asm volatile("" : "+v"(one));
            const float t1 = fast_exp(m1 - m0), den = one / (one + t1);
            const int e0 = gi * 8 + i0, e1 = gi * 8 + i1;
            int r0 = 0, r1 = 0, mycnt = 0; const unsigned long long ltm = (1ull << ptid) - 1ull;
#pragma unroll 1
            for (int e = 0; e < 32; ++e) {
                const unsigned long long b0 = __ballot(e0 == e), b1 = __ballot(e1 == e);
                const int below = __popcll(b0 & ltm) + __popcll(b1 & ltm);
                if (e0 == e) r0 = below; if (e1 == e) r1 = below;
                if (ptid == e) mycnt = __popcll(b0) + __popcll(b1);
            }
            TOK_E[2 * n] = e0; TOK_E[2 * n + 1] = e1; TOK_W[2 * n] = pg * den; TOK_W[2 * n + 1] = pg * t1 * den; TOK_R[2 * n] = r0; TOK_R[2 * n + 1] = r1;
            if (ptid < 32) BLKCNT[pvcu * 32 + ptid] = mycnt;
        }
        }
        GBAR();
        volatile LAS int* EOFF = (volatile LAS int*)(F.MISC + 16);
        PHASE_BEGIN(14)
        { volatile LAS int* red = (volatile LAS int*)F.lds;
          const int e = ptid & 31, grp = ptid >> 5; int tot = 0, bel = 0;
          for (int b2 = grp; b2 < pG; b2 += 16) { const int c = BLKCNT[b2 * 32 + e]; tot += c; bel += (b2 < pvcu) ? c : 0; }
          red[ptid] = tot; red[512 + ptid] = bel;
          __syncthreads();
          if (ptid < 32) { int t = 0, q = 0; for (int g = 0; g < 16; ++g) { t += red[g * 32 + ptid]; q += red[512 + g * 32 + ptid]; } red[1024 + ptid] = t; red[1056 + ptid] = q; }
          __syncthreads();
          if (ptid == 0) { int acc = 0; for (int q = 0; q < 32; ++q) { EOFF[q] = acc; acc += (red[1024 + q] + 255) & ~255; } EOFF[32] = acc; }
          __syncthreads();
          if (ptid < 64) { const int n = pvcu * 64 + ptid;
#pragma unroll
            for (int k = 0; k < 2; ++k) { const int ee = TOK_E[2 * n + k]; const int slot = EOFF[ee] + red[1056 + ee] + TOK_R[2 * n + k]; SLOT_TOK[slot] = n; TOK_S[2 * n + k] = slot; } }
          for (int ee = pvcu; ee < 32; ee += pG) { const int c = red[1024 + ee]; const int pe = (c + 255) & ~255;
            for (int i = c + ptid; i < pe; i += 512) SLOT_TOK[EOFF[ee] + i] = 0; }
          __syncthreads();
        }
        }
        GBAR();
        const int ntiles = EOFF[32] >> 8;
        PHASE_BEGIN(15)
        {
            struct MoeGU { const char* A; const char* Bt; const int* slot_tok; volatile LAS int* eoff; int nun, G, c;
                __device__ __forceinline__ bool next(int i, pg8::Unit& u) const { const long Lq = (long)i * G + c; if (Lq >= nun) return false; const int t = (int)(Lq >> 2), pn = (int)(Lq & 3);
                    int e = 0;
#pragma unroll 1
                    for (int q = 1; q < 32; ++q) if (eoff[q] <= t * 256) e = q;
                    u.pm = t; u.pn = pn; u.a = A; u.b = Bt + ((size_t)e * 1024 + pn * 256) * 2048 * 2; return true; }
                __device__ __forceinline__ void rows(const pg8::Unit& u, int R, int C, unsigned (&o0)[2], unsigned (&o1)[2]) const {
                    int Ro = R; asm volatile("" : "+v"(Ro));
                    const int* st = slot_tok + u.pm * 256 + Ro;
                    o0[0] = (unsigned)st[0] * 4096u + (unsigned)C * 2u; o0[1] = (unsigned)st[64] * 4096u + (unsigned)C * 2u; o1[0] = (unsigned)st[128] * 4096u + (unsigned)C * 2u; o1[1] = (unsigned)st[192] * 4096u + (unsigned)C * 2u; }
            } S{(const char*)XB, (const char*)W_GU, SLOT_TOK, EOFF, ntiles * 4, pG, pvcu};
            pg8::EpiGU E{HB};
            pg8::gemm_phase<pg8::EpiGU, MoeGU, true, true>(F.lds, 2048, S, E);
        }
        }
        GBAR();
        PHASE_BEGIN(16)
        {
            struct MoeDN { const char* A; const char* Bt; volatile LAS int* eoff; int nun, G, c;
                __device__ __forceinline__ bool next(int i, pg8::Unit& u) const { const long Lq = (long)i * G + c; if (Lq >= nun) return false; const int t = (int)(Lq >> 3), pn = (int)(Lq & 7);
                    int e = 0;
#pragma unroll 1
                    for (int q = 1; q < 32; ++q) if (eoff[q] <= t * 256) e = q;
                    u.pm = t; u.pn = pn; u.a = A + (size_t)t * 256 * 512 * 2; u.b = Bt + ((size_t)e * 2048 + pn * 256) * 512 * 2; return true; }
                __device__ __forceinline__ void rows(const pg8::Unit&, int, int, unsigned (&)[2], unsigned (&)[2]) const {}
            } S{(const char*)HB, (const char*)W_DN, EOFF, ntiles * 8, pG, pvcu};
            pg8::EpiPlain E{YB, 2048};
            pg8::gemm_phase<pg8::EpiPlain, MoeDN, true, false>(F.lds, 512, S, E);
        }
        }
        GBAR();
        PHASE_BEGIN(17)
        for (int m = gwp; m < NTOK; m += ngwp) {
            const int s0 = TOK_S[2 * m], s1 = TOK_S[2 * m + 1]; const float w0 = TOK_W[2 * m], w1 = TOK_W[2 * m + 1];
            const u32x4* xr = (const u32x4*)(XB + (size_t)m * DM) + plane; const u32x4* y0 = (const u32x4*)(YB + (size_t)s0 * DM) + plane; const u32x4* y1 = (const u32x4*)(YB + (size_t)s1 * DM) + plane;
            const u32x4* pr = (const u32x4*)(PLE + (size_t)m * DM) + plane;
            float v[4][8]; float s = 0.f;
#pragma unroll
            for (int j = 0; j < 4; ++j) { const u32x4 a = xr[64 * j], b0 = y0[64 * j], b1 = y1[64 * j], c = pr[64 * j];
                const unsigned aw[4] = {a.x, a.y, a.z, a.w}, b0w[4] = {b0.x, b0.y, b0.z, b0.w}, b1w[4] = {b1.x, b1.y, b1.z, b1.w}, cw[4] = {c.x, c.y, c.z, c.w};
#pragma unroll
                for (int q = 0; q < 4; ++q) { v[j][2 * q] = DN_ALPHA * bf_lo(aw[q]) + w0 * bf_lo(b0w[q]) + w1 * bf_lo(b1w[q]) + bf_lo(cw[q]); v[j][2 * q + 1] = DN_ALPHA * bf_hi(aw[q]) + w0 * bf_hi(b0w[q]) + w1 * bf_hi(b1w[q]) + bf_hi(cw[q]);
                    s += v[j][2 * q] + v[j][2 * q + 1]; } }
            const float mean = wave_sum(s, plane) * (1.f / DM); float s2 = 0.f;
#pragma unroll
            for (int j = 0; j < 4; ++j)
#pragma unroll
                for (int q = 0; q < 8; ++q) { v[j][q] -= mean; s2 += v[j][q] * v[j][q]; }
            const float rstd = 1.0f / sqrtf(wave_sum(s2, plane) * (1.f / DM) + LN_EPS);
            u32x4* ox = (u32x4*)(XB + (size_t)m * DM) + plane;
#pragma unroll
            for (int j = 0; j < 4; ++j) { const int c0 = 512 * j + 8 * plane;
                const f32x4 g0 = *(const f32x4*)(ln2_g + L * DM + c0), g1 = *(const f32x4*)(ln2_g + L * DM + c0 + 4), b0 = *(const f32x4*)(ln2_b + L * DM + c0), b1 = *(const f32x4*)(ln2_b + L * DM + c0 + 4);
                f32x4 y0v, y1v;
#pragma unroll
                for (int q = 0; q < 4; ++q) { y0v[q] = v[j][q] * rstd * g0[q] + b0[q]; y1v[q] = v[j][4 + q] * rstd * g1[q] + b1[q]; }
                if (L == 1) { *(f32x4*)(OUTP() + (size_t)m * DM + c0) = y0v; *(f32x4*)(OUTP() + (size_t)m * DM + c0 + 4) = y1v; }
                else ox[64 * j] = pg8::pack8(y0v, y1v); }
        }
        }
        if (L == 0) GBAR();
    }
#if defined(STAMP_A) && defined(STAMP_B)
    STAMP();
#if defined(CH_WAVE) || defined(GEMM_STAMP)
    if (threadIdx.x == 0 && blockIdx.x == 0) { const unsigned dt = F.MISC[450 + CH_SEG]; const unsigned long long t0 = __builtin_amdgcn_s_memrealtime();
#else
    if (threadIdx.x == 0 && blockIdx.x == 0) { const unsigned dt = F.MISC[401 + STAMP_B] - F.MISC[401 + STAMP_A]; const unsigned long long t0 = __builtin_amdgcn_s_memrealtime();
#endif
        while (__builtin_amdgcn_s_memrealtime() - t0 < (unsigned long long)dt * STAMP_AMP) __builtin_amdgcn_s_sleep(32); }
#endif
}

extern "C" void kernel_launch(void* const* d_in, const int* in_sizes, int n_in, void* d_out, int out_size, void* d_ws, size_t ws_size, hipStream_t stream) {
    static int grid = 0;
    if (grid == 0) {
        if (n_in != 27 || out_size != NTOK * DM || ws_size < WS_END) { fprintf(stderr, "kernel_launch: unexpected shapes (n_in %d out %d ws %zu need %zu)\n", n_in, out_size, ws_size, (size_t)WS_END); grid = -1; return; }
        int dev = 0, cus = 0;
        if (hipGetDevice(&dev) != hipSuccess || hipDeviceGetAttribute(&cus, hipDeviceAttributeMultiprocessorCount, dev) != hipSuccess) { grid = -1; return; }
        if (hipFuncSetAttribute((const void*)fwd_kernel, hipFuncAttributeMaxDynamicSharedMemorySize, LDS_BYTES) != hipSuccess) { grid = -1; return; }
        if (cus < 256) { fprintf(stderr, "kernel_launch: needs 256 CUs\n"); grid = -1; return; }
        grid = 256;
    }
    if (grid < 0) return;
    (void)hipMemsetAsync((char*)d_ws + WS_CTL, 0, CTL_ZERO_BYTES, stream);
    Args a{};
    for (int i = 0; i < 27; ++i) a.in[i] = (const float*)d_in[i];
    a.out = (float*)d_out; a.ws = (unsigned char*)d_ws;
    hipLaunchKernelGGL(fwd_kernel, dim3(grid), dim3(512), LDS_BYTES, stream, a);
}
```

```cpp
#include <hip/hip_runtime.h>
#include <cstdio>
#include <cstdint>

#define GAS __attribute__((address_space(1)))
#define LAS __attribute__((address_space(3)))
typedef unsigned short bf16;
typedef unsigned short bf16_t;
typedef short bf16x8 __attribute__((ext_vector_type(8)));
typedef short s16x4 __attribute__((ext_vector_type(4)));
typedef float f32x4 __attribute__((ext_vector_type(4)));
typedef float f32x2 __attribute__((ext_vector_type(2)));
typedef float f32x8 __attribute__((ext_vector_type(8)));
typedef float f32x16 __attribute__((ext_vector_type(16)));
typedef unsigned u32x4 __attribute__((ext_vector_type(4)));
typedef unsigned u32x2 __attribute__((ext_vector_type(2)));
typedef unsigned v4u __attribute__((ext_vector_type(4)));

#define LDS_WAIT() asm volatile("s_waitcnt lgkmcnt(0)" ::: "memory")
#define VM_WAIT() asm volatile("s_waitcnt vmcnt(0)" ::: "memory")
#define SBAR() __builtin_amdgcn_sched_barrier(0)

__device__ __forceinline__ unsigned cvt_pk_bf16(float lo, float hi) { unsigned r; asm volatile("v_cvt_pk_bf16_f32 %0, %1, %2" : "=v"(r) : "v"(lo), "v"(hi)); return r; }
__device__ __forceinline__ float bf_lo(unsigned w) { return __uint_as_float(w << 16); }
__device__ __forceinline__ float bf_hi(unsigned w) { return __uint_as_float(w & 0xffff0000u); }
__device__ __forceinline__ float bf2f(bf16 h) { return __uint_as_float(((unsigned)h) << 16); }
__device__ __forceinline__ bf16 f2bf(float f) { return (bf16)(cvt_pk_bf16(f, 0.f) & 0xffffu); }
__device__ __forceinline__ float dpp_add(float v, const int ctrl, const int row_mask) { return v; }
#define DPP_ADD(v, ctrl, rmask) ((v) + __int_as_float(__builtin_amdgcn_update_dpp(0, __float_as_int(v), (ctrl), (rmask), 0xF, false)))
__device__ __forceinline__ float wave_sum(float v, int) {
    v = DPP_ADD(v, 0xB1, 0xF);
    v = DPP_ADD(v, 0x4E, 0xF);
    v = DPP_ADD(v, 0x141, 0xF);
    v = DPP_ADD(v, 0x140, 0xF);
    v = DPP_ADD(v, 0x142, 0xA);
    v = DPP_ADD(v, 0x143, 0xC);
    return __int_as_float(__builtin_amdgcn_readlane(__float_as_int(v), 63));
}
__device__ __forceinline__ float fast_exp(float x) { return __builtin_amdgcn_exp2f(x * 1.4426950408889634f); }
__device__ __forceinline__ float sigmoidf_(float x) { return __builtin_amdgcn_rcpf(1.0f + fast_exp(-x)); }

#define XB_TMO      128
#define XB_XCNT(j)  (256  + 64 * (j))
#define XB_XSUB(j)  (1280 + 64 * (j))
#define XB_XGEN(j)  (2304 + 64 * (j))
#define XB_TOP      3328
#define XB_TOPGEN   3392
#define XCD_BAR_WORDS 3456
#define XB_SPIN_CAP (1u << 18)

__device__ __forceinline__ unsigned xb_ld(unsigned* p)              { return __hip_atomic_load(p, __ATOMIC_RELAXED, __HIP_MEMORY_SCOPE_AGENT); }
__device__ __forceinline__ unsigned xb_add(unsigned* p, unsigned v) { return __hip_atomic_fetch_add(p, v, __ATOMIC_RELAXED, __HIP_MEMORY_SCOPE_AGENT); }
__device__ __forceinline__ unsigned xb_xcc_id() { return (unsigned)__builtin_amdgcn_s_getreg((3 << 11) | 20) & 0xFu; }
#define XB_SPIN(cond, bar) do { unsigned _sp = 0; while (cond) { __builtin_amdgcn_s_sleep(1); \
    if ((++_sp & 255u) == 0u) { if (xb_ld(&(bar)[XB_TMO])) break; if (_sp > XB_SPIN_CAP) { atomicAdd(&(bar)[XB_TMO], 1u); break; } } } } while (0)

struct XcdBarrier { unsigned* bar; unsigned x; volatile LAS unsigned* st; };

__device__ __forceinline__ XcdBarrier xcd_barrier_post(unsigned* bar, volatile LAS unsigned* st) {
    XcdBarrier b; b.bar = bar; b.x = xb_xcc_id(); b.st = st;
    if (threadIdx.x == 0) (void)xb_add(&bar[XB_XCNT(b.x)], 1u);
    return b;
}
__device__ __forceinline__ void xcd_barrier_complete(unsigned* bar, unsigned x, unsigned& nloc, unsigned& nx) {
    const unsigned G = gridDim.x * gridDim.y * gridDim.z;
    unsigned sum, cnt, mine, sp = 0u;
    for (;;) {
        sum = 0u; cnt = 0u; mine = 0u;
#pragma unroll
        for (unsigned j = 0; j < 16; ++j) { const unsigned c = xb_ld(&bar[XB_XCNT(j)]); sum += c; cnt += (c > 0u) ? 1u : 0u; mine = (j == x) ? c : mine; }
        if (sum == G) break;
        __builtin_amdgcn_s_sleep(1);
        if ((++sp & 255u) == 0u) { if (xb_ld(&bar[XB_TMO])) break; if (sp > XB_SPIN_CAP) { atomicAdd(&bar[XB_TMO], 1u); break; } }
    }
    nloc = mine > 0u ? mine : 1u; nx = cnt > 0u ? cnt : 1u;
}
__device__ __forceinline__ void xcd_barrier(const XcdBarrier& b) {
    asm volatile("s_waitcnt vmcnt(0)" ::: "memory");
    __syncthreads();
    if (threadIdx.x == 0) {
        unsigned* bar = b.bar; asm volatile("" : "+s"(bar));
        __builtin_amdgcn_s_waitcnt(0);
        unsigned nloc = b.st[0], nx = b.st[1]; unsigned bx = b.x; asm volatile("" : "+s"(bx));
        if (nloc == 0u) { xcd_barrier_complete(bar, bx, nloc, nx); b.st[0] = nloc; b.st[1] = nx; }
        const unsigned old = xb_add(&bar[XB_XSUB(bx)], 1u);
        const unsigned gen = old / nloc;
        if (old + 1u == (gen + 1u) * nloc) {
            __builtin_amdgcn_fence(__ATOMIC_RELEASE, "agent");
            asm volatile("s_waitcnt vmcnt(0)" ::: "memory");
            const unsigned og = xb_add(&bar[XB_TOP], 1u);
            const unsigned tg = og / nx;
            if (og + 1u == (tg + 1u) * nx) xb_add(&bar[XB_TOPGEN], 1u);
            else XB_SPIN(xb_ld(&bar[XB_TOPGEN]) == tg, bar);
            __builtin_amdgcn_fence(__ATOMIC_ACQUIRE, "agent");
            xb_add(&bar[XB_XGEN(bx)], 1u);
            asm volatile("s_waitcnt vmcnt(0)" ::: "memory");
        } else {
            XB_SPIN(xb_ld(&bar[XB_XGEN(bx)]) == gen, bar);
            __builtin_amdgcn_fence(__ATOMIC_ACQUIRE, "agent");
            asm volatile("s_waitcnt vmcnt(0)" ::: "memory");
        }
    }
    __syncthreads();
}

namespace pg8 {
constexpr int BM = 256, BK = 64, HALF = 128, HTB = HALF * BK * 2, STAGE_BYTES = 8 * HTB, NXCD = 8, WGM = 8;
__host__ __device__ __forceinline__ int lds_byte(int r, int c) { const int st = (r >> 4) * 2 + (c >> 5), rr = r & 15, cc = c & 31, ob = rr * 64 + cc * 2; return st * 1024 + (ob ^ (((ob >> 9) & 1) << 5)); }
__host__ __device__ __forceinline__ void stage_rc(int b, int& R, int& C) { const int st = b / 1024, sb = b % 1024, swz = sb ^ (((sb >> 9) & 1) << 5); R = (st >> 1) * 16 + swz / 64; C = (st & 1) * 32 + (swz % 64) / 2; }
__host__ __device__ __forceinline__ int perm32(int rho) { const int n = rho >> 4, i = rho & 15; return 8 * (i >> 2) + 4 * n + (i & 3); }

struct Unit { const char* a; const char* b; int pm, pn; };

__device__ __forceinline__ bool static_tile(int i, int G, int c, int nM, int nN, int& pm, int& pn, const int wgm = WGM) {
    const int nwg = nM * nN; const long L = (long)i * G + c; if (L >= nwg) return false;
    int wgid = (int)L; { const int q = nwg / NXCD, r = nwg % NXCD, xcd = wgid % NXCD, off = wgid / NXCD; wgid = (xcd < r ? xcd * (q + 1) : r * (q + 1) + (xcd - r) * q) + off; }
    const int nig = wgm * nN, gid = wgid / nig, fm = gid * wgm, gsz = (nM - fm) < wgm ? (nM - fm) : wgm;
    pm = fm + ((wgid % nig) % gsz); pn = (wgid % nig) / gsz; return true;
}
struct DenseOrder {
    const char* A; const char* Bt; int K, nM, nN, G, c, split, skip; int wgm = WGM;
    __device__ __forceinline__ bool next(int i, Unit& u) const {
        int pm, pn; if (!static_tile(i, G, c, nM, nN, pm, pn, wgm)) return false;
        const int pp = pn < split ? pn : pn + skip;
        u.pm = pm; u.pn = pn; u.a = A + (size_t)pm * 256 * K * 2; u.b = Bt + (size_t)pp * 256 * K * 2; return true;
    }
    __device__ __forceinline__ void rows(const Unit&, int, int, unsigned (&)[2], unsigned (&)[2]) const {}
};

#if defined(GEMM_STAMP)
#define GSTAMP(seg) do { if (blockIdx.x == 0 && wid == 0 && lane == 0) { volatile LAS unsigned* m_ = (volatile LAS unsigned*)(lds + 159744 + 4 * 450); if (m_[14]) { const unsigned now_ = (unsigned)__builtin_amdgcn_s_memrealtime(); m_[seg] += now_ - m_[15]; m_[15] = now_; } } } while (0)
#else
#define GSTAMP(seg) do { } while (0)
#endif
template <class Epi, class Sched, bool ALIGN_EPI, bool GATHER>
__device__ __forceinline__ void gemm_phase(LAS unsigned char* lds, const int K, const Sched& S, const Epi& E, const int ld_ = 0) {
    int tid_ = threadIdx.x; asm volatile("" : "+v"(tid_));
    const int tid = tid_, wid = __builtin_amdgcn_readfirstlane(tid >> 6), lane = tid & 63, wr = wid >> 2, wc = wid & 3, fr = lane & 15, fq = lane >> 4;
    const int nt = K / BK, LD = ld_ ? ld_ : K;
    unsigned voffA[2], voffB[2]; int stR = 0, stC = 0;
#pragma unroll
    for (int i = 0; i < 2; ++i) { int R, C; stage_rc(tid * 16 + i * 8192, R, C); const int Rb = Epi::PERM ? (Epi::ADJ ? ((R >> 5) * 64 + perm32(R & 31)) : ((R & ~31) + perm32(R & 31))) : R;
        voffA[i] = (unsigned)(R * LD + C) * 2u; voffB[i] = (unsigned)(Rb * LD + C) * 2u; if (i == 0) { stR = R; stC = C; } }
    const size_t kstep = (size_t)(BK * 2);
    const size_t hstep = (size_t)HALF * LD * 2;
    const size_t hstepB = Epi::ADJ ? (size_t)32 * LD * 2 : hstep;
    const unsigned ldsw = (unsigned)wid * 1024u;
    const int aoff = lds_byte(wr * 64 + fr, fq * 8), boff = lds_byte(wc * 32 + fr, fq * 8);
    unsigned ga0[2] = {0u, 0u}, ga1[2] = {0u, 0u};
#define PG8_SA(b, h) (((b) * 2 + (h)) * HTB)
#define PG8_SB(b, h) ((4 + (b) * 2 + (h)) * HTB)
#define PG8_STAGE(bufoff, gbase, voff) do { _Pragma("unroll") for (int _i = 0; _i < 2; ++_i) \
        __builtin_amdgcn_global_load_lds((const unsigned*)((const char*)(gbase) + (voff)[_i]), (LAS unsigned*)(lds + (bufoff) + ldsw + _i * 8192), 16, 0, 0); } while (0)
#define PG8_STAGE_A(bufoff, gbase, h, nx) do { if constexpr (GATHER) { if (h) PG8_STAGE(bufoff, gbase, ga1); else PG8_STAGE(bufoff, gbase, ga0); } \
        else { PG8_STAGE(bufoff, (gbase) + (h) * hstep, voffA); } } while (0)
#define PG8_LDA(dst, b, h) do { _Pragma("unroll") for (int m = 0; m < 4; ++m) _Pragma("unroll") for (int k = 0; k < 2; ++k) dst[m][k] = *(const LAS bf16x8*)(lds + PG8_SA(b, h) + aoff + m * 2048 + k * 1024); } while (0)
#define PG8_LDB(dst, b, h) do { _Pragma("unroll") for (int n = 0; n < 2; ++n) _Pragma("unroll") for (int k = 0; k < 2; ++k) dst[n][k] = *(const LAS bf16x8*)(lds + PG8_SB(b, h) + boff + n * 2048 + k * 1024); } while (0)
#define PG8_MMA(ai, bj, At, Bt) do { __builtin_amdgcn_s_setprio(1); _Pragma("unroll") for (int m = 0; m < 4; ++m) _Pragma("unroll") for (int n = 0; n < 2; ++n) _Pragma("unroll") for (int k = 0; k < 2; ++k) \
        acc[ai][bj][m][n] = __builtin_amdgcn_mfma_f32_16x16x32_bf16(Bt[n][k], At[m][k], acc[ai][bj][m][n], 0, 0, 0); __builtin_amdgcn_s_setprio(0); } while (0)
#define PG8_WAIT_V(n) asm volatile("s_waitcnt vmcnt(" #n ")" ::: "memory")
#define PG8_WAIT_L(n) asm volatile("s_waitcnt lgkmcnt(" #n ")" ::: "memory")
#define PG8_BAR __builtin_amdgcn_s_barrier()
#define PG8_SCHED __builtin_amdgcn_sched_barrier(0)
    Unit cur, nxt; int ui = 0;
    if (!S.next(0, cur)) return;
    f32x4 acc[2][2][4][2];
#pragma unroll
    for (int a = 0; a < 2; ++a)
#pragma unroll
        for (int b = 0; b < 2; ++b)
#pragma unroll
            for (int m = 0; m < 4; ++m)
#pragma unroll
                for (int n = 0; n < 2; ++n) acc[a][b][m][n] = (f32x4){0.f, 0.f, 0.f, 0.f};
    bf16x8 At[4][2], B0[2][2], B1[2][2];
    const char* cA = cur.a; const char* cB = cur.b;
    if constexpr (GATHER) { S.rows(cur, stR, stC, ga0, ga1); }
    PG8_STAGE(PG8_SB(0, 0), cB, voffB); PG8_STAGE(PG8_SB(0, 1), cB + hstepB, voffB); PG8_STAGE_A(PG8_SA(0, 0), cA, 0, false); PG8_STAGE_A(PG8_SA(0, 1), cA, 1, false);
    if (wr == 1) PG8_BAR;
    PG8_WAIT_V(2); PG8_BAR;
    PG8_STAGE(PG8_SB(1, 0), cB + kstep, voffB); PG8_STAGE_A(PG8_SA(1, 0), cA + kstep, 0, false); PG8_STAGE(PG8_SB(1, 1), cB + hstepB + kstep, voffB);
    PG8_WAIT_V(6); PG8_BAR;
    for (;;) {
        const bool has_next = S.next(ui + 1, nxt);
        const char* nA = has_next ? nxt.a : cA; const char* nB = has_next ? nxt.b : cB;
        GSTAMP(0);
#pragma unroll 1
        for (int t = 0; t < nt; t += 2) {
            const bool last = (t == nt - 2);
            const char* a1 = cA + (size_t)(t + 1) * kstep;
            const char* a2 = last ? nA : cA + (size_t)(t + 2) * kstep; const char* b2 = last ? nB : cB + (size_t)(t + 2) * kstep;
            const char* a3 = a2 + kstep; const char* b3 = b2 + kstep;
            PG8_LDB(B0, 0, 0); PG8_LDB(B1, 0, 1); PG8_SCHED; PG8_LDA(At, 0, 0); PG8_STAGE_A(PG8_SA(1, 1), a1, 1, false);
            if constexpr (GATHER) { if (last && has_next) S.rows(nxt, stR, stC, ga0, ga1); }
            PG8_WAIT_V(8); PG8_WAIT_L(0); PG8_BAR; PG8_MMA(0, 0, At, B0); PG8_MMA(0, 1, At, B1); PG8_BAR; PG8_SCHED;
            PG8_LDA(At, 0, 1); PG8_STAGE(PG8_SB(0, 0), b2, voffB); PG8_STAGE(PG8_SB(0, 1), b2 + hstepB, voffB); PG8_STAGE_A(PG8_SA(0, 0), a2, 0, last);
            PG8_WAIT_V(8); PG8_WAIT_L(0); PG8_BAR; PG8_MMA(1, 0, At, B0); PG8_MMA(1, 1, At, B1); PG8_BAR; PG8_SCHED;
            PG8_LDB(B0, 1, 0); PG8_LDB(B1, 1, 1); PG8_SCHED; PG8_LDA(At, 1, 0); PG8_STAGE_A(PG8_SA(0, 1), a2, 1, last);
            PG8_WAIT_V(8); PG8_WAIT_L(0); PG8_BAR; PG8_MMA(0, 0, At, B0); PG8_MMA(0, 1, At, B1); PG8_BAR; PG8_SCHED;
            PG8_LDA(At, 1, 1); PG8_STAGE(PG8_SB(1, 0), b3, voffB); PG8_STAGE(PG8_SB(1, 1), b3 + hstepB, voffB); PG8_STAGE_A(PG8_SA(1, 0), a3, 0, last);
            PG8_WAIT_V(8); PG8_WAIT_L(0); PG8_BAR; PG8_MMA(1, 0, At, B0); PG8_MMA(1, 1, At, B1); PG8_BAR; PG8_SCHED;
#if defined(GEMM_STAMP)
            if (t == 0) GSTAMP(2);
#endif
        }
        GSTAMP(1);
        if constexpr (ALIGN_EPI) { if (wr == 0) PG8_BAR; }
        E(acc, cur, wr, wc, fr, fq);
        if (!has_next) break;
#pragma unroll
        for (int a = 0; a < 2; ++a)
#pragma unroll
            for (int b = 0; b < 2; ++b)
#pragma unroll
                for (int m = 0; m < 4; ++m)
#pragma unroll
                    for (int n = 0; n < 2; ++n) acc[a][b][m][n] = (f32x4){0.f, 0.f, 0.f, 0.f};
        cur = nxt; cA = nA; cB = nB; ++ui;
        if constexpr (ALIGN_EPI) { if (wr == 1) PG8_BAR; }
    }
    PG8_WAIT_V(0);
    if constexpr (!ALIGN_EPI) { if (wr == 0) PG8_BAR; }
    PG8_BAR;
#undef PG8_SA
#undef PG8_SB
#undef PG8_STAGE
#undef PG8_STAGE_A
#undef PG8_LDA
#undef PG8_LDB
#undef PG8_MMA
#undef PG8_WAIT_V
#undef PG8_WAIT_L
#undef PG8_BAR
#undef PG8_SCHED
}

#ifndef EPI_NT
#define EPI_NT 1
#endif
#if EPI_NT
#define ST16(p, v) __builtin_nontemporal_store((v), (p))
#else
#define ST16(p, v) (*(p) = (v))
#endif
#define ST16P(p, v) (*(p) = (v))
__device__ __forceinline__ u32x4 pack8(const f32x4 v0, const f32x4 v1) { u32x4 w; w.x = cvt_pk_bf16(v0[0], v0[1]); w.y = cvt_pk_bf16(v0[2], v0[3]); w.z = cvt_pk_bf16(v1[0], v1[1]); w.w = cvt_pk_bf16(v1[2], v1[3]); return w; }

__device__ __forceinline__ u32x4 ror8(const u32x4 v) { u32x4 r;
    r.x = (unsigned)__builtin_amdgcn_update_dpp(0, (int)v.x, 0x128, 0xF, 0xF, false); r.y = (unsigned)__builtin_amdgcn_update_dpp(0, (int)v.y, 0x128, 0xF, 0xF, false);
    r.z = (unsigned)__builtin_amdgcn_update_dpp(0, (int)v.z, 0x128, 0xF, 0xF, false); r.w = (unsigned)__builtin_amdgcn_update_dpp(0, (int)v.w, 0x128, 0xF, 0xF, false); return r; }
__device__ __forceinline__ u32x4 sel4(const bool c, const u32x4 a, const u32x4 b) { u32x4 r; r.x = c ? a.x : b.x; r.y = c ? a.y : b.y; r.z = c ? a.z : b.z; r.w = c ? a.w : b.w; return r; }
__device__ __forceinline__ void pair_rows(const bool hi, const u32x4 v0, const u32x4 v1, u32x4& dA, u32x4& dB) {
    const u32x4 recv = ror8(sel4(hi, v0, v1)); dA = sel4(hi, recv, v0); dB = sel4(hi, v1, recv); }
struct EpiPlain {
    static constexpr bool PERM = true, ADJ = true;
    bf16_t* O; int ldc;
    __device__ __forceinline__ void operator()(const f32x4 (&acc)[2][2][4][2], const Unit& u, int wr, int wc, int fr, int fq) const {
        bf16_t* base = O + (size_t)u.pm * BM * ldc + u.pn * BM;
        const bool hi = (fr & 8) != 0;
        const unsigned lo = (unsigned)((wr * 64 + (fr & 7)) * ldc + wc * 64 + (hi ? 32 : 0) + 8 * fq);
#pragma unroll
        for (int ai = 0; ai < 2; ++ai)
#pragma unroll
            for (int m = 0; m < 4; ++m) { u32x4 dA, dB; pair_rows(hi, pack8(acc[ai][0][m][0], acc[ai][0][m][1]), pack8(acc[ai][1][m][0], acc[ai][1][m][1]), dA, dB);
                bf16_t* rp = base + (size_t)((ai * HALF + m * 16) * ldc) + lo; ST16((u32x4*)rp, dA); ST16((u32x4*)(rp + 8 * ldc), dB); }

    }
};
struct EpiPre {
    static constexpr bool PERM = true, ADJ = true;
    bf16_t* out; const bf16_t* xb; float alpha;
    __device__ __forceinline__ void operator()(const f32x4 (&acc)[2][2][4][2], const Unit& u, int wr, int wc, int fr, int fq) const {
        const size_t ub = (size_t)u.pm * BM * 2048 + u.pn * BM; bf16_t* ob = out + ub; const bf16_t* xbb = xb + ub;
        const bool hi = (fr & 8) != 0;
        const unsigned li = (unsigned)((wr * 64 + fr) * 2048 + wc * 64 + 8 * fq);
        const unsigned lo = (unsigned)((wr * 64 + (fr & 7)) * 2048 + wc * 64 + (hi ? 32 : 0) + 8 * fq);
#pragma unroll
        for (int ai = 0; ai < 2; ++ai)
#pragma unroll
            for (int m = 0; m < 4; ++m) { const unsigned uo = (unsigned)((ai * HALF + m * 16) * 2048); u32x4 pk[2];
#pragma unroll
                for (int bj = 0; bj < 2; ++bj) { const u32x4 xw = *(const u32x4*)(xbb + uo + li + bj * 32);
                    f32x4 o0, o1; o0[0] = alpha * bf_lo(xw.x) + acc[ai][bj][m][0][0]; o0[1] = alpha * bf_hi(xw.x) + acc[ai][bj][m][0][1]; o0[2] = alpha * bf_lo(xw.y) + acc[ai][bj][m][0][2]; o0[3] = alpha * bf_hi(xw.y) + acc[ai][bj][m][0][3];
                    o1[0] = alpha * bf_lo(xw.z) + acc[ai][bj][m][1][0]; o1[1] = alpha * bf_hi(xw.z) + acc[ai][bj][m][1][1]; o1[2] = alpha * bf_lo(xw.w) + acc[ai][bj][m][1][2]; o1[3] = alpha * bf_hi(xw.w) + acc[ai][bj][m][1][3];
                    pk[bj] = pack8(o0, o1); }
                u32x4 dA, dB; pair_rows(hi, pk[0], pk[1], dA, dB);
#if defined(PRE_NT)
                ST16((u32x4*)(ob + uo + lo), dA); ST16((u32x4*)(ob + uo + 8 * 2048 + lo), dB); }
#else
                ST16P((u32x4*)(ob + uo + lo), dA); ST16P((u32x4*)(ob + uo + 8 * 2048 + lo), dB); }
#endif

    }
};
#if defined(EPI_NOSTORE)
struct EpiCinN {
    static constexpr bool PERM = true, ADJ = false;
    bf16_t* Q; bf16_t* G; const float* cs; const float* sn; int st = 1;
    __device__ __forceinline__ void operator()(const f32x4 (&acc)[2][2][4][2], const Unit& u, int wr, int wc, int fr, int fq) const {
        if (u.pn < 8) {
            bf16_t* base = Q + (size_t)u.pm * BM * 2048 + u.pn * 256;
            const int i0 = wc * 32 + 8 * fq; const unsigned lo = (unsigned)((wr * 64 + fr) * 2048 + i0);
            const int s0 = ((u.pm * BM) & 4095) + wr * 64 + fr;
            const unsigned to = (unsigned)(s0 * 128 + i0);
#pragma unroll
            for (int ai = 0; ai < 2; ++ai)
#pragma unroll
                for (int m = 0; m < 4; ++m) { const unsigned tt = to + (unsigned)((ai * HALF + m * 16) * 128);
                    const f32x4 c0 = *(const f32x4*)(cs + tt), c1 = *(const f32x4*)(cs + tt + 4), s0v = *(const f32x4*)(sn + tt), s1v = *(const f32x4*)(sn + tt + 4);
                    const f32x4 x10 = acc[ai][0][m][0], x11 = acc[ai][0][m][1], x20 = acc[ai][1][m][0], x21 = acc[ai][1][m][1];
                    const f32x4 o10 = x10 * c0 - x20 * s0v, o11 = x11 * c1 - x21 * s1v, o20 = x20 * c0 + x10 * s0v, o21 = x21 * c1 + x11 * s1v;
                    bf16_t* rowp = base + (size_t)((ai * HALF + m * 16) * 2048) + lo;
                    if (st) { ST16P((u32x4*)(rowp), pack8(o10, o11)); ST16P((u32x4*)(rowp + 128), pack8(o20, o21)); } }
        } else {
            bf16_t* base = G + (size_t)u.pm * BM * 4096 + (u.pn - 8) * BM; const unsigned lo = (unsigned)((wr * 64 + fr) * 4096 + wc * 32 + 8 * fq);
#pragma unroll
            for (int ai = 0; ai < 2; ++ai)
#pragma unroll
                for (int m = 0; m < 4; ++m)
#pragma unroll
                    for (int bj = 0; bj < 2; ++bj) if (st) ST16P((u32x4*)(base + (size_t)((ai * HALF + m * 16) * 4096 + bj * HALF) + lo), pack8(acc[ai][bj][m][0], acc[ai][bj][m][1]));
        }
    }
};
#else
struct EpiCinN {
    static constexpr bool PERM = true, ADJ = false;
    bf16_t* Q; bf16_t* G; const float* cs; const float* sn;
    __device__ __forceinline__ void operator()(const f32x4 (&acc)[2][2][4][2], const Unit& u, int wr, int wc, int fr, int fq) const {
        if (u.pn < 8) {
            bf16_t* base = Q + (size_t)u.pm * BM * 2048 + u.pn * 256;
            const int i0 = wc * 32 + 8 * fq; const unsigned lo = (unsigned)((wr * 64 + fr) * 2048 + i0);
            const int s0 = ((u.pm * BM) & 4095) + wr * 64 + fr;
            const unsigned to = (unsigned)(s0 * 128 + i0);
#pragma unroll
            for (int ai = 0; ai < 2; ++ai)
#pragma unroll
                for (int m = 0; m < 4; ++m) { const unsigned tt = to + (unsigned)((ai * HALF + m * 16) * 128);
                    const f32x4 c0 = *(const f32x4*)(cs + tt), c1 = *(const f32x4*)(cs + tt + 4), s0v = *(const f32x4*)(sn + tt), s1v = *(const f32x4*)(sn + tt + 4);
                    const f32x4 x10 = acc[ai][0][m][0], x11 = acc[ai][0][m][1], x20 = acc[ai][1][m][0], x21 = acc[ai][1][m][1];
                    const f32x4 o10 = x10 * c0 - x20 * s0v, o11 = x11 * c1 - x21 * s1v, o20 = x20 * c0 + x10 * s0v, o21 = x21 * c1 + x11 * s1v;
                    bf16_t* rowp = base + (size_t)((ai * HALF + m * 16) * 2048) + lo;
                    ST16P((u32x4*)(rowp), pack8(o10, o11)); ST16P((u32x4*)(rowp + 128), pack8(o20, o21)); }
        } else {
            bf16_t* base = G + (size_t)u.pm * BM * 4096 + (u.pn - 8) * BM; const unsigned lo = (unsigned)((wr * 64 + fr) * 4096 + wc * 32 + 8 * fq);
#pragma unroll
            for (int ai = 0; ai < 2; ++ai)
#pragma unroll
                for (int m = 0; m < 4; ++m)
#pragma unroll
                    for (int bj = 0; bj < 2; ++bj) ST16P((u32x4*)(base + (size_t)((ai * HALF + m * 16) * 4096 + bj * HALF) + lo), pack8(acc[ai][bj][m][0], acc[ai][bj][m][1]));
        }
    }
};
#endif
struct EpiCinT {
    static constexpr bool PERM = true, ADJ = false;
    bf16_t* O; const float* csT; const float* snT;
    __device__ __forceinline__ void operator()(const f32x4 (&acc)[2][2][4][2], const Unit& u, int wr, int wc, int fr, int fq) const {
        bf16_t* base = O + (size_t)u.pm * BM * 16384 + u.pn * BM; const unsigned lo = (unsigned)((wr * 64 + fr) * 16384 + wc * 32 + 8 * fq);
        if (u.pm < 8) {
            const unsigned to = (unsigned)((wr * 64 + fr) * 4096 + ((u.pn * BM) & 4095) + wc * 32 + 8 * fq);
#pragma unroll
            for (int m = 0; m < 4; ++m)
#pragma unroll
                for (int bj = 0; bj < 2; ++bj) { const unsigned tt = to + (unsigned)(m * 16 * 4096 + bj * HALF);
                    const f32x4 c0 = *(const f32x4*)(csT + tt), c1 = *(const f32x4*)(csT + tt + 4), s0 = *(const f32x4*)(snT + tt), s1 = *(const f32x4*)(snT + tt + 4);
                    const f32x4 x10 = acc[0][bj][m][0], x11 = acc[0][bj][m][1], x20 = acc[1][bj][m][0], x21 = acc[1][bj][m][1];
                    const f32x4 o10 = (x10 * c0 - x20 * s0) * 0.0625f, o11 = (x11 * c1 - x21 * s1) * 0.0625f, o20 = (x20 * c0 + x10 * s0) * 0.0625f, o21 = (x21 * c1 + x11 * s1) * 0.0625f;
                    ST16P((u32x4*)(base + (size_t)(m * 16 * 16384 + bj * HALF) + lo), pack8(o10, o11));
                    ST16P((u32x4*)(base + (size_t)((HALF + m * 16) * 16384 + bj * HALF) + lo), pack8(o20, o21)); }
        } else {
#pragma unroll
            for (int ai = 0; ai < 2; ++ai)
#pragma unroll
                for (int m = 0; m < 4; ++m)
#pragma unroll
                    for (int bj = 0; bj < 2; ++bj) ST16P((u32x4*)(base + (size_t)((ai * HALF + m * 16) * 16384 + bj * HALF) + lo), pack8(acc[ai][bj][m][0], acc[ai][bj][m][1]));
        }
    }
};
struct EpiPle {
    static constexpr bool PERM = true, ADJ = false;
    bf16_t* PLE; const bf16_t* PROJ; const float* bias; float* LOG;
    __device__ __forceinline__ void operator()(const f32x4 (&acc)[2][2][4][2], const Unit& u, int wr, int wc, int fr, int fq) const {
        if (u.pn < 8) {
            const size_t ub = (size_t)u.pm * BM * 2048 + u.pn * BM; bf16_t* pb = PLE + ub; const bf16_t* jb = PROJ + ub; const float* bb = bias + u.pn * BM;
            const unsigned lo = (unsigned)((wr * 64 + fr) * 2048 + wc * 32 + 8 * fq), lc = (unsigned)(wc * 32 + 8 * fq);
#pragma unroll
            for (int bj = 0; bj < 2; ++bj) { const f32x4 bv0 = *(const f32x4*)(bb + lc + bj * HALF), bv1 = *(const f32x4*)(bb + lc + bj * HALF + 4);
#pragma unroll
                for (int ai = 0; ai < 2; ++ai)
#pragma unroll
                    for (int m = 0; m < 4; ++m) { const unsigned uo = (unsigned)((ai * HALF + m * 16) * 2048 + bj * HALF); const u32x4 pw = __builtin_nontemporal_load((const u32x4*)(jb + uo + lo));
                        f32x4 v0 = acc[ai][bj][m][0] + bv0, v1 = acc[ai][bj][m][1] + bv1;
                        v0[0] = sigmoidf_(v0[0]) * bf_lo(pw.x); v0[1] = sigmoidf_(v0[1]) * bf_hi(pw.x); v0[2] = sigmoidf_(v0[2]) * bf_lo(pw.y); v0[3] = sigmoidf_(v0[3]) * bf_hi(pw.y);
                        v1[0] = sigmoidf_(v1[0]) * bf_lo(pw.z); v1[1] = sigmoidf_(v1[1]) * bf_hi(pw.z); v1[2] = sigmoidf_(v1[2]) * bf_lo(pw.w); v1[3] = sigmoidf_(v1[3]) * bf_hi(pw.w);
                        ST16P((u32x4*)(pb + uo + lo), pack8(v0, v1)); } }
        } else if (wc < 2) {
            float* lb = LOG + (size_t)u.pm * BM * 64; const unsigned lo = (unsigned)((wr * 64 + fr) * 64 + wc * 32 + 8 * fq);
#pragma unroll
            for (int ai = 0; ai < 2; ++ai)
#pragma unroll
                for (int m = 0; m < 4; ++m) { float* rowp = lb + (ai * HALF + m * 16) * 64 + lo;
                    *(f32x4*)(rowp) = acc[ai][0][m][0]; *(f32x4*)(rowp + 4) = acc[ai][0][m][1]; }
        }
    }
};
struct EpiLogP {
    static constexpr bool PERM = true, ADJ = false;
    float* LOGP;
    __device__ __forceinline__ void operator()(const f32x4 (&acc)[2][2][4][2], const Unit& u, int wr, int wc, int fr, int fq) const {
        if (wc < 2) {
            float* lb = LOGP + ((size_t)u.pn * 16384 + (size_t)u.pm * BM) * 64; const unsigned lo = (unsigned)((wr * 64 + fr) * 64 + wc * 32 + 8 * fq);
#pragma unroll
            for (int ai = 0; ai < 2; ++ai)
#pragma unroll
                for (int m = 0; m < 4; ++m) { float* rowp = lb + (ai * HALF + m * 16) * 64 + lo;
                    *(f32x4*)(rowp) = acc[ai][0][m][0]; *(f32x4*)(rowp + 4) = acc[ai][0][m][1]; }
        }
    }
};
struct EpiGU {
    static constexpr bool PERM = true, ADJ = false;
    bf16_t* HB;
    __device__ __forceinline__ void operator()(const f32x4 (&acc)[2][2][4][2], const Unit& u, int wr, int wc, int fr, int fq) const {
        bf16_t* base = HB + (size_t)u.pm * BM * 512 + u.pn * 128; const unsigned lo = (unsigned)((wr * 64 + fr) * 512 + wc * 32 + 8 * fq);
#pragma unroll
        for (int ai = 0; ai < 2; ++ai)
#pragma unroll
            for (int m = 0; m < 4; ++m) { f32x4 h0, h1;
#pragma unroll
                for (int j = 0; j < 4; ++j) { const float g0 = acc[ai][0][m][0][j], g1 = acc[ai][0][m][1][j]; h0[j] = g0 * sigmoidf_(g0) * acc[ai][1][m][0][j]; h1[j] = g1 * sigmoidf_(g1) * acc[ai][1][m][1][j]; }
                ST16P((u32x4*)(base + (size_t)((ai * HALF + m * 16) * 512) + lo), pack8(h0, h1)); }
    }
};
}

namespace att {
constexpr int KVBLK = 64;
constexpr int SHM_V = 16384, SHM_K = 16384, SHM_P = 8192;
constexpr int OFF_V = 0, OFF_K = 2 * SHM_V, OFF_P = OFF_K + 2 * SHM_K, OFF_WS = OFF_P + 2 * SHM_P, OFF_BIAS = OFF_WS + 8 * 64 * 4, OFF_QPE = OFF_BIAS + 512 * 4, OFF_QNO = OFF_QPE + 256 * 128, ATT_LDS = OFF_QNO + 256 * 128;
#define KSWZ(row, colB) ((row) * 256 + ((colB) ^ (((row) & 7) << 4)))
#define PSWZ(row, colB) ((row) * 128 + ((colB) ^ (((row) & 7) << 4)))
__device__ __forceinline__ int crow(int r, int hi) { return (r & 3) + 8 * (r >> 2) + 4 * hi; }

template <int MODE> struct Cfg;
template <> struct Cfg<0> { static constexpr int NQ = 4; static constexpr float SCALE = 0.07216878364870323f; static constexpr int LDQ = 1536, LDK = 2048, LDO = 2048; };
template <> struct Cfg<1> { static constexpr int NQ = 4;  static constexpr float SCALE = 0.08838834764831845f; static constexpr int LDQ = 4096, LDK = 4096, LDO = 2048; };
constexpr float THRN = 8.f;

template <int MODE>
__device__ __forceinline__ void partialSM(f32x16& p0, f32x16& p1, float& m_reg, float& mn, float& alpha) {
  constexpr float SCALE = Cfg<MODE>::SCALE; constexpr float C = SCALE * 1.4426950408889634f;
  float pmax = p0[0];
#pragma unroll
  for (int r = 1; r < 16; ++r) pmax = fmaxf(pmax, p0[r]);
#pragma unroll
  for (int r = 0; r < 16; ++r) pmax = fmaxf(pmax, p1[r]);
  { auto rr = __builtin_amdgcn_permlane32_swap(__float_as_uint(pmax), __float_as_uint(pmax), false, false);
    pmax = fmaxf(__uint_as_float(rr[0]), __uint_as_float(rr[1])); }
  if (__builtin_expect(__all(pmax - m_reg <= THRN / SCALE), 1)) { mn = m_reg; alpha = 1.f; }
  else { mn = fmaxf(m_reg, pmax); alpha = __builtin_amdgcn_exp2f((m_reg - mn) * C); m_reg = mn; }
  float mnC = -mn * C;
#pragma unroll
  for (int r = 0; r < 16; ++r) p0[r] = fmaf(p0[r], C, mnC);
#pragma unroll
  for (int r = 0; r < 16; ++r) p1[r] = fmaf(p1[r], C, mnC);
#pragma unroll
  for (int r = 0; r < 16; ++r) p0[r] = __builtin_amdgcn_exp2f(p0[r]);
}
__device__ __forceinline__ void finishSM(f32x16& p0, f32x16& p1, float alpha, float& l_reg, bf16x8& pa0, bf16x8& pa1, bf16x8& pa2, bf16x8& pa3) {
#pragma unroll
  for (int r = 0; r < 16; ++r) p1[r] = __builtin_amdgcn_exp2f(p1[r]);
  float ps = 0;
#pragma unroll
  for (int r = 0; r < 16; ++r) ps += p0[r];
#pragma unroll
  for (int r = 0; r < 16; ++r) ps += p1[r];
  { auto rr = __builtin_amdgcn_permlane32_swap(__float_as_uint(ps), __float_as_uint(ps), false, false);
    ps = __uint_as_float(rr[0]) + __uint_as_float(rr[1]); }
  l_reg = l_reg * alpha + ps;
#define PK4(P, BASE, OUT) do { unsigned a0 = cvt_pk_bf16(P[BASE + 0], P[BASE + 1]), a1 = cvt_pk_bf16(P[BASE + 2], P[BASE + 3]);   \
    unsigned b0 = cvt_pk_bf16(P[BASE + 4], P[BASE + 5]), b1 = cvt_pk_bf16(P[BASE + 6], P[BASE + 7]);                              \
    auto r0 = __builtin_amdgcn_permlane32_swap(a0, b0, false, false); auto r1 = __builtin_amdgcn_permlane32_swap(a1, b1, false, false); \
    u32x4 w = {r0[0], r1[0], r0[1], r1[1]}; OUT = *reinterpret_cast<bf16x8*>(&w); } while (0)
  PK4(p0, 0, pa0); PK4(p0, 8, pa1); PK4(p1, 0, pa2); PK4(p1, 8, pa3);
#undef PK4
}
template <int MODE>
__device__ __forceinline__ void qkt(f32x16& p0, f32x16& p1, const char* Ks, const char* Ps, const bf16x8* qr, const char* qpe, int r32, int hi) {
  p0 = f32x16{}; p1 = f32x16{};
#pragma unroll
  for (int d0 = 0; d0 < 8; ++d0) { int cb = (d0 * 16 + hi * 8) * 2;
    bf16x8 b0 = *reinterpret_cast<const bf16x8*>(Ks + KSWZ(r32, cb));
    bf16x8 b1 = *reinterpret_cast<const bf16x8*>(Ks + KSWZ(32 + r32, cb));
    const bf16x8 qf = d0 < 4 ? qr[d0 & 3] : *reinterpret_cast<const bf16x8*>(qpe + 256 * 128 + ((((d0 - 4) * 16 + hi * 8) * 2) ^ ((r32 & 7) << 4)));
    p0 = __builtin_amdgcn_mfma_f32_32x32x16_bf16(b0, qf, p0, 0, 0, 0);
    p1 = __builtin_amdgcn_mfma_f32_32x32x16_bf16(b1, qf, p1, 0, 0, 0); }
  if constexpr (MODE == 0) {
#pragma unroll
    for (int d0 = 0; d0 < 4; ++d0) { int cb = (d0 * 16 + hi * 8) * 2;
      bf16x8 b0 = *reinterpret_cast<const bf16x8*>(Ps + PSWZ(r32, cb));
      bf16x8 b1 = *reinterpret_cast<const bf16x8*>(Ps + PSWZ(32 + r32, cb));
      const bf16x8 qp = *reinterpret_cast<const bf16x8*>(qpe + (cb ^ ((r32 & 7) << 4)));
      p0 = __builtin_amdgcn_mfma_f32_32x32x16_bf16(b0, qp, p0, 0, 0, 0);
      p1 = __builtin_amdgcn_mfma_f32_32x32x16_bf16(b1, qp, p1, 0, 0, 0); }
  }
}
__device__ __forceinline__ int v_st(int k, int c) { const int kk = (k & ~0xC) | ((k & 4) << 1) | ((k & 8) >> 1); return ((kk >> 3) * 4 + (c >> 5)) * 512 + ((kk & 7) * 32 + (c & 31)) * 2; }
__device__ __forceinline__ int v_rd_base(int lane) { return ((lane & 3) << 3) | (((lane >> 2) & 3) << 6) | (((lane >> 4) & 1) << 5) | (((lane >> 5) & 1) << 8); }
constexpr int v_rd_off(int d0, int ks, int half) { return d0 * 512 + ks * 4096 + half * 2048; }
template <int OFF> __device__ __forceinline__ s16x4 tr_read(int vb) {
  s16x4 r; asm volatile("ds_read_b64_tr_b16 %0, %1 offset:%2" : "=&v"(r) : "v"(vb), "i"(OFF) : "memory"); return r;
}
template <int D0> __device__ __forceinline__ void pv_one(f32x16& od, int vb, bf16x8 pa0, bf16x8 pa1, bf16x8 pa2, bf16x8 pa3) {
  const s16x4 l0 = tr_read<v_rd_off(D0, 0, 0)>(vb), h0 = tr_read<v_rd_off(D0, 0, 1)>(vb), l1 = tr_read<v_rd_off(D0, 1, 0)>(vb), h1 = tr_read<v_rd_off(D0, 1, 1)>(vb);
  const s16x4 l2 = tr_read<v_rd_off(D0, 2, 0)>(vb), h2 = tr_read<v_rd_off(D0, 2, 1)>(vb), l3 = tr_read<v_rd_off(D0, 3, 0)>(vb), h3 = tr_read<v_rd_off(D0, 3, 1)>(vb);
  asm volatile("s_waitcnt lgkmcnt(0)" ::: "memory"); SBAR();
#define PKV(L, H) (bf16x8){L[0], L[1], L[2], L[3], H[0], H[1], H[2], H[3]}
  od = __builtin_amdgcn_mfma_f32_32x32x16_bf16(pa0, PKV(l0, h0), od, 0, 0, 0);
  od = __builtin_amdgcn_mfma_f32_32x32x16_bf16(pa1, PKV(l1, h1), od, 0, 0, 0);
  od = __builtin_amdgcn_mfma_f32_32x32x16_bf16(pa2, PKV(l2, h2), od, 0, 0, 0);
  od = __builtin_amdgcn_mfma_f32_32x32x16_bf16(pa3, PKV(l3, h3), od, 0, 0, 0);
#undef PKV
}
__device__ __forceinline__ void pv_d0(f32x16* o, int vb, bf16x8 pa0, bf16x8 pa1, bf16x8 pa2, bf16x8 pa3) {
  pv_one<0>(o[0], vb, pa0, pa1, pa2, pa3); pv_one<1>(o[1], vb, pa0, pa1, pa2, pa3); pv_one<2>(o[2], vb, pa0, pa1, pa2, pa3); pv_one<3>(o[3], vb, pa0, pa1, pa2, pa3);
}
__device__ __forceinline__ void na_mask(f32x16& p0, f32x16& p1, const float* biasS, int kr, int rq, int cq, int hi) {
  const int rs = min(max(rq - 4, 0), 56), cs = min(max(cq - 8, 0), 48);
  const bool rowok = (kr >= rs) && (kr <= rs + 7);
  int lo = (rowok ? cs : 1000) - 4 * hi;
  int bidx = (kr - rq + 7) * 31 - cq + 15 + 4 * hi;
  asm volatile("" : "+v"(bidx), "+v"(lo));
  const float* bp = biasS + bidx;
#pragma unroll
  for (int r = 0; r < 16; ++r) {
    const int c0 = (r & 3) + 8 * (r >> 2), c1 = 32 + c0;
    const bool ok0 = (unsigned)(c0 - lo) < 16u, ok1 = (unsigned)(c1 - lo) < 16u;
    const float b0 = bp[c0], b1 = bp[c1];
    p0[r] = ok0 ? p0[r] + b0 : -3.0e38f; p1[r] = ok1 ? p1[r] + b1 : -3.0e38f;
  }
}

struct AttnArgs {
  const bf16* Qp;
  const bf16* Kp; const bf16* Vp;
  const bf16* Pp;
  bf16* Op;
  const float* cosM; const float* sinM;
  int s0;
  int NT;
  int kr0;
  int rg;
  const bf16* Cq; const bf16* Wq;
};

template <int MODE>
__device__ __forceinline__ void attn_item(const AttnArgs& A, char* lds) {
  constexpr int NQ = Cfg<MODE>::NQ, LDQ = Cfg<MODE>::LDQ, LDK = Cfg<MODE>::LDK, LDO = Cfg<MODE>::LDO;
  int tid_ = threadIdx.x; asm volatile("" : "+v"(tid_));
  const int tid = tid_, wid = tid >> 6, lane = tid & 63, r32 = lane & 31, hi = lane >> 5;
  char* V_lds = lds + OFF_V; char* K_lds = lds + OFF_K; char* P_lds = lds + OFF_P;
  float* ws = (float*)(lds + OFF_WS) + wid * 64; float* li_l = ws; float* al_l = ws + 32;
  const float* biasS = (const float*)(lds + OFF_BIAS);
  float m_reg = -1e30f, l_reg = 0; f32x16 o[4] = {}; bf16x8 qr[NQ];
  char* qpe_row = lds + OFF_QPE + (wid * 32 + r32) * 128;
#ifndef FUSE_UQ
#define FUSE_UQ 1
#endif
  if constexpr (MODE == 0 && FUSE_UQ) {
    const int sig = 16 * ((r32 >> 4) & 1) + 8 * ((r32 >> 2) & 1) + 4 * ((r32 >> 3) & 1) + (r32 & 3);
    const bf16* Cw = A.Cq + (wid * 32 + r32) * 512 + hi * 8;
    const int wrow = tid >> 3, wpc = tid & 7;
    const bf16* Wg = A.Wq + wrow * 512 + wpc * 8; char* Wl = lds + OFF_V + wrow * 128 + ((wpc ^ (wrow & 7)) << 4);
    const char* Wr = lds + OFF_V + sig * 128;
    f32x16 qa[6] = {}; u32x4 wst[3]; bf16x8 cnx[4], ccur[4];
#pragma unroll
    for (int i = 0; i < 3; ++i) wst[i] = *reinterpret_cast<const u32x4*>(Wg + i * (64 * 512));
#pragma unroll
    for (int q = 0; q < 4; ++q) cnx[q] = *reinterpret_cast<const bf16x8*>(Cw + q * 16);
    __syncthreads();
#pragma unroll 1
    for (int kc = 0; kc < 8; ++kc) { const int bo = (kc & 1) * 24576;
#pragma unroll
      for (int i = 0; i < 3; ++i) *reinterpret_cast<u32x4*>(Wl + bo + i * 8192) = wst[i];
#pragma unroll
      for (int q = 0; q < 4; ++q) ccur[q] = cnx[q];
      if (kc < 7) {
#pragma unroll
        for (int i = 0; i < 3; ++i) wst[i] = *reinterpret_cast<const u32x4*>(Wg + i * (64 * 512) + (kc + 1) * 64);
#pragma unroll
        for (int q = 0; q < 4; ++q) cnx[q] = *reinterpret_cast<const bf16x8*>(Cw + (kc + 1) * 64 + q * 16); }
      __syncthreads();
#pragma unroll
      for (int q = 0; q < 4; ++q) {
#pragma unroll
        for (int j = 0; j < 6; ++j) { const bf16x8 aw = *reinterpret_cast<const bf16x8*>(Wr + bo + j * 4096 + (((2 * q + hi) ^ (sig & 7)) << 4)); qa[j] = __builtin_amdgcn_mfma_f32_32x32x16_bf16(aw, ccur[q], qa[j], 0, 0, 0); } }
    }
    __syncthreads();
#define QPK8(ACC, O) ({ u32x4 w_ = {cvt_pk_bf16(ACC[(O)], ACC[(O) + 1]), cvt_pk_bf16(ACC[(O) + 2], ACC[(O) + 3]), cvt_pk_bf16(ACC[(O) + 4], ACC[(O) + 5]), cvt_pk_bf16(ACC[(O) + 6], ACC[(O) + 7])}; *reinterpret_cast<bf16x8*>(&w_); })
    qr[0] = QPK8(qa[0], 0); qr[1] = QPK8(qa[0], 8); qr[2] = QPK8(qa[1], 0); qr[3] = QPK8(qa[1], 8);
#pragma unroll
    for (int d0 = 4; d0 < 8; ++d0) *reinterpret_cast<bf16x8*>(qpe_row + 256 * 128 + ((((d0 - 4) * 16 + hi * 8) * 2) ^ ((r32 & 7) << 4))) = (d0 & 1) ? QPK8(qa[d0 >> 1], 8) : QPK8(qa[d0 >> 1], 0);
    const int s = A.s0 + wid * 32 + r32;
#pragma unroll
    for (int c = 0; c < 2; ++c) { const int i0 = c * 16 + hi * 8;
      const f32x4 ca = *(const f32x4*)(A.cosM + s * 32 + i0), cb = *(const f32x4*)(A.cosM + s * 32 + i0 + 4), sa = *(const f32x4*)(A.sinM + s * 32 + i0), sb = *(const f32x4*)(A.sinM + s * 32 + i0 + 4);
      float o1[8], o2[8];
#pragma unroll
      for (int j = 0; j < 8; ++j) { const float a = qa[4][8 * c + j], b = qa[5][8 * c + j], cc = j < 4 ? ca[j] : cb[j - 4], ss = j < 4 ? sa[j] : sb[j - 4]; o1[j] = a * cc - b * ss; o2[j] = b * cc + a * ss; }
      u32x4 w1 = {cvt_pk_bf16(o1[0], o1[1]), cvt_pk_bf16(o1[2], o1[3]), cvt_pk_bf16(o1[4], o1[5]), cvt_pk_bf16(o1[6], o1[7])};
      u32x4 w2 = {cvt_pk_bf16(o2[0], o2[1]), cvt_pk_bf16(o2[2], o2[3]), cvt_pk_bf16(o2[4], o2[5]), cvt_pk_bf16(o2[6], o2[7])};
      *reinterpret_cast<u32x4*>(qpe_row + (((c * 16 + hi * 8) * 2) ^ ((r32 & 7) << 4))) = w1; *reinterpret_cast<u32x4*>(qpe_row + (((32 + c * 16 + hi * 8) * 2) ^ ((r32 & 7) << 4))) = w2; }
#undef QPK8
  } else {
  const bf16* Qw = A.Qp + (wid * 32 + r32) * LDQ + hi * 8;
#pragma unroll
  for (int d0 = 0; d0 < 4; ++d0) qr[d0] = *reinterpret_cast<const bf16x8*>(Qw + d0 * 16);
#pragma unroll
  for (int d0 = 4; d0 < 8; ++d0) *reinterpret_cast<bf16x8*>(qpe_row + 256 * 128 + ((((d0 - 4) * 16 + hi * 8) * 2) ^ ((r32 & 7) << 4))) = *reinterpret_cast<const bf16x8*>(Qw + d0 * 16);
  if constexpr (MODE == 0) {
    const int s = A.s0 + wid * 32 + r32;
#pragma unroll
    for (int c = 0; c < 2; ++c) {
      const u32x4 x1 = *reinterpret_cast<const u32x4*>(Qw + (8 + c) * 16), x2 = *reinterpret_cast<const u32x4*>(Qw + (10 + c) * 16);
      const int i0 = c * 16 + hi * 8;
      const f32x4 ca = *(const f32x4*)(A.cosM + s * 32 + i0), cb = *(const f32x4*)(A.cosM + s * 32 + i0 + 4), sa = *(const f32x4*)(A.sinM + s * 32 + i0), sb = *(const f32x4*)(A.sinM + s * 32 + i0 + 4);
      float a[8], b[8], cc[8], ss[8];
      a[0] = bf_lo(x1.x); a[1] = bf_hi(x1.x); a[2] = bf_lo(x1.y); a[3] = bf_hi(x1.y); a[4] = bf_lo(x1.z); a[5] = bf_hi(x1.z); a[6] = bf_lo(x1.w); a[7] = bf_hi(x1.w);
      b[0] = bf_lo(x2.x); b[1] = bf_hi(x2.x); b[2] = bf_lo(x2.y); b[3] = bf_hi(x2.y); b[4] = bf_lo(x2.z); b[5] = bf_hi(x2.z); b[6] = bf_lo(x2.w); b[7] = bf_hi(x2.w);
#pragma unroll
      for (int j = 0; j < 4; ++j) { cc[j] = ca[j]; cc[4 + j] = cb[j]; ss[j] = sa[j]; ss[4 + j] = sb[j]; }
      float o1[8], o2[8];
#pragma unroll
      for (int j = 0; j < 8; ++j) { o1[j] = a[j] * cc[j] - b[j] * ss[j]; o2[j] = b[j] * cc[j] + a[j] * ss[j]; }
      u32x4 w1 = {cvt_pk_bf16(o1[0], o1[1]), cvt_pk_bf16(o1[2], o1[3]), cvt_pk_bf16(o1[4], o1[5]), cvt_pk_bf16(o1[6], o1[7])};
      u32x4 w2 = {cvt_pk_bf16(o2[0], o2[1]), cvt_pk_bf16(o2[2], o2[3]), cvt_pk_bf16(o2[4], o2[5]), cvt_pk_bf16(o2[6], o2[7])};
      *reinterpret_cast<u32x4*>(qpe_row + (((c * 16 + hi * 8) * 2) ^ ((r32 & 7) << 4))) = w1; *reinterpret_cast<u32x4*>(qpe_row + (((32 + c * 16 + hi * 8) * 2) ^ ((r32 & 7) << 4))) = w2;
    }
  }
  }
  const int rq = A.rg * 4 + (wid >> 1), cq = 32 * (wid & 1) + r32;
  const int sr = tid >> 4, sc = (tid & 15) * 8, vst0 = v_st(sr, sc), vst1 = v_st(32 + sr, sc);
  const int pr = tid >> 3, pc = (tid & 7) * 8;
  const int vb0 = (int)(uintptr_t)V_lds + v_rd_base(lane);
  bf16x8 vs0, vs1, ks0, ks1, ps0;
  const int kvo0 = sr * LDK + sc, kvo1 = (32 + sr) * LDK + sc, po0 = pr * 64 + pc;
#define SLOAD(k0) do { const bf16* Vt = A.Vp + (size_t)(k0) * LDK; const bf16* Kt = A.Kp + (size_t)(k0) * LDK; \
    vs0 = *reinterpret_cast<const bf16x8*>(Vt + kvo0); vs1 = *reinterpret_cast<const bf16x8*>(Vt + kvo1); \
    ks0 = *reinterpret_cast<const bf16x8*>(Kt + kvo0); ks1 = *reinterpret_cast<const bf16x8*>(Kt + kvo1); \
    if constexpr (MODE == 0) ps0 = *reinterpret_cast<const bf16x8*>(A.Pp + (size_t)(k0) * 64 + po0); } while (0)
#define SWRITE(b) do { *(bf16x8*)(V_lds + (b) * SHM_V + vst0) = vs0; *(bf16x8*)(V_lds + (b) * SHM_V + vst1) = vs1; int kc = sc * 2; \
    *(bf16x8*)(K_lds + (b) * SHM_K + KSWZ(sr, kc)) = ks0; *(bf16x8*)(K_lds + (b) * SHM_K + KSWZ(32 + sr, kc)) = ks1; \
    if constexpr (MODE == 0) *(bf16x8*)(P_lds + (b) * SHM_P + PSWZ(pr, pc * 2)) = ps0; } while (0)
#define SWAIT() asm volatile("s_waitcnt vmcnt(0)" ::: "memory")
#define RESC(a) do { if (__any((a) < 1.f)) { if (hi == 0) al_l[r32] = (a); asm volatile("s_waitcnt lgkmcnt(0)" ::: "memory"); \
    _Pragma("unroll") for (int d = 0; d < 4; ++d) _Pragma("unroll") for (int r = 0; r < 16; ++r) o[d][r] *= al_l[crow(r, hi)]; } } while (0)
#define NAM(P0, P1, j) do { if constexpr (MODE == 1) na_mask(P0, P1, biasS, A.kr0 + (j), rq, cq, hi); } while (0)
  f32x16 pA0, pA1, pB0, pB1; float mnA, mnB, alA, alB; bf16x8 pa0, pa1, pa2, pa3; const int NT = A.NT;
  SLOAD(0); asm volatile("s_waitcnt vmcnt(0)" ::: "memory"); SWRITE(0); __syncthreads();
  qkt<MODE>(pA0, pA1, K_lds, P_lds, qr, qpe_row, r32, hi); NAM(pA0, pA1, 0); partialSM<MODE>(pA0, pA1, m_reg, mnA, alA);
  SLOAD(KVBLK);
  SWAIT(); SWRITE(1); __syncthreads();
  for (int j = 1; j + 1 < NT; j += 2) {
    SBAR(); qkt<MODE>(pB0, pB1, K_lds + SHM_K, P_lds + SHM_P, qr, qpe_row, r32, hi); NAM(pB0, pB1, j);
    finishSM(pA0, pA1, alA, l_reg, pa0, pa1, pa2, pa3); SBAR();
    SLOAD((j + 1) * KVBLK); SBAR();
    pv_d0(o, vb0, pa0, pa1, pa2, pa3); partialSM<MODE>(pB0, pB1, m_reg, mnB, alB);
    __syncthreads(); SWAIT(); SWRITE(0);
    RESC(alB); __syncthreads();
    SBAR(); qkt<MODE>(pA0, pA1, K_lds, P_lds, qr, qpe_row, r32, hi); NAM(pA0, pA1, j + 1);
    finishSM(pB0, pB1, alB, l_reg, pa0, pa1, pa2, pa3); SBAR();
    SLOAD((j + 2) * KVBLK); SBAR();
    pv_d0(o, vb0 + SHM_V, pa0, pa1, pa2, pa3); partialSM<MODE>(pA0, pA1, m_reg, mnA, alA);
    __syncthreads(); SWAIT(); SWRITE(1);
    RESC(alA); __syncthreads();
  }
  SBAR(); qkt<MODE>(pB0, pB1, K_lds + SHM_K, P_lds + SHM_P, qr, qpe_row, r32, hi); NAM(pB0, pB1, NT - 1);
  finishSM(pA0, pA1, alA, l_reg, pa0, pa1, pa2, pa3); SBAR();
  pv_d0(o, vb0, pa0, pa1, pa2, pa3); partialSM<MODE>(pB0, pB1, m_reg, mnB, alB);
  __syncthreads(); RESC(alB);
  finishSM(pB0, pB1, alB, l_reg, pa0, pa1, pa2, pa3); SBAR();
  pv_d0(o, vb0 + SHM_V, pa0, pa1, pa2, pa3);
  if (hi == 0) li_l[r32] = l_reg; asm volatile("s_waitcnt lgkmcnt(0)" ::: "memory");
  float rli[16];
#pragma unroll
  for (int r = 0; r < 16; ++r) rli[r] = __builtin_amdgcn_rcpf(li_l[crow(r, hi)]);
  bf16* Ow = A.Op + (wid * 32) * LDO + r32;
#pragma unroll
  for (int r = 0; r < 16; ++r) { const int orow = crow(r, hi);
#pragma unroll
    for (int d0 = 0; d0 < 4; ++d0) Ow[orow * LDO + d0 * 32] = f2bf(o[d0][r] * rli[r]); }
  __syncthreads();
#undef SLOAD
#undef SWRITE
#undef SWAIT
#undef RESC
#undef NAM
}
}

namespace ret {
constexpr int ST_PITCH = 528;
constexpr int OFF_VT = 0, VT_BYTES = 128 * 256, OFF_ST = 2 * VT_BYTES, ST_BYTES = 128 * ST_PITCH, RET_LDS = OFF_ST + ST_BYTES;
__device__ __forceinline__ int crow(int r, int hi) { return (r & 3) + 8 * (r >> 2) + 4 * hi; }

__device__ __forceinline__ unsigned ktoff(unsigned row, unsigned ch) { return 256u * row + 16u * (ch ^ (((row & 3u) << 2) | ((row >> 2) & 3u))); }
__device__ __forceinline__ void pprime_item(int item, const bf16* Qm, const bf16* KVT, bf16* PP, const float* lg2f, const float* lg2b, char* lds) {
  int tid_ = threadIdx.x; asm volatile("" : "+v"(tid_));
  const int tid = tid_, wid = __builtin_amdgcn_readfirstlane(tid >> 6), lane = tid & 63, r32 = lane & 31, hi = lane >> 5;
  const int bh = item >> 5, n = item & 31, b = bh >> 3, h = bh & 7;
  const int T0 = b * 4096 + n * 128;
  const int kb = wid >> 1, qb0 = 2 * (wid & 1);
  LAS unsigned char* ldsl = (LAS unsigned char*)lds;
  const char* kg = (const char*)(KVT + (size_t)(h * 256) * 16384 + T0);
#pragma unroll
  for (int i = 0; i < 8; ++i) { const unsigned d = 32u * wid + 4u * i + (lane >> 4); const unsigned ch = (lane & 15u) ^ (((d & 3u) << 2) | ((d >> 2) & 3u));
    __builtin_amdgcn_global_load_lds((const unsigned*)(kg + (size_t)d * 32768 + ch * 16), (LAS unsigned*)(ldsl + (8 * wid + i) * 1024), 16, 0, 0); }
  const char* qg = (const char*)(Qm + (size_t)T0 * 2048 + h * 256);
#pragma unroll
  for (int i = 0; i < 8; ++i) { const unsigned q = 2u * (8u * wid + i) + (lane >> 5); const unsigned ch = (lane & 31u) ^ (q & 15u);
    __builtin_amdgcn_global_load_lds((const unsigned*)(qg + (size_t)q * 4096 + ch * 16), (LAS unsigned*)(ldsl + 65536 + (8 * wid + i) * 1024), 16, 0, 0); }
  asm volatile("s_waitcnt vmcnt(0)" ::: "memory");
  __builtin_amdgcn_s_barrier(); asm volatile("" ::: "memory");
  const unsigned blk = (lane >> 4) & 1u, qq = (lane & 15u) >> 2, pp = lane & 3u;
  const unsigned ldsb = (unsigned)(size_t)ldsl;
  const unsigned qrow = ldsb + 65536u + (unsigned)(32 * qb0 + r32) * 512u + (unsigned)((hi ^ (r32 & 1)) << 4), qx = (unsigned)((r32 & 14) << 4);
  f32x16 acc0 = {}, acc1 = {};
#pragma unroll
  for (int ks = 0; ks < 16; ++ks) {
    const unsigned a0 = ldsb + ktoff(16u * ks + 8u * hi + qq, 4u * kb + 2u * blk + (pp >> 1)) + 8u * (pp & 1u);
    const unsigned a1 = ldsb + ktoff(16u * ks + 8u * hi + 4u + qq, 4u * kb + 2u * blk + (pp >> 1)) + 8u * (pp & 1u);
    const unsigned qa = qrow + ((32u * ks) ^ qx);
    s16x4 lo, hi4; bf16x8 q0, q1;
    asm volatile("ds_read_b64_tr_b16 %0, %4\n\tds_read_b64_tr_b16 %1, %5\n\tds_read_b128 %2, %6\n\tds_read_b128 %3, %6 offset:16384\n\ts_waitcnt lgkmcnt(0)" : "=&v"(lo), "=&v"(hi4), "=&v"(q0), "=&v"(q1) : "v"(a0), "v"(a1), "v"(qa) : "memory");
    const bf16x8 a = (bf16x8){lo[0], lo[1], lo[2], lo[3], hi4[0], hi4[1], hi4[2], hi4[3]};
    acc0 = __builtin_amdgcn_mfma_f32_32x32x16_bf16(a, q0, acc0, 0, 0, 0);
    acc1 = __builtin_amdgcn_mfma_f32_32x32x16_bf16(a, q1, acc1, 0, 0, 0);
  }
  bf16* Pf = PP + ((size_t)(bh * 32 + n) * 128) * 128;
  bf16* Pb = Pf + (size_t)1024 * 128 * 128;
  asm volatile("s_waitcnt lgkmcnt(0)" ::: "memory"); __builtin_amdgcn_s_barrier(); asm volatile("" ::: "memory");
#pragma unroll
  for (int t = 0; t < 2; ++t) {
    const int q = 32 * (qb0 + t) + r32;
#pragma unroll
    for (int g = 0; g < 4; ++g) {
      const int k0 = 32 * kb + 8 * g + 4 * hi;
      float vf[4], vb[4];
#pragma unroll
      for (int j = 0; j < 4; ++j) { const int k = k0 + j; const float sc = t ? acc1[4 * g + j] : acc0[4 * g + j];
        vf[j] = (k <= q) ? sc : 0.f;
        vb[j] = (k > q) ? sc : 0.f; }
      u32x2 wf = {cvt_pk_bf16(vf[0], vf[1]), cvt_pk_bf16(vf[2], vf[3])}, wb = {cvt_pk_bf16(vb[0], vb[1]), cvt_pk_bf16(vb[2], vb[3])};
      *reinterpret_cast<u32x2*>(lds + q * 272 + k0 * 2) = wf;
      *reinterpret_cast<u32x2*>(lds + 128 * 272 + q * 272 + k0 * 2) = wb;
    }
  }
  asm volatile("s_waitcnt lgkmcnt(0)" ::: "memory"); __builtin_amdgcn_s_barrier(); asm volatile("" ::: "memory");
#pragma unroll
  for (int i = 0; i < 8; ++i) { const int c = tid + 512 * i, dirt = c >> 11, cc = c & 2047; const u32x4 w = *reinterpret_cast<const u32x4*>(lds + dirt * (128 * 272) + (cc >> 4) * 272 + (cc & 15) * 16);
    *reinterpret_cast<u32x4*>((dirt ? Pb : Pf) + (size_t)cc * 8) = w; }
  asm volatile("s_waitcnt lgkmcnt(0)" ::: "memory"); __builtin_amdgcn_s_barrier(); asm volatile("" ::: "memory");
}


#if defined(CH_WAVE)
#define CSTAMP(seg) do { if (blockIdx.x == 0 && wid == CH_WAVE && lane == 0) { const unsigned now_ = (unsigned)__builtin_amdgcn_s_memrealtime(); volatile unsigned* m_ = (volatile unsigned*)(lds + 159744 + 4 * 450); m_[seg] += now_ - m_[15]; m_[15] = now_; } } while (0)
#else
#define CSTAMP(seg) do { } while (0)
#endif
__device__ __forceinline__ void chain_item(int item, const bf16* Qm, const bf16* KVT, const bf16* PP, bf16* Rf, bf16* Rb, const float* lg2f, const float* lg2b, char* lds) {
  int tid_ = threadIdx.x; asm volatile("" : "+v"(tid_));
  const int tid = tid_, wid = __builtin_amdgcn_readfirstlane(tid >> 6), lane = tid & 63, r32 = lane & 31, hi = lane >> 5;
  const int j = item & 3, dir = (item >> 2) & 1, bh = item >> 3, b = bh >> 3, h = bh & 7;
  const float lg2 = dir ? lg2b[h] : lg2f[h];
  const float cdec = __builtin_amdgcn_exp2f(lg2 * 128.f);
  bf16* Rout = dir ? Rb : Rf;
  const bf16* VTg = KVT + (size_t)(2048 + h * 512 + 128 * j) * 16384;
  const bf16* KTg = KVT + (size_t)(h * 256) * 16384;
  const bf16* PPd = PP + (size_t)dir * 1024 * 128 * 128 + (size_t)(bh * 32) * 128 * 128;
  char* STl = lds + OFF_ST;
  { unsigned z = 0u; asm volatile("" : "+v"(z));
    for (int i = tid; i < ST_BYTES / 16; i += 512) *reinterpret_cast<u32x4*>(STl + i * 16) = (u32x4){z, z, z, z}; }
#define VDMA(T0, buf) do { const char* vg = (const char*)(VTg + (T0)); int l_ = lane; asm volatile("" : "+v"(l_)); _Pragma("unroll") for (int i = 0; i < 4; ++i) { \
      const int v_ = 16 * wid + 4 * i + (l_ >> 4); const unsigned so_ = (unsigned)v_ * 32768u + (unsigned)(((l_ & 15) ^ (v_ & 15)) * 16); \
      __builtin_amdgcn_global_load_lds((const unsigned*)(vg + so_), (LAS unsigned*)(ldsl + OFF_VT + (buf) * VT_BYTES + (4 * wid + i) * 1024), 16, 0, 0); } } while (0)
  LAS unsigned char* ldsl = (LAS unsigned char*)lds;
  { const int n0 = dir ? 31 : 0; VDMA(b * 4096 + n0 * 128, 0); asm volatile("s_waitcnt vmcnt(0)" ::: "memory"); }
#define WGBAR() do { asm volatile("s_waitcnt lgkmcnt(0)" ::: "memory"); __builtin_amdgcn_s_barrier(); asm volatile("" ::: "memory"); } while (0)
#define VSCALE(buf) do { float lq_ = lg2; asm volatile("" : "+v"(lq_)); const int kc_ = 8 * ((tid & 15) ^ ((tid >> 4) & 15)); float kq_[8]; \
      _Pragma("unroll") for (int e = 0; e < 8; ++e) kq_[e] = __builtin_amdgcn_exp2f(dir ? lq_ * (float)(kc_ + e - 128) : -lq_ * (float)(kc_ + e + 1)); \
      _Pragma("unroll") for (int i = 0; i < 4; ++i) { u32x4* p_ = reinterpret_cast<u32x4*>(lds + OFF_VT + (buf) * VT_BYTES + (tid + 512 * i) * 16); const u32x4 x_ = *p_; u32x4 w_; \
        w_.x = cvt_pk_bf16(bf_lo(x_.x) * kq_[0], bf_hi(x_.x) * kq_[1]); w_.y = cvt_pk_bf16(bf_lo(x_.y) * kq_[2], bf_hi(x_.y) * kq_[3]); w_.z = cvt_pk_bf16(bf_lo(x_.z) * kq_[4], bf_hi(x_.z) * kq_[5]); w_.w = cvt_pk_bf16(bf_lo(x_.w) * kq_[6], bf_hi(x_.w) * kq_[7]); \
        *p_ = w_; } } while (0)
  WGBAR();
  VSCALE(0);
  WGBAR();
  if (wid < 4) {
#ifndef RET_NO_Q
    const int qb = wid; int buf = 0;
    bf16x8 pf[8], qf[16];
    const unsigned qlo = (unsigned)(r32 * 2048 + 8 * hi), plo = (unsigned)(r32 * 128 + 8 * hi), rlo = (unsigned)(4 * hi * 4096 + r32);
    { const int n = dir ? 31 : 0; const int T0 = b * 4096 + n * 128;
      const bf16* Qr = Qm + (size_t)(T0 + 32 * qb) * 2048 + h * 256 + qlo; const bf16* Pr = PPd + ((size_t)n * 128 + 32 * qb) * 128 + plo;
#pragma unroll
      for (int s = 0; s < 8; ++s) pf[s] = *reinterpret_cast<const bf16x8*>(Pr + 16 * s);
#pragma unroll
      for (int s = 0; s < 16; ++s) qf[s] = *reinterpret_cast<const bf16x8*>(Qr + 16 * s); }
    const int vrow = r32 * 256 + ((hi ^ (r32 & 1)) << 4), vx = (r32 & 14) << 4, srow = r32 * ST_PITCH + 16 * hi;
    for (int ci = 0; ci < 32; ++ci) {
      const int n = dir ? 31 - ci : ci; const int T0 = b * 4096 + n * 128;
      const int nn = dir ? n - 1 : n + 1; const int T1 = b * 4096 + nn * 128;
      CSTAMP(0);
      if (ci < 31) VDMA(T1, buf ^ 1);
      const char* VTl = lds + OFF_VT + buf * VT_BYTES + vrow; const char* STr = STl + srow;
      f32x16 o[4];
#pragma unroll
      for (int v = 0; v < 4; ++v) o[v] = f32x16{};
      bf16x8 b0[4];
#define RB(dst, t) do { _Pragma("unroll") for (int v = 0; v < 4; ++v) dst[v] = ((t) < 8) ? *reinterpret_cast<const bf16x8*>(VTl + (32 * v) * 256 + ((32 * (t)) ^ vx)) : *reinterpret_cast<const bf16x8*>(STr + (32 * v) * ST_PITCH + 32 * ((t) - 8)); } while (0)
#define RA(t) (((t) < 8) ? pf[(t) & 7] : qf[((t) - 8) & 15])
#pragma unroll
      for (int t = 0; t < 24; ++t) {
        RB(b0, t);
#pragma unroll
        for (int v = 0; v < 4; ++v) o[v] = __builtin_amdgcn_mfma_f32_32x32x16_bf16(RA(t), b0[v], o[v], 0, 0, 0);
        SBAR();
        if (t == 7) CSTAMP(1);
        if (t == 7 && ci < 31) {
          const bf16* Pr = PPd + ((size_t)nn * 128 + 32 * qb) * 128 + plo;
#pragma unroll
          for (int s = 0; s < 8; ++s) pf[s] = *reinterpret_cast<const bf16x8*>(Pr + 16 * s);
          SBAR(); }
      }
#undef RB
#undef RA
      CSTAMP(2);
      if (ci < 31) {
        const bf16* Qr = Qm + (size_t)(T1 + 32 * qb) * 2048 + h * 256 + qlo;
#pragma unroll
        for (int s = 0; s < 16; ++s) qf[s] = *reinterpret_cast<const bf16x8*>(Qr + 16 * s);
        asm volatile("s_waitcnt vmcnt(24)" ::: "memory"); }
      CSTAMP(3);
      WGBAR();
      CSTAMP(4);
      float lgc = lg2; asm volatile("" : "+v"(lgc));
      bf16* rb = Rout + (size_t)(T0 + 32 * qb) * 4096 + h * 512 + 128 * j;
#pragma unroll
      for (int r = 0; r < 16; ++r) { const int q = 32 * qb + crow(r, hi);
        const float qd = __builtin_amdgcn_exp2f(dir ? lgc * (float)(128 - q) : lgc * (float)(q + 1));
        bf16* orow = rb + (size_t)(((r & 3) + 8 * (r >> 2)) * 4096);
#pragma unroll
        for (int v = 0; v < 4; ++v) orow[32 * v + rlo] = f2bf(o[v][r] * qd); }
      if (ci < 31) VSCALE(buf ^ 1);
      CSTAMP(5);
      WGBAR();
      CSTAMP(6);
      buf ^= 1;
    }
#endif
  } else {
#ifndef RET_NO_S
    const int sw = wid - 4; int buf = 0;
    f32x16 st[2][4];
#pragma unroll
    for (int a = 0; a < 2; ++a)
#pragma unroll
      for (int v = 0; v < 4; ++v) st[a][v] = f32x16{};
    u32x4 kr0[8], kr1[8];
    const unsigned klo = (unsigned)(r32 * 16384 + 8 * hi); const bf16* Kl = KTg + (size_t)(64 * sw) * 16384;
    { const int n = dir ? 31 : 0; const bf16* K0 = Kl + b * 4096 + n * 128;
#pragma unroll
      for (int s = 0; s < 4; ++s) { kr0[s] = *reinterpret_cast<const u32x4*>(K0 + 16 * s + klo); kr1[s] = *reinterpret_cast<const u32x4*>(K0 + (size_t)32 * 16384 + 16 * s + klo); } }
    const int vrow = r32 * 256 + ((hi ^ (r32 & 1)) << 4), vx = (r32 & 14) << 4;
    for (int ci = 0; ci < 32; ++ci) {
      const int n = dir ? 31 - ci : ci;
      const int nn = dir ? n - 1 : n + 1; const int T1 = b * 4096 + nn * 128;
      CSTAMP(0);
      const char* VTl = lds + OFF_VT + buf * VT_BYTES + vrow;
      { const bf16* K0 = Kl + b * 4096 + n * 128;
#pragma unroll
        for (int s = 4; s < 8; ++s) { kr0[s] = *reinterpret_cast<const u32x4*>(K0 + 16 * s + klo); kr1[s] = *reinterpret_cast<const u32x4*>(K0 + (size_t)32 * 16384 + 16 * s + klo); } }
      SBAR();
      if (ci < 31) VDMA(T1, buf ^ 1);
      SBAR();
      CSTAMP(1);
#pragma unroll
      for (int s = 0; s < 8; ++s) {
        if (s == 4) CSTAMP(2);
        const bf16x8 f0 = __builtin_bit_cast(bf16x8, kr0[s]), f1 = __builtin_bit_cast(bf16x8, kr1[s]);
#pragma unroll
        for (int v = 0; v < 4; ++v) { const bf16x8 bv = *reinterpret_cast<const bf16x8*>(VTl + (32 * v) * 256 + ((32 * s) ^ vx));
          st[0][v] = __builtin_amdgcn_mfma_f32_32x32x16_bf16(f0, bv, st[0][v], 0, 0, 0);
          st[1][v] = __builtin_amdgcn_mfma_f32_32x32x16_bf16(f1, bv, st[1][v], 0, 0, 0); }
        SBAR();
        if (s == 3 && ci < 31) { const bf16* K0 = Kl + T1;
#pragma unroll
          for (int s2 = 0; s2 < 4; ++s2) { kr0[s2] = *reinterpret_cast<const u32x4*>(K0 + 16 * s2 + klo); kr1[s2] = *reinterpret_cast<const u32x4*>(K0 + (size_t)32 * 16384 + 16 * s2 + klo); }
          SBAR(); }
      }
      CSTAMP(3);
      if (ci < 31) asm volatile("s_waitcnt vmcnt(8)" ::: "memory");
      else asm volatile("s_waitcnt vmcnt(0)" ::: "memory");
      CSTAMP(4);
#pragma unroll
      for (int a = 0; a < 2; ++a)
#pragma unroll
        for (int v = 0; v < 4; ++v) st[a][v] = st[a][v] * cdec;
      CSTAMP(5);
      WGBAR();
      CSTAMP(6);
#pragma unroll
      for (int a = 0; a < 2; ++a)
#pragma unroll
        for (int v = 0; v < 4; ++v)
#pragma unroll
          for (int g = 0; g < 4; ++g) { const int d = 64 * sw + 32 * a + 8 * g + 4 * hi;
            u32x2 w = {cvt_pk_bf16(st[a][v][4 * g + 0], st[a][v][4 * g + 1]), cvt_pk_bf16(st[a][v][4 * g + 2], st[a][v][4 * g + 3])};
            *reinterpret_cast<u32x2*>(STl + (32 * v + r32) * ST_PITCH + d * 2) = w; }
      if (ci < 31) VSCALE(buf ^ 1);
      CSTAMP(7);
      WGBAR();
      CSTAMP(9);
      buf ^= 1;
    }
#endif
  }
  WGBAR();
#undef WGBAR
#undef VDMA
#undef VSCALE
}
}

#ifndef PHMASK
#define PHMASK 0xFFFFFFFFu
#endif
#define PH(k) ((PHMASK >> (k)) & 1u)
#ifndef REPMASK
#define REPMASK 0u
#endif
#define PHASE_OPQ int tid_o = threadIdx.x; asm volatile("" : "+v"(tid_o)); const int ptid = tid_o, plane = tid_o & 63; (void)ptid; (void)plane; int gwp = gw, ngwp = NGW, pbx = blockIdx.x, pvcu = F.vcu, pG = F.G; asm volatile("" : "+s"(gwp), "+s"(ngwp), "+s"(pbx), "+s"(pvcu), "+s"(pG)); (void)gwp; (void)ngwp; (void)pbx; (void)pvcu; (void)pG;
#if REPMASK == 0u
#define PHASE_BEGIN(k) if (PH(k)) { PHASE_OPQ
#else
#define PHASE_BEGIN(k) if (PH(k)) for (int rep_ = 0; rep_ <= (int)((REPMASK >> (k)) & 1u); ++rep_) { if (rep_) xcd_barrier(bar); PHASE_OPQ
#endif
#if defined(STAMP_A) && defined(STAMP_B)
#ifndef STAMP_AMP
#define STAMP_AMP 8
#endif
#define STAMP() do { if (threadIdx.x == 0 && blockIdx.x == 0) { const unsigned n_ = F.MISC[400]; F.MISC[401 + n_] = (unsigned)__builtin_amdgcn_s_memrealtime(); F.MISC[400] = n_ + 1u; } } while (0)
#else
#define STAMP() do { } while (0)
#endif
#define GBAR() do { xcd_barrier(bar); STAMP(); } while (0)
constexpr int NTOK = 16384, SEQ = 4096, DM = 2048, NWAVES = 8;
constexpr float DN_ALPHA = 1.4142135623730951f;
constexpr float LN_EPS = 1e-5f, RMS_EPS = 1e-6f;
constexpr size_t MiB = 1u << 20;
constexpr size_t WS_CTL = 0, CTL_ZERO_BYTES = 1 * MiB;
constexpr int CW_BAR = 4096;
constexpr int CW_CNT = 8192;
constexpr size_t WS_ABIN = 1 * MiB;
constexpr size_t WS_UQ   = 17 * MiB;
constexpr size_t WS_UKV  = WS_UQ + 1536 * 512 * 2;
constexpr size_t WS_ABOUT = WS_UKV + 2048 * 256 * 2;
constexpr size_t WS_CIN  = WS_ABOUT + 8 * MiB;
constexpr size_t WS_COUT = WS_CIN + 48 * MiB;
constexpr size_t WS_PLEG = WS_COUT + 16 * MiB;
constexpr size_t WS_PLEP = WS_PLEG + 18 * MiB;
constexpr size_t WS_TAB  = WS_PLEP + 2 * MiB;
constexpr size_t WS_PB   = WS_TAB + 10 * MiB;
constexpr size_t WS_GU   = WS_PB + 16 * MiB;
constexpr size_t WS_DN   = WS_GU + 128 * MiB;
constexpr size_t WS_XB   = WS_DN + 64 * MiB;
constexpr size_t WS_AR   = WS_XB + 64 * MiB;
static_assert(WS_AR == 393 * MiB + 512 * 1024, "map");
constexpr size_t A_H = WS_AR, A_Q = A_H + 128 * MiB, A_KV = A_Q + 48 * MiB, A_AO = A_KV + 64 * MiB, A_KPE = A_AO + 64 * MiB, A_CQN = A_KPE + 2 * MiB, A_CKVN = A_CQN + 16 * MiB;
constexpr size_t C_PRE = WS_AR + 330 * MiB;
constexpr size_t C_HB = WS_AR, C_PROJ = WS_AR + 128 * MiB, C_YB = C_PROJ + 64 * MiB, C_PLE = C_YB + 160 * MiB, C_LOG = C_PLE + 64 * MiB, C_RT = C_LOG + 4 * MiB;
static_assert(C_RT + 2 * MiB <= WS_AR + 704 * MiB, "arena");
constexpr size_t B_Q = WS_AR, B_KVT = B_Q + 64 * MiB, B_G = B_KVT + 192 * MiB, B_PP = B_G + 128 * MiB, B_K = B_PP + 64 * MiB, B_RF = B_K, B_RB = B_RF + 128 * MiB, B_A = WS_AR, WS_END = B_RB + 128 * MiB;
constexpr int MAXSLOT = 40960;
constexpr size_t RT_E = 0, RT_W = RT_E + 16384 * 8, RT_R = RT_W + 16384 * 8, RT_S = RT_R + 16384 * 8, RT_ST = RT_S + 16384 * 8, RT_BC = RT_ST + 40960 * 4;
constexpr int RING_BYTES = 159744, MISC_OFF = RING_BYTES, LDS_BYTES = 163840;
static_assert(ret::RET_LDS <= RING_BYTES && att::ATT_LDS <= RING_BYTES && pg8::STAGE_BYTES <= RING_BYTES, "LDS map");

struct Frame {
    LAS unsigned char* lds; volatile LAS unsigned* MISC; unsigned* ctl;
    int tid, lane, wave, vcu, G;
};
__device__ __forceinline__ unsigned long long ld_ptr(const Frame& F, int k) {
    volatile LAS unsigned* p = F.MISC + 256 + 2 * k; const unsigned lo = __builtin_amdgcn_readfirstlane(p[0]), hi = __builtin_amdgcn_readfirstlane(p[1]);
    return ((unsigned long long)hi << 32) | lo;
}
#define INP(k) ((const float*)(GAS const float*)ld_ptr(F, (k)))
#define WSB() ((unsigned char*)(GAS unsigned char*)ld_ptr(F, 28))
#define OUTP() ((float*)(GAS float*)ld_ptr(F, 27))
struct Args { const float* in[27]; float* out; unsigned char* ws; };

constexpr int TR_WAVE_BYTES = 64 * 68 * 4;
__device__ __forceinline__ void transpose_item(const float* W, int ldw, bf16* WT, int ldt, int k0, int n0, int dst_row0, LAS float* scr, int lane) {
    const float* src = W + (size_t)(k0 + (lane >> 4)) * ldw + n0 + 4 * (lane & 15);
#pragma unroll
    for (int i = 0; i < 16; ++i) { const int kk = 4 * i + (lane >> 4); const f32x4 v = *(const f32x4*)(src + (size_t)(4 * i) * ldw);
        *(LAS f32x4*)(scr + kk * 68 + ((4 * (lane & 15)) ^ (((kk >> 3) & 7) << 2))) = v; }
    LDS_WAIT(); asm volatile("" ::: "memory");
    const int c = lane & 7;
#pragma unroll
    for (int j = 0; j < 8; ++j) { const int n = (lane >> 3) + 8 * j; const LAS float* p = scr + (8 * c) * 68 + (n ^ (c << 2));
        v4u o; o.x = cvt_pk_bf16(p[0 * 68], p[1 * 68]); o.y = cvt_pk_bf16(p[2 * 68], p[3 * 68]); o.z = cvt_pk_bf16(p[4 * 68], p[5 * 68]); o.w = cvt_pk_bf16(p[6 * 68], p[7 * 68]);
        *(v4u*)(WT + (size_t)(dst_row0 + n) * ldt + k0 + 8 * c) = o; }
    LDS_WAIT(); asm volatile("" ::: "memory");
}
__device__ __forceinline__ void transpose_plain(const float* W, int K, int N, bf16* WT, int item, LAS float* scr, int lane) {
    const int nblk = N / 64, kb = item / nblk, nb = item % nblk;
    transpose_item(W, N, WT, K, 64 * kb, 64 * nb, 64 * nb, scr, lane);
}
struct TrItem { const float* src; bf16* dst; int ldw, ldt; };
__device__ __forceinline__ void tr_load(const TrItem& t, f32x4 (&v)[16], int lane) {
    const float* p = t.src + (size_t)(lane >> 4) * t.ldw + 4 * (lane & 15);
#pragma unroll
    for (int i = 0; i < 16; ++i) v[i] = __builtin_nontemporal_load((const f32x4*)(p + (size_t)(4 * i) * t.ldw));
}
__device__ __forceinline__ void tr_store(const TrItem& t, const f32x4 (&v)[16], LAS float* scr, int lane) {
#pragma unroll
    for (int i = 0; i < 16; ++i) { const int kk = 4 * i + (lane >> 4); *(LAS f32x4*)(scr + kk * 68 + ((4 * (lane & 15)) ^ (((kk >> 3) & 7) << 2))) = v[i]; }
    LDS_WAIT(); asm volatile("" ::: "memory");
    const int c = lane & 7;
#pragma unroll
    for (int j = 0; j < 8; ++j) { const int n = (lane >> 3) + 8 * j; const LAS float* p = scr + (8 * c) * 68 + (n ^ (c << 2));
        v4u o; o.x = cvt_pk_bf16(p[0 * 68], p[1 * 68]); o.y = cvt_pk_bf16(p[2 * 68], p[3 * 68]); o.z = cvt_pk_bf16(p[4 * 68], p[5 * 68]); o.w = cvt_pk_bf16(p[6 * 68], p[7 * 68]);
        *(v4u*)(t.dst + (size_t)n * t.ldt + 8 * c) = o; }
    LDS_WAIT(); asm volatile("" ::: "memory");
}
__device__ __forceinline__ TrItem moe_decode(int it, const float* wg, const float* wu, const float* wd, bf16* GU, bf16* DN) {
    const int which = it >> 13, r = it & 8191, e = r >> 8, q = r & 255; TrItem t;
    if (which < 2) { const int kb = q >> 3, n0 = 64 * (q & 7);
        t.src = (which ? wu : wg) + (size_t)e * 2048 * 512 + (size_t)(64 * kb) * 512 + n0; t.ldw = 512; t.ldt = 2048;
        t.dst = GU + (size_t)(e * 1024 + (n0 >> 7) * 256 + (which ? 128 : 0) + (n0 & 127)) * 2048 + 64 * kb; }
    else { const int kb = q >> 5, n0 = 64 * (q & 31);
        t.src = wd + (size_t)e * 512 * 2048 + (size_t)(64 * kb) * 2048 + n0; t.ldw = 2048; t.ldt = 512; t.dst = DN + (size_t)(e * 2048 + n0) * 512 + 64 * kb; }
    return t;
}
struct MoeDec { const float* wg; const float* wu; const float* wd; bf16* GU; bf16* DN; __device__ __forceinline__ TrItem operator()(int it) const { return moe_decode(it, wg, wu, wd, GU, DN); } };
template <class Dec>
__device__ __forceinline__ void filler_items(int first, const int stride, const int nitems, const Dec& dec, LAS float* scr, int lane) {
    int i0 = first; if (i0 >= nitems) return;
    f32x4 A[16], B[16], C[16]; TrItem ta = dec(i0), tb = ta, tc = ta; tr_load(ta, A, lane);
    int i1 = i0 + stride; bool h1 = i1 < nitems; if (h1) { tb = dec(i1); tr_load(tb, B, lane); }
    for (;;) {
        const int i2 = i1 + stride; const bool h2 = h1 && i2 < nitems; if (h2) { tc = dec(i2); tr_load(tc, C, lane); }
        tr_store(ta, A, scr, lane); if (!h1) break;
        const int i3 = i2 + stride; const bool h3 = h2 && i3 < nitems; if (h3) { ta = dec(i3); tr_load(ta, A, lane); }
        tr_store(tb, B, scr, lane); if (!h2) break;
        const int i4 = i3 + stride; const bool h4 = h3 && i4 < nitems; if (h4) { tb = dec(i4); tr_load(tb, B, lane); }
        tr_store(tc, C, scr, lane); if (!h3) break;
        i1 = i4; h1 = h4;
    }
}
__device__ __forceinline__ void moe_convert_items(int first, int stride, int lane, const float* wg, const float* wu, const float* wd, bf16* GU, bf16* DN, LAS float* scr, const int iend = 3 * 8192) {
    f32x4 cur[16], nxt[16]; int it = first;
    if (it >= iend) return;
    TrItem tc = moe_decode(it, wg, wu, wd, GU, DN); tr_load(tc, cur, lane);
    for (;;) {
        const int in = it + stride; const bool more = in < iend; TrItem tn = tc;
        if (more) { tn = moe_decode(in, wg, wu, wd, GU, DN); tr_load(tn, nxt, lane); }
        tr_store(tc, cur, scr, lane);
        if (!more) break;
#pragma unroll
        for (int i = 0; i < 16; ++i) cur[i] = nxt[i];
        tc = tn; it = in;
    }
}
#define FILLER_DEAL(c_, G_, nun_) const int rem_ = (nun_) % (G_); const bool idle_ = (c_) >= rem_; const int f0_ = (((c_) - rem_) * NWAVES + F.wave), fs_ = ((G_) - rem_) * NWAVES
__device__ __forceinline__ TrItem plain_item(const float* W, int K, int N, bf16* WT, int item) { const int nblk = N / 64, kb = item / nblk, nb = item % nblk; TrItem t;
    t.src = W + (size_t)(64 * kb) * N + 64 * nb; t.ldw = N; t.ldt = K; t.dst = WT + (size_t)(64 * nb) * K + 64 * kb; return t; }
__device__ __forceinline__ void cvt_rows(const Frame& F, int tid, const float* src, bf16* dst, size_t n8) {
    for (size_t i = (size_t)(F.vcu * 512 + tid); i < n8; i += (size_t)F.G * 512) {
        const f32x4 a = __builtin_nontemporal_load((const f32x4*)(src + i * 8)), b = __builtin_nontemporal_load((const f32x4*)(src + i * 8 + 4));
        *(u32x4*)(dst + i * 8) = pg8::pack8(a, b); }
}
__device__ __forceinline__ void sincos_acc(int pos, float inv, float& c, float& s) {
    const double a = (double)pos * (double)inv; const double k = __builtin_rint(a * 0.15915494309189535); const float r = (float)(a - k * 6.283185307179586);
    s = sinf(r); c = cosf(r);
}

#define x_in INP(0)
#define p_in INP(1)
#define ab_w_in INP(2)
#define ab_rpb INP(3)
#define ab_q_norm INP(4)
#define ab_w_uq INP(5)
#define ab_kv_norm INP(6)
#define ab_w_ukv INP(7)
#define ab_w_out INP(8)
#define c_w_in INP(9)
#define c_lrf INP(10)
#define c_lrb INP(11)
#define c_w_out INP(12)
#define ln1_g INP(13)
#define ln1_b INP(14)
#define moe_w_group INP(15)
#define moe_b_group INP(16)
#define moe_w_router INP(17)
#define moe_b_router INP(18)
#define moe_w_gate INP(19)
#define moe_w_up INP(20)
#define moe_w_down INP(21)
#define ple_w_proj INP(22)
#define ple_w_gate INP(23)
#define ple_b_gate INP(24)
#define ln2_g INP(25)
#define ln2_b INP(26)
#define W_ABIN ((bf16*)(WSB() + WS_ABIN))
#define W_UQ ((bf16*)(WSB() + WS_UQ))
#define W_UKV ((bf16*)(WSB() + WS_UKV))
#define W_ABOUT ((bf16*)(WSB() + WS_ABOUT))
#define W_CIN ((bf16*)(WSB() + WS_CIN))
#define W_COUT ((bf16*)(WSB() + WS_COUT))
#define W_PLEG ((bf16*)(WSB() + WS_PLEG))
#define W_PLEP ((bf16*)(WSB() + WS_PLEP))
#define T_COSM ((float*)(WSB() + WS_TAB))
#define T_SINM (T_COSM + 4096 * 32)
#define T_COSR (T_COSM + 2 * 4096 * 32)
#define T_SINR (T_COSR + 4096 * 128)
#define T_COSRT (T_COSR + 2 * 4096 * 128)
#define T_SINRT (T_COSR + 3 * 4096 * 128)
#define T_LG (T_COSR + 4 * 4096 * 128)
#define PB ((bf16*)(WSB() + WS_PB))
#define W_GU ((bf16*)(WSB() + WS_GU))
#define W_DN ((bf16*)(WSB() + WS_DN))
#define XB ((bf16*)(WSB() + WS_XB))
#define PRE ((bf16*)(WSB() + C_PRE))
#define H ((bf16*)(WSB() + A_H))
#define Qb ((bf16*)(WSB() + A_Q))
#define KVb ((bf16*)(WSB() + A_KV))
#define AO ((bf16*)(WSB() + A_AO))
#define KPE ((bf16*)(WSB() + A_KPE))
#define CQN ((bf16*)(WSB() + A_CQN))
#define CKVN ((bf16*)(WSB() + A_CKVN))
#define Qm ((bf16*)(WSB() + B_Q))
#define KVT ((bf16*)(WSB() + B_KVT))
#define Gm ((bf16*)(WSB() + B_G))
#define PP ((bf16*)(WSB() + B_PP))
#define Km ((bf16*)(WSB() + B_K))
#define Rf ((bf16*)(WSB() + B_RF))
#define Rb ((bf16*)(WSB() + B_RB))
#define Am ((bf16*)(WSB() + B_A))
#define PROJ ((bf16*)(WSB() + C_PROJ))
#define HB ((bf16*)(WSB() + C_HB))
#define YB ((bf16*)(WSB() + C_YB))
#define PLE ((bf16*)(WSB() + C_PLE))
#define LOG ((float*)(WSB() + C_LOG))
#define LOGP ((float*)(WSB() + C_HB))
#define TOK_E ((int*)(WSB() + C_RT + RT_E))
#define TOK_W ((float*)(WSB() + C_RT + RT_W))
#define TOK_R ((int*)(WSB() + C_RT + RT_R))
#define TOK_S ((int*)(WSB() + C_RT + RT_S))
#define SLOT_TOK ((int*)(WSB() + C_RT + RT_ST))
#define BLKCNT ((int*)(WSB() + C_RT + RT_BC))
#define MOE_CONVERT(LAYER) MOE_CONVERT_R(LAYER, 3 * 8192)
#define MOE_CONVERT_R(LAYER, IEND) do { int tq_ = threadIdx.x; asm volatile("" : "+v"(tq_)); const int lane_ = tq_ & 63; int g0_ = gw, gs_ = NGW; asm volatile("" : "+s"(g0_), "+s"(gs_)); \
        LAS float* scr_ = (LAS float*)(F.lds + F.wave * TR_WAVE_BYTES); const size_t lo_ = (size_t)(LAYER) * 32 * 2048 * 512; \
        moe_convert_items(g0_, gs_, lane_, moe_w_gate + lo_, moe_w_up + lo_, moe_w_down + lo_, W_GU, W_DN, scr_, (IEND)); \
        __syncthreads(); } while (0)
__global__ void __launch_bounds__(512, 2) fwd_kernel(Args args) {
    extern __shared__ __attribute__((aligned(16))) unsigned char lds[];
    Frame F;
    F.lds = (LAS unsigned char*)lds; F.MISC = (volatile LAS unsigned*)(F.lds + MISC_OFF);
    F.tid = threadIdx.x; F.lane = F.tid & 63; F.wave = __builtin_amdgcn_readfirstlane(F.tid >> 6);
    F.G = gridDim.x; { const int bx = blockIdx.x; F.vcu = (F.G % 8 == 0) ? (bx % 8) * (F.G / 8) + bx / 8 : bx; }
    F.ctl = (unsigned*)(args.ws + WS_CTL);
    for (int u = F.tid; u < (LDS_BYTES - MISC_OFF) / 4; u += 512) ((LAS unsigned*)(F.lds + MISC_OFF))[u] = 0u;
    __syncthreads();
    if (F.tid == 0) {
#pragma unroll
        for (int i = 0; i < 27; ++i) { const unsigned long long v = (unsigned long long)args.in[i]; F.MISC[256 + 2 * i] = (unsigned)v; F.MISC[257 + 2 * i] = (unsigned)(v >> 32); }
        { const unsigned long long v = (unsigned long long)args.out; F.MISC[256 + 54] = (unsigned)v; F.MISC[257 + 54] = (unsigned)(v >> 32); }
        { const unsigned long long v = (unsigned long long)args.ws; F.MISC[256 + 56] = (unsigned)v; F.MISC[257 + 56] = (unsigned)(v >> 32); }
    }
    __syncthreads();
    XcdBarrier bar = xcd_barrier_post(F.ctl + CW_BAR, F.MISC + 8);
    STAMP();
    const int gw = F.vcu * NWAVES + F.wave, NGW = F.G * NWAVES;
    char* ldsg = (char*)lds;


        PHASE_BEGIN(0)
    {
        LAS float* scr = (LAS float*)(F.lds + F.wave * TR_WAVE_BYTES);
        constexpr int I_ABIN = 32 * 61, I_UQ = 8 * 24, I_UKV = 4 * 32, I_ABOUT = 32 * 32, I_CIN = 32 * 192, I_COUT = 64 * 32, I_PLEG = 32 * 32, I_PLEP = 4 * 32;
        constexpr int NIT = I_ABIN + I_UQ + I_UKV + I_ABOUT + I_PLEG + I_PLEP;
        { struct Dec0 { const float* abin; const float* uq; const float* ukv; const float* about; const float* pg; const float* pp; bf16* wabin; bf16* wuq; bf16* wukv; bf16* wabout; bf16* wpg; bf16* wpp;
              __device__ __forceinline__ TrItem operator()(int r) const {
                  if (r < I_ABIN) return plain_item(abin, 2048, 3904, wabin, r); r -= I_ABIN;
                  if (r < I_UQ) return plain_item(uq, 512, 1536, wuq, r); r -= I_UQ;
                  if (r < I_UKV) return plain_item(ukv, 256, 2048, wukv, r); r -= I_UKV;
                  if (r < I_ABOUT) return plain_item(about, 2048, 2048, wabout, r); r -= I_ABOUT;
                  if (r < I_PLEG) return plain_item(pg, 2048, 2048, wpg, r); r -= I_PLEG;
                  return plain_item(pp, 256, 2048, wpp, r); } } D{ab_w_in, ab_w_uq, ab_w_ukv, ab_w_out, ple_w_gate, ple_w_proj, W_ABIN, W_UQ, W_UKV, W_ABOUT, W_PLEG, W_PLEP};
          for (int it = gwp; it < NIT; it += ngwp) { const TrItem t = D(it); f32x4 v[16]; tr_load(t, v, plane); tr_store(t, v, scr, plane); } }
        const size_t gt = (size_t)pvcu * 512 + ptid, GT = (size_t)pG * 512;
        for (size_t i = gt; i < (size_t)192 * 2048 / 8; i += GT) *(u32x4*)(W_ABIN + (size_t)3904 * 2048 + i * 8) = (u32x4){0u, 0u, 0u, 0u};
        for (size_t i = gt; i < (size_t)2 * 220 * 2048 / 8; i += GT) { const size_t L = i / (220 * 2048 / 8), r = i % (220 * 2048 / 8); *(u32x4*)(W_PLEG + (L * 2304 + 2084) * 2048 + r * 8) = (u32x4){0u, 0u, 0u, 0u}; }
        for (size_t i = gt; i < (size_t)2 * 36 * 2048; i += GT) { const int L = (int)(i / (36 * 2048)), r = (int)(i % (36 * 2048)), row = r / 2048, k = r % 2048;
            const float v = row < 4 ? moe_w_group[((size_t)L * 2048 + k) * 4 + row] : moe_w_router[(((size_t)L * 4 + ((row - 4) >> 3)) * 2048 + k) * 8 + ((row - 4) & 7)];
            W_PLEG[((size_t)L * 2304 + 2048 + row) * 2048 + k] = f2bf(v); }
        cvt_rows(F, ptid, x_in, XB, (size_t)NTOK * DM / 8);
        cvt_rows(F, ptid, p_in, PB, (size_t)2 * NTOK * 256 / 8);
        for (size_t i = gt; i < (size_t)4096 * 32; i += GT) { const int s = (int)(i >> 5), f = (int)(i & 31); float c, sn; sincos_acc(s, expf((float)(2 * f) * (-9.210340371976184f / 64.f)), c, sn); T_COSM[i] = c; T_SINM[i] = sn; }
        for (size_t i = gt; i < (size_t)4096 * 128; i += GT) { const int s = (int)(i >> 7), f = (int)(i & 127); float c, sn; sincos_acc(s, expf((float)(2 * f) * (-9.210340371976184f / 256.f)), c, sn);
            T_COSR[i] = c; T_SINR[i] = sn; T_COSRT[(size_t)f * 4096 + s] = c; T_SINRT[(size_t)f * 4096 + s] = sn; }
        if (gt < 16) { const float lr = gt < 8 ? c_lrf[gt] : c_lrb[gt - 8]; T_LG[gt] = log1pf(-expf(lr)) * 1.4426950408889634f; }
    }
        }
    GBAR();

#pragma unroll 1
    for (int L = 0; L < 2; ++L) {
        if (L == 0) {
        PHASE_BEGIN(1)
#if defined(GEMM_STAMP)
            if (GEMM_STAMP == 1) { if (threadIdx.x == 0) { F.MISC[450 + 14] = 1u; F.MISC[450 + 15] = (unsigned)__builtin_amdgcn_s_memrealtime(); } __syncthreads(); }
#endif
            { pg8::DenseOrder S{(const char*)XB, (const char*)W_ABIN, 2048, 64, 16, pG, pbx, 1 << 30, 0, 4}; pg8::EpiPlain E{H, 4096};
              pg8::gemm_phase<pg8::EpiPlain, pg8::DenseOrder, true, false>(F.lds, 2048, S, E); }
        }
            GBAR();
#if defined(GEMM_STAMP)
            if (threadIdx.x == 0) F.MISC[450 + 14] = 0u;
#endif
        PHASE_BEGIN(2)
            for (int m0 = gwp; m0 < NTOK; m0 += 4 * ngwp) {
                u32x4 wq[4]; u32x2 wk[4]; float x1[4], x2[4], rc[4], rn[4]; const int ri = plane & 31;
#pragma unroll
                for (int r = 0; r < 4; ++r) { const int m = m0 + r * ngwp; const bf16* hr = H + (size_t)m * 4096; const int s = m & 4095;
                    wq[r] = *(const u32x4*)(hr + 3072 + 8 * plane); wk[r] = *(const u32x2*)(hr + 3584 + 4 * plane); x1[r] = bf2f(hr[3840 + ri]); x2[r] = bf2f(hr[3872 + ri]);
                    rc[r] = T_COSM[s * 32 + ri]; rn[r] = T_SINM[s * 32 + ri]; }
                const f32x4 gq0 = *(const f32x4*)(ab_q_norm + 8 * plane), gq1 = *(const f32x4*)(ab_q_norm + 8 * plane + 4), gk0 = *(const f32x4*)(ab_kv_norm + 4 * plane);
#pragma unroll
                for (int r = 0; r < 4; ++r) { const int m = m0 + r * ngwp;
                    { const u32x4 w = wq[r]; float v[8] = {bf_lo(w.x), bf_hi(w.x), bf_lo(w.y), bf_hi(w.y), bf_lo(w.z), bf_hi(w.z), bf_lo(w.w), bf_hi(w.w)};
                      float ss = 0.f;
#pragma unroll
                      for (int j = 0; j < 8; ++j) ss += v[j] * v[j];
                      const float rs = 1.0f / sqrtf(wave_sum(ss, plane) * (1.f / 512.f) + RMS_EPS);
                      const f32x4 o0 = {v[0] * rs * gq0[0], v[1] * rs * gq0[1], v[2] * rs * gq0[2], v[3] * rs * gq0[3]}, o1 = {v[4] * rs * gq1[0], v[5] * rs * gq1[1], v[6] * rs * gq1[2], v[7] * rs * gq1[3]};
                      *(u32x4*)(CQN + (size_t)m * 512 + 8 * plane) = pg8::pack8(o0, o1); }
                    { const u32x2 w = wk[r]; float v[4] = {bf_lo(w.x), bf_hi(w.x), bf_lo(w.y), bf_hi(w.y)};
                      const float ss = v[0] * v[0] + v[1] * v[1] + v[2] * v[2] + v[3] * v[3];
                      const float rs = 1.0f / sqrtf(wave_sum(ss, plane) * (1.f / 256.f) + RMS_EPS);
                      u32x2 o; o.x = cvt_pk_bf16(v[0] * rs * gk0[0], v[1] * rs * gk0[1]); o.y = cvt_pk_bf16(v[2] * rs * gk0[2], v[3] * rs * gk0[3]);
                      *(u32x2*)(CKVN + (size_t)m * 256 + 4 * plane) = o; }
                    KPE[(size_t)m * 64 + plane] = f2bf(plane < 32 ? x1[r] * rc[r] - x2[r] * rn[r] : x2[r] * rc[r] + x1[r] * rn[r]); }
            }
        }
            GBAR();
        PHASE_BEGIN(3)
#if !FUSE_UQ
            { pg8::DenseOrder S{(const char*)CQN, (const char*)W_UQ, 512, 64, 6, pG, pbx, 1 << 30, 0}; pg8::EpiPlain E{Qb, 1536};
              pg8::gemm_phase<pg8::EpiPlain, pg8::DenseOrder, true, false>(F.lds, 512, S, E); }
#endif
            { pg8::DenseOrder S{(const char*)CKVN, (const char*)W_UKV, 256, 64, 8, pG, pbx, 1 << 30, 0}; pg8::EpiPlain E{KVb, 2048};
              pg8::gemm_phase<pg8::EpiPlain, pg8::DenseOrder, true, false>(F.lds, 256, S, E); }
        }
            GBAR();
        PHASE_BEGIN(4)
            if (pvcu & 1) MOE_CONVERT_R(0, 2 * 8192);
            for (int rep2_ = 0; rep2_ <= (int)((REPMASK >> 20) & 1u); ++rep2_) for (int it = pvcu; it < 512; it += pG) {
                const int bh = it >> 4, qb = it & 15, b = bh >> 3, h = bh & 7; const size_t t0 = (size_t)b * 4096 + qb * 256;
                att::AttnArgs A; A.Qp = Qb + t0 * 1536 + h * 192; A.Kp = KVb + (size_t)b * 4096 * 2048 + h * 256; A.Vp = A.Kp + 128;
                A.Pp = KPE + (size_t)b * 4096 * 64; A.Op = AO + t0 * 2048 + 1024 + h * 128; A.cosM = T_COSM; A.sinM = T_SINM; A.s0 = qb * 256; A.NT = 64; A.kr0 = 0; A.rg = 0; A.Cq = CQN + t0 * 512; A.Wq = W_UQ + (size_t)h * 192 * 512;
                att::attn_item<0>(A, ldsg);
            }
            for (int rep2_ = 0; rep2_ <= (int)((REPMASK >> 21) & 1u); ++rep2_) for (int it = pvcu; it < 512; it += pG) {
                const int bh = it >> 4, rg = it & 15, b = bh >> 3, h = bh & 7; const size_t t0 = (size_t)b * 4096 + rg * 256;
                int klo = min(max(4 * rg - 4, 0), 56), khi = min(max(4 * rg - 1, 0), 56) + 7;
                if ((khi - klo + 1) & 1) { if (khi < 63) ++khi; else --klo; }
                for (int i = ptid; i < 465; i += 512) ((float*)(ldsg + att::OFF_BIAS))[i] = ab_rpb[h * 465 + i] * 11.313708498984761f;
                att::AttnArgs A; A.Qp = H + t0 * 4096 + h * 128; A.Kp = H + ((size_t)b * 4096 + klo * 64) * 4096 + 1024 + h * 128; A.Vp = A.Kp + 1024;
                A.Pp = nullptr; A.Op = AO + t0 * 2048 + h * 128; A.cosM = nullptr; A.sinM = nullptr; A.s0 = 0; A.NT = khi - klo + 1; A.kr0 = klo; A.rg = rg; A.Cq = nullptr; A.Wq = nullptr;
                att::attn_item<1>(A, ldsg);
            }
            if (!(pvcu & 1)) MOE_CONVERT_R(0, 2 * 8192);
        }
            GBAR();
        } else {
        PHASE_BEGIN(6)
#if defined(GEMM_STAMP)
            if (GEMM_STAMP == 6) { if (threadIdx.x == 0) { F.MISC[450 + 14] = 1u; F.MISC[450 + 15] = (unsigned)__builtin_amdgcn_s_memrealtime(); } __syncthreads(); }
#endif
#if defined(B1_DELAY)
            { const unsigned long long t0_ = __builtin_amdgcn_s_memrealtime(); const unsigned long long d_ = (unsigned long long)(pvcu % B1_GROUPS) * B1_DELAY; while (__builtin_amdgcn_s_memrealtime() - t0_ < d_) __builtin_amdgcn_s_sleep(16); }
#endif
            { pg8::DenseOrder S{(const char*)XB, (const char*)W_CIN, 2048, 64, 24, pG, pbx, 8, 24, 4}; pg8::EpiCinN E{Qm, Gm, T_COSR, T_SINR};
              pg8::gemm_phase<pg8::EpiCinN, pg8::DenseOrder, true, false>(F.lds, 2048, S, E); }
            { pg8::DenseOrder S{(const char*)(W_CIN + (size_t)2048 * 2048), (const char*)XB, 2048, 24, 64, pG, pbx, 1 << 30, 0, 2}; pg8::EpiCinT E{KVT, T_COSRT, T_SINRT};
              pg8::gemm_phase<pg8::EpiCinT, pg8::DenseOrder, true, false>(F.lds, 2048, S, E); }
#if defined(EPI_NOSTORE)
            { int st_ = EPI_NOSTORE; asm volatile("" : "+s"(st_)); pg8::DenseOrder S{(const char*)XB, (const char*)W_CIN, 2048, 64, 24, pG, pbx, 8, 24, 4}; pg8::EpiCinN E{Qm, Gm, T_COSR, T_SINR, st_};
              pg8::gemm_phase<pg8::EpiCinN, pg8::DenseOrder, true, false>(F.lds, 2048, S, E); }
#endif
        }
            GBAR();
#if defined(GEMM_STAMP)
            if (threadIdx.x == 0) F.MISC[450 + 14] = 0u;
#endif
        PHASE_BEGIN(7)
            for (int it = pvcu; it < 1024; it += pG) ret::pprime_item(it, Qm, KVT, PP, T_LG, T_LG + 8, ldsg);
            __syncthreads();
#ifdef STAMP_MID_B2
            STAMP();
#endif
        }
            GBAR();
        PHASE_BEGIN(8)
            if (pvcu & 1) MOE_CONVERT(1);
            for (int it = pvcu; it < 256; it += pG) ret::chain_item(it, Qm, KVT, PP, Rf, Rb, T_LG, T_LG + 8, ldsg);
            if (!(pvcu & 1)) MOE_CONVERT(1);
        }
            GBAR();
        PHASE_BEGIN(9)
            for (int u = gwp; u < NTOK * 8; u += 4 * ngwp) {
                u32x4 a[4], bq[4], gq[4]; size_t off[4];
#pragma unroll
                for (int r = 0; r < 4; ++r) { const int uu = u + r * ngwp; off[r] = (size_t)(uu >> 3) * 4096 + (uu & 7) * 512 + 8 * plane;
                    a[r] = __builtin_nontemporal_load((const u32x4*)(Rf + off[r])); bq[r] = __builtin_nontemporal_load((const u32x4*)(Rb + off[r])); gq[r] = __builtin_nontemporal_load((const u32x4*)(Gm + off[r])); }
#pragma unroll
                for (int r = 0; r < 4; ++r) {
                    float rr[8] = {bf_lo(a[r].x) + bf_lo(bq[r].x), bf_hi(a[r].x) + bf_hi(bq[r].x), bf_lo(a[r].y) + bf_lo(bq[r].y), bf_hi(a[r].y) + bf_hi(bq[r].y), bf_lo(a[r].z) + bf_lo(bq[r].z), bf_hi(a[r].z) + bf_hi(bq[r].z), bf_lo(a[r].w) + bf_lo(bq[r].w), bf_hi(a[r].w) + bf_hi(bq[r].w)};
                    const float g[8] = {bf_lo(gq[r].x), bf_hi(gq[r].x), bf_lo(gq[r].y), bf_hi(gq[r].y), bf_lo(gq[r].z), bf_hi(gq[r].z), bf_lo(gq[r].w), bf_hi(gq[r].w)};
                    float s = 0.f;
#pragma unroll
                    for (int j = 0; j < 8; ++j) s += rr[j];
                    const float mean = wave_sum(s, plane) * (1.f / 512.f); float s2 = 0.f;
#pragma unroll
                    for (int j = 0; j < 8; ++j) { rr[j] -= mean; s2 += rr[j] * rr[j]; }
                    const float rstd = 1.0f / sqrtf(wave_sum(s2, plane) * (1.f / 512.f) + LN_EPS);
                    f32x4 o0, o1;
#pragma unroll
                    for (int j = 0; j < 4; ++j) { o0[j] = g[j] * sigmoidf_(g[j]) * rr[j] * rstd; o1[j] = g[4 + j] * sigmoidf_(g[4 + j]) * rr[4 + j] * rstd; }
                    *(u32x4*)(Am + off[r]) = pg8::pack8(o0, o1);
                }
            }
        }
            GBAR();
        }
        PHASE_BEGIN(5)
        { pg8::DenseOrder S{(const char*)(L ? Am : AO), (const char*)(L ? W_COUT : W_ABOUT), L ? 4096 : 2048, 64, 8, pG, pbx, 1 << 30, 0}; pg8::EpiPre E{PRE, XB, DN_ALPHA};
          pg8::gemm_phase<pg8::EpiPre, pg8::DenseOrder, true, false>(F.lds, L ? 4096 : 2048, S, E); }
        { pg8::DenseOrder S{(const char*)(PB + (size_t)L * NTOK * 256), (const char*)(W_PLEP + (size_t)L * 2048 * 256), 256, 64, 8, pG, pbx, 1 << 30, 0}; pg8::EpiPlain E{PROJ, 2048};
          pg8::gemm_phase<pg8::EpiPlain, pg8::DenseOrder, true, false>(F.lds, 256, S, E); }
        }
        GBAR();
#ifndef C1R
#define C1R 4
#endif
        PHASE_BEGIN(11)
        { int tid_q = threadIdx.x; asm volatile("" : "+v"(tid_q)); const int plane = tid_q & 63; int gwp = gw, ngwp = NGW; asm volatile("" : "+s"(gwp), "+s"(ngwp));
        for (int m = gwp; m < NTOK; m += C1R * ngwp) {
            float v[C1R][4][8]; float s[C1R];
#pragma unroll
            for (int r = 0; r < C1R; ++r) s[r] = 0.f;
#pragma unroll
            for (int r = 0; r < C1R; ++r) { const u32x4* xr = (const u32x4*)(PRE + (size_t)(m + r * ngwp) * DM) + plane;
#pragma unroll
                for (int j = 0; j < 4; ++j) { const u32x4 w = __builtin_nontemporal_load(xr + 64 * j); v[r][j][0] = bf_lo(w.x); v[r][j][1] = bf_hi(w.x); v[r][j][2] = bf_lo(w.y); v[r][j][3] = bf_hi(w.y); v[r][j][4] = bf_lo(w.z); v[r][j][5] = bf_hi(w.z); v[r][j][6] = bf_lo(w.w); v[r][j][7] = bf_hi(w.w); } }
#pragma unroll
            for (int r = 0; r < C1R; ++r)
#pragma unroll
                for (int j = 0; j < 4; ++j)
#pragma unroll
                    for (int q = 0; q < 8; ++q) s[r] += v[r][j][q];
            float mean[C1R], s2[C1R];
#pragma unroll
            for (int r = 0; r < C1R; ++r) { mean[r] = wave_sum(s[r], plane) * (1.f / DM); s2[r] = 0.f; }
#pragma unroll
            for (int r = 0; r < C1R; ++r)
#pragma unroll
                for (int j = 0; j < 4; ++j)
#pragma unroll
                    for (int q = 0; q < 8; ++q) { v[r][j][q] -= mean[r]; s2[r] += v[r][j][q] * v[r][j][q]; }
            float rstd[C1R];
#pragma unroll
            for (int r = 0; r < C1R; ++r) rstd[r] = 1.0f / sqrtf(wave_sum(s2[r], plane) * (1.f / DM) + LN_EPS);
#pragma unroll
            for (int j = 0; j < 4; ++j) { const int c0 = 512 * j + 8 * plane;
                const f32x4 g0 = *(const f32x4*)(ln1_g + L * DM + c0), g1 = *(const f32x4*)(ln1_g + L * DM + c0 + 4), b0 = *(const f32x4*)(ln1_b + L * DM + c0), b1 = *(const f32x4*)(ln1_b + L * DM + c0 + 4);
#pragma unroll
                for (int r = 0; r < C1R; ++r) { f32x4 y0, y1;
#pragma unroll
                    for (int q = 0; q < 4; ++q) { y0[q] = v[r][j][q] * rstd[r] * g0[q] + b0[q]; y1[q] = v[r][j][4 + q] * rstd[r] * g1[q] + b1[q]; }
                    ((u32x4*)(XB + (size_t)(m + r * ngwp) * DM) + plane)[64 * j] = pg8::pack8(y0, y1); } }
        } }
        }
        GBAR();
        PHASE_BEGIN(12)
        { pg8::DenseOrder S{(const char*)XB, (const char*)(W_PLEG + (size_t)L * 2304 * 2048), 2048, 64, 8, pG, pbx, 1 << 30, 0}; pg8::EpiPle E{PLE, PROJ, ple_b_gate + L * DM, LOG};
          pg8::gemm_phase<pg8::EpiPle, pg8::DenseOrder, true, false>(F.lds, 2048, S, E); }
        { struct LogitOrder { const char* A; const char* Bt; int G, c;
              __device__ __forceinline__ bool next(int i, pg8::Unit& u) const { const int idx = i * G + c; if (idx >= 256) return false; u.pm = idx >> 2; u.pn = idx & 3;
                  u.a = A + ((size_t)u.pm * 256 * 2048 + u.pn * 512) * 2; u.b = Bt + (size_t)u.pn * 512 * 2; return true; }
              __device__ __forceinline__ void rows(const pg8::Unit&, int, int, unsigned (&)[2], unsigned (&)[2]) const {}
          } S{(const char*)XB, (const char*)(W_PLEG + ((size_t)L * 2304 + 2048) * 2048), pG, pvcu}; pg8::EpiLogP E{LOGP};
          pg8::gemm_phase<pg8::EpiLogP, LogitOrder, true, false>(F.lds, 512, S, E, 2048); }
        if (L == 0) {
            struct Dec1 { const float* cin; const float* cout; const float* pg; const float* pp; bf16* wcin; bf16* wcout; bf16* wpg; bf16* wpp;
                __device__ __forceinline__ TrItem operator()(int it) const {
                    if (it < 6144) return plain_item(cin, 2048, 12288, wcin, it); it -= 6144;
                    if (it < 2048) return plain_item(cout, 4096, 2048, wcout, it); it -= 2048;
                    if (it < 1024) return plain_item(pg, 2048, 2048, wpg, it); it -= 1024;
                    return plain_item(pp, 256, 2048, wpp, it); } } D{c_w_in, c_w_out, ple_w_gate + (size_t)2048 * 2048, ple_w_proj + (size_t)256 * 2048, W_CIN, W_COUT, W_PLEG + (size_t)2304 * 2048, W_PLEP + (size_t)2048 * 256};
            FILLER_DEAL(pbx, pG, 512); if (idle_) filler_items(f0_, fs_, 6144 + 2048 + 1024 + 128, D, (LAS float*)(F.lds + F.wave * TR_WAVE_BYTES), plane); }
        }
        GBAR();
        PHASE_BEGIN(13)
        if (ptid < 64) {
            const int n = pvcu * 64 + ptid;
            const float* lg = LOGP + (size_t)n * 64; constexpr size_t LP = (size_t)16384 * 64;
            float gl[4]; int gi = 0;
#pragma unroll
            for (int g = 0; g < 4; ++g) gl[g] = ((lg[g] + lg[g + LP]) + (lg[g + 2 * LP] + lg[g + 3 * LP])) + moe_b_group[L * 4 + g];
            float gm = gl[0];
#pragma unroll
            for (int g = 1; g < 4; ++g) if (gl[g] > gm) { gm = gl[g]; gi = g; }
            float gs = 0.f;
#pragma unroll
            for (int g = 0; g < 4; ++g) gs += fast_exp(gl[g] - gm);
            const float pg = 1.0f / gs;
            float el[8];
#pragma unroll
            for (int e = 0; e < 8; ++e) { const float* le = lg + 4 + gi * 8 + e; el[e] = ((le[0] + le[LP]) + (le[2 * LP] + le[3 * LP])) + moe_b_router[(L * 4 + gi) * 8 + e]; }
            int i0 = 0; float m0 = el[0];
#pragma unroll
            for (int e = 1; e < 8; ++e) if (el[e] > m0) { m0 = el[e]; i0 = e; }
            int i1 = -1; float m1 = -3.0e38f;
#pragma unroll
            for (int e = 0; e < 8; ++e) if (e != i0 && el[e] > m1) { m1 = el[e]; i1 = e; }
            float one = 1.0f; asm volatile("" : "+v"(one));
            const float t1 = fast_exp(m1 - m0), den = one / (one + t1);
            const int e0 = gi * 8 + i0, e1 = gi * 8 + i1;
            int r0 = 0, r1 = 0, mycnt = 0; const unsigned long long ltm = (1ull << ptid) - 1ull;
#pragma unroll 1
            for (int e = 0; e < 32; ++e) {
                const unsigned long long b0 = __ballot(e0 == e), b1 = __ballot(e1 == e);
                const int below = __popcll(b0 & ltm) + __popcll(b1 & ltm);
                if (e0 == e) r0 = below; if (e1 == e) r1 = below;
                if (ptid == e) mycnt = __popcll(b0) + __popcll(b1);
            }
            TOK_E[2 * n] = e0; TOK_E[2 * n + 1] = e1; TOK_W[2 * n] = pg * den; TOK_W[2 * n + 1] = pg * t1 * den; TOK_R[2 * n] = r0; TOK_R[2 * n + 1] = r1;
            if (ptid < 32) BLKCNT[pvcu * 32 + ptid] = mycnt;
        }
        }
        GBAR();
        volatile LAS int* EOFF = (volatile LAS int*)(F.MISC + 16);
        PHASE_BEGIN(14)
        { volatile LAS int* red = (volatile LAS int*)F.lds;
          const int e = ptid & 31, grp = ptid >> 5; int tot = 0, bel = 0;
          for (int b2 = grp; b2 < pG; b2 += 16) { const int c = BLKCNT[b2 * 32 + e]; tot += c; bel += (b2 < pvcu) ? c : 0; }
          red[ptid] = tot; red[512 + ptid] = bel;
          __syncthreads();
          if (ptid < 32) { int t = 0, q = 0; for (int g = 0; g < 16; ++g) { t += red[g * 32 + ptid]; q += red[512 + g * 32 + ptid]; } red[1024 + ptid] = t; red[1056 + ptid] = q; }
          __syncthreads();
          if (ptid == 0) { int acc = 0; for (int q = 0; q < 32; ++q) { EOFF[q] = acc; acc += (red[1024 + q] + 255) & ~255; } EOFF[32] = acc; }
          __syncthreads();
          if (ptid < 64) { const int n = pvcu * 64 + ptid;
#pragma unroll
            for (int k = 0; k < 2; ++k) { const int ee = TOK_E[2 * n + k]; const int slot = EOFF[ee] + red[1056 + ee] + TOK_R[2 * n + k]; SLOT_TOK[slot] = n; TOK_S[2 * n + k] = slot; } }
          for (int ee = pvcu; ee < 32; ee += pG) { const int c = red[1024 + ee]; const int pe = (c + 255) & ~255;
            for (int i = c + ptid; i < pe; i += 512) SLOT_TOK[EOFF[ee] + i] = 0; }
          __syncthreads();
        }
        }
        GBAR();
        const int ntiles = EOFF[32] >> 8;
        PHASE_BEGIN(15)
        {
            struct MoeGU { const char* A; const char* Bt; const int* slot_tok; volatile LAS int* eoff; int nun, G, c;
                __device__ __forceinline__ bool next(int i, pg8::Unit& u) const { const long Lq = (long)i * G + c; if (Lq >= nun) return false; const int t = (int)(Lq >> 2), pn = (int)(Lq & 3);
                    int e = 0;
#pragma unroll 1
                    for (int q = 1; q < 32; ++q) if (eoff[q] <= t * 256) e = q;
                    u.pm = t; u.pn = pn; u.a = A; u.b = Bt + ((size_t)e * 1024 + pn * 256) * 2048 * 2; return true; }
                __device__ __forceinline__ void rows(const pg8::Unit& u, int R, int C, unsigned (&o0)[2], unsigned (&o1)[2]) const {
                    int Ro = R; asm volatile("" : "+v"(Ro));
                    const int* st = slot_tok + u.pm * 256 + Ro;
                    o0[0] = (unsigned)st[0] * 4096u + (unsigned)C * 2u; o0[1] = (unsigned)st[64] * 4096u + (unsigned)C * 2u; o1[0] = (unsigned)st[128] * 4096u + (unsigned)C * 2u; o1[1] = (unsigned)st[192] * 4096u + (unsigned)C * 2u; }
            } S{(const char*)XB, (const char*)W_GU, SLOT_TOK, EOFF, ntiles * 4, pG, pvcu};
            pg8::EpiGU E{HB};
            pg8::gemm_phase<pg8::EpiGU, MoeGU, true, true>(F.lds, 2048, S, E);
            if (L == 0) {
                struct Dec2 { const float* wg; const float* wu; const float* wd; bf16* gu; bf16* dn;
                    __device__ __forceinline__ TrItem operator()(int it) const { return moe_decode(it + 2 * 8192, wg, wu, wd, gu, dn); } } D{moe_w_gate, moe_w_up, moe_w_down, W_GU, W_DN};
                FILLER_DEAL(pvcu, pG, ntiles * 4); if (idle_) filler_items(f0_, fs_, 8192, D, (LAS float*)(F.lds + F.wave * TR_WAVE_BYTES), plane); }
        }
        }
        GBAR();
        PHASE_BEGIN(16)
        {
            struct MoeDN { const char* A; const char* Bt; volatile LAS int* eoff; int nun, G, c;
                __device__ __forceinline__ bool next(int i, pg8::Unit& u) const { const long Lq = (long)i * G + c; if (Lq >= nun) return false; const int t = (int)(Lq >> 3), pn = (int)(Lq & 7);
                    int e = 0;
#pragma unroll 1
                    for (int q = 1; q < 32; ++q) if (eoff[q] <= t * 256) e = q;
                    u.pm = t; u.pn = pn; u.a = A + (size_t)t * 256 * 512 * 2; u.b = Bt + ((size_t)e * 2048 + pn * 256) * 512 * 2; return true; }
                __device__ __forceinline__ void rows(const pg8::Unit&, int, int, unsigned (&)[2], unsigned (&)[2]) const {}
            } S{(const char*)HB, (const char*)W_DN, EOFF, ntiles * 8, pG, pvcu};
            pg8::EpiPlain E{YB, 2048};
            pg8::gemm_phase<pg8::EpiPlain, MoeDN, true, false>(F.lds, 512, S, E);
        }
        }
        GBAR();
        PHASE_BEGIN(17)
#ifndef C7R
#define C7R 2
#endif
        int ns0[C7R], ns1[C7R]; float nw0[C7R], nw1[C7R];
#pragma unroll
        for (int r = 0; r < C7R; ++r) { const int mm = gwp + r * ngwp; ns0[r] = TOK_S[2 * mm]; ns1[r] = TOK_S[2 * mm + 1]; nw0[r] = TOK_W[2 * mm]; nw1[r] = TOK_W[2 * mm + 1]; }
        for (int m = gwp; m < NTOK; m += C7R * ngwp) {
            int s0[C7R], s1[C7R]; float w0[C7R], w1[C7R];
#pragma unroll
            for (int r = 0; r < C7R; ++r) { s0[r] = ns0[r]; s1[r] = ns1[r]; w0[r] = nw0[r]; w1[r] = nw1[r]; }
            { const int mb = (m + C7R * ngwp < NTOK) ? m + C7R * ngwp : m;
#pragma unroll
              for (int r = 0; r < C7R; ++r) { const int mm = mb + r * ngwp; ns0[r] = TOK_S[2 * mm]; ns1[r] = TOK_S[2 * mm + 1]; nw0[r] = TOK_W[2 * mm]; nw1[r] = TOK_W[2 * mm + 1]; } }
            float v[C7R][4][8]; float s[C7R];
#pragma unroll
            for (int r = 0; r < C7R; ++r) { const int mr = m + r * ngwp; s[r] = 0.f;
                const u32x4* xr = (const u32x4*)(XB + (size_t)mr * DM) + plane; const u32x4* y0 = (const u32x4*)(YB + (size_t)s0[r] * DM) + plane; const u32x4* y1 = (const u32x4*)(YB + (size_t)s1[r] * DM) + plane;
                const u32x4* pr = (const u32x4*)(PLE + (size_t)mr * DM) + plane;
#pragma unroll
                for (int j = 0; j < 4; ++j) { const u32x4 a = xr[64 * j], b0 = __builtin_nontemporal_load(y0 + 64 * j), b1 = __builtin_nontemporal_load(y1 + 64 * j), c = __builtin_nontemporal_load(pr + 64 * j);
                    const unsigned aw[4] = {a.x, a.y, a.z, a.w}, b0w[4] = {b0.x, b0.y, b0.z, b0.w}, b1w[4] = {b1.x, b1.y, b1.z, b1.w}, cw[4] = {c.x, c.y, c.z, c.w};
#pragma unroll
                    for (int q = 0; q < 4; ++q) { v[r][j][2 * q] = DN_ALPHA * bf_lo(aw[q]) + w0[r] * bf_lo(b0w[q]) + w1[r] * bf_lo(b1w[q]) + bf_lo(cw[q]); v[r][j][2 * q + 1] = DN_ALPHA * bf_hi(aw[q]) + w0[r] * bf_hi(b0w[q]) + w1[r] * bf_hi(b1w[q]) + bf_hi(cw[q]);
                        s[r] += v[r][j][2 * q] + v[r][j][2 * q + 1]; } } }
            float rstd[C7R];
#pragma unroll
            for (int r = 0; r < C7R; ++r) { const float mean = wave_sum(s[r], plane) * (1.f / DM); float s2 = 0.f;
#pragma unroll
                for (int j = 0; j < 4; ++j)
#pragma unroll
                    for (int q = 0; q < 8; ++q) { v[r][j][q] -= mean; s2 += v[r][j][q] * v[r][j][q]; }
                rstd[r] = 1.0f / sqrtf(wave_sum(s2, plane) * (1.f / DM) + LN_EPS); }
#pragma unroll
            for (int j = 0; j < 4; ++j) { const int c0 = 512 * j + 8 * plane;
                const f32x4 g0 = *(const f32x4*)(ln2_g + L * DM + c0), g1 = *(const f32x4*)(ln2_g + L * DM + c0 + 4), b0 = *(const f32x4*)(ln2_b + L * DM + c0), b1 = *(const f32x4*)(ln2_b + L * DM + c0 + 4);
#pragma unroll
                for (int r = 0; r < C7R; ++r) { const int mr = m + r * ngwp; f32x4 y0v, y1v;
#pragma unroll
                    for (int q = 0; q < 4; ++q) { y0v[q] = v[r][j][q] * rstd[r] * g0[q] + b0[q]; y1v[q] = v[r][j][4 + q] * rstd[r] * g1[q] + b1[q]; }
                    if (L == 1) { *(f32x4*)(OUTP() + (size_t)mr * DM + c0) = y0v; *(f32x4*)(OUTP() + (size_t)mr * DM + c0 + 4) = y1v; }
                    else ((u32x4*)(XB + (size_t)mr * DM) + plane)[64 * j] = pg8::pack8(y0v, y1v); } }
        }
        }
        if (L == 0) GBAR();
    }
#if defined(STAMP_A) && defined(STAMP_B)
    STAMP();
#if defined(CH_WAVE) || defined(GEMM_STAMP)
    if (threadIdx.x == 0 && blockIdx.x == 0) { const unsigned dt = F.MISC[450 + CH_SEG]; const unsigned long long t0 = __builtin_amdgcn_s_memrealtime();
#else
    if (threadIdx.x == 0 && blockIdx.x == 0) { const unsigned dt = F.MISC[401 + STAMP_B] - F.MISC[401 + STAMP_A]; const unsigned long long t0 = __builtin_amdgcn_s_memrealtime();
#endif
        while (__builtin_amdgcn_s_memrealtime() - t0 < (unsigned long long)dt * STAMP_AMP) __builtin_amdgcn_s_sleep(32); }
#endif
}

extern "C" void kernel_launch(void* const* d_in, const int* in_sizes, int n_in, void* d_out, int out_size, void* d_ws, size_t ws_size, hipStream_t stream) {
    static int grid = 0;
    if (grid == 0) {
        if (n_in != 27 || out_size != NTOK * DM || ws_size < WS_END) { fprintf(stderr, "kernel_launch: unexpected shapes (n_in %d out %d ws %zu need %zu)\n", n_in, out_size, ws_size, (size_t)WS_END); grid = -1; return; }
        int dev = 0, cus = 0;
        if (hipGetDevice(&dev) != hipSuccess || hipDeviceGetAttribute(&cus, hipDeviceAttributeMultiprocessorCount, dev) != hipSuccess) { grid = -1; return; }
        if (hipFuncSetAttribute((const void*)fwd_kernel, hipFuncAttributeMaxDynamicSharedMemorySize, LDS_BYTES) != hipSuccess) { grid = -1; return; }
        if (cus < 256) { fprintf(stderr, "kernel_launch: needs 256 CUs\n"); grid = -1; return; }
        grid = 256;
    }
    if (grid < 0) return;
    (void)hipMemsetAsync((char*)d_ws + WS_CTL, 0, CTL_ZERO_BYTES, stream);
    Args a{};
    for (int i = 0; i < 27; ++i) a.in[i] = (const float*)d_in[i];
    a.out = (float*)d_out; a.ws = (unsigned char*)d_ws;
    hipLaunchKernelGGL(fwd_kernel, dim3(grid), dim3(512), LDS_BYTES, stream, a);
}
```
